# Optimizing an MI355X kernel written in HIP

```python
import math
import jax, jax.numpy as jnp
from jax import lax
import numpy as np

D_MODEL = 2048
BATCH = 2
SEQ = 4096
DEPTH = 2

N_EVEN = (DEPTH + 1) // 2
N_ODD = DEPTH // 2
PLE_DIM = 256
D_FF = 5632
NORM_EPS = 1e-6
POOL_WINDOWS = (2, 4, 8, 16)
POOL_GROUPS = 4
POOL_WIDTH = D_MODEL // 2
POOL_GROUP_DIM = POOL_WIDTH // POOL_GROUPS
DIFF_HEAD_DIM = 128
DIFF_HEADS = D_MODEL // (4 * DIFF_HEAD_DIM)
DIFF_WIDTH = DIFF_HEADS * 2 * DIFF_HEAD_DIM
ROPE_THETA = 500000.0
ROT_DIM = DIFF_HEAD_DIM // 4
Q_BLOCK = 128
SUBLN_EPS = 1e-5
AB_IN_WIDTH = POOL_WIDTH + 3 * DIFF_WIDTH
AB_OUT_WIDTH = POOL_WIDTH + DIFF_WIDTH
HGRN_EXPAND = 128
HGRN_HEADS = D_MODEL // HGRN_EXPAND
HGRN_DK = HGRN_EXPAND
HGRN_DV = D_MODEL // HGRN_HEADS
HGRN_CHUNK = 64

kernel_name = "hybrid_pool_diffattn_hgrn2_macaron"


def rmsnorm(x, gain, eps=NORM_EPS):
    xf = x.astype(jnp.float32)
    y = xf * lax.rsqrt(jnp.mean(xf * xf, axis=-1, keepdims=True) + eps) * gain.astype(jnp.float32)
    return y.astype(x.dtype)


def swiglu(h, w_gate, w_up, w_down):
    return (jax.nn.silu(h @ w_gate) * (h @ w_up)) @ w_down


def rope_tables(positions):
    inv_freq = ROPE_THETA ** (-jnp.arange(0, ROT_DIM, 2, dtype=jnp.float32) / ROT_DIM)
    ang = positions.astype(jnp.float32)[..., None] * inv_freq
    return jnp.cos(ang), jnp.sin(ang)


def partial_rope(t, cos, sin):
    c = cos[:, :, None, None, :]
    s = sin[:, :, None, None, :]
    half = ROT_DIM // 2
    x1 = t[..., :half]
    x2 = t[..., half:ROT_DIM]
    rot = jnp.concatenate([x1 * c - x2 * s, x2 * c + x1 * s], axis=-1).astype(t.dtype)
    return jnp.concatenate([rot, t[..., ROT_DIM:]], axis=-1)


def multiscale_pool(u, pool_w, pool_scale):
    B, S, _ = u.shape
    ug = u.reshape(B, S, POOL_GROUPS, POOL_GROUP_DIM)
    t = jnp.arange(1, S + 1, dtype=jnp.float32)
    outs = []
    for g, w in enumerate(POOL_WINDOWS):
        v = ug[:, :, g].astype(jnp.float32)
        cs = jnp.cumsum(v, axis=1)
        lag = jnp.pad(cs, ((0, 0), (w, 0), (0, 0)))[:, :S]
        mean = (cs - lag) / jnp.minimum(t, float(w))[None, :, None]
        outs.append(mean - v)
    d = jnp.stack(outs, axis=2).astype(u.dtype)
    y = jnp.einsum('bsgc,gcd->bsgd', d, pool_w).reshape(B, S, POOL_WIDTH)
    return y * pool_scale


def diff_attention(q, k, v, cos, sin, lam_params, subln, lam_init):
    B, S, _ = q.shape
    H, DH = DIFF_HEADS, DIFF_HEAD_DIM
    q = partial_rope(q.reshape(B, S, H, 2, DH), cos, sin)
    k = partial_rope(k.reshape(B, S, H, 2, DH), cos, sin)
    v = v.reshape(B, S, H, 2 * DH)
    lp = lam_params.astype(jnp.float32)
    lam = jnp.exp(jnp.sum(lp[0] * lp[1])) - jnp.exp(jnp.sum(lp[2] * lp[3])) + lam_init
    scale = DH ** -0.5
    kt = k.transpose(0, 2, 3, 1, 4)
    vt = v.transpose(0, 2, 1, 3)
    nb = S // Q_BLOCK
    qb = q.reshape(B, nb, Q_BLOCK, H, 2, DH).transpose(1, 0, 3, 4, 2, 5)
    kpos = jnp.arange(S)

    def one_block(args):
        q_blk, b_idx = args
        qpos = b_idx * Q_BLOCK + jnp.arange(Q_BLOCK)
        s = jnp.einsum('bhcqd,bhckd->bhcqk', q_blk, kt).astype(jnp.float32) * scale
        s = jnp.where(kpos[None, :] <= qpos[:, None], s, -jnp.inf)
        pr = jax.nn.softmax(s, axis=-1)
        a = pr[:, :, 0] - lam * pr[:, :, 1]
        return jnp.einsum('bhqk,bhke->bhqe', a.astype(vt.dtype), vt)

    o = lax.map(one_block, (qb, jnp.arange(nb)))
    o = o.transpose(1, 0, 3, 2, 4).reshape(B, S, H, 2 * DH)
    o = rmsnorm(o, subln, SUBLN_EPS) * (1.0 - lam_init)
    return o.reshape(B, S, DIFF_WIDTH)


def hgrn2_scan(q, k, v, log_f):
    B, S, H, DK = q.shape
    DV = v.shape[-1]
    C = HGRN_CHUNK
    nc = S // C

    def to_chunks(t):
        return t.reshape(B, nc, C, H, t.shape[-1]).transpose(1, 0, 3, 2, 4)

    qc, kc, vc, gc = to_chunks(q), to_chunks(k), to_chunks(v), to_chunks(log_f)
    causal = jnp.tril(jnp.ones((C, C), dtype=bool))

    def step(state, inp):
        q_c, k_c, v_c, g_c = inp
        G = jnp.cumsum(g_c, axis=2)
        o_inter = jnp.einsum('bhtd,bhde->bhte', q_c * jnp.exp(G), state)
        diff = G[:, :, :, None, :] - G[:, :, None, :, :]
        decay = jnp.exp(jnp.where(causal[None, None, :, :, None], diff, -jnp.inf))
        A = jnp.einsum('bhtd,bhtsd,bhsd->bhts', q_c, decay, k_c)
        o_intra = jnp.einsum('bhts,bhse->bhte', A, v_c)
        G_last = G[:, :, -1, :]
        new_state = jnp.exp(G_last)[..., None] * state + jnp.einsum(
            'bhsd,bhse->bhde', k_c * jnp.exp(G_last[:, :, None, :] - G), v_c)
        return new_state, (o_inter + o_intra).astype(v.dtype)

    s0 = jnp.zeros((B, H, DK, DV), jnp.float32)
    _, oc = lax.scan(step, s0, (qc, kc, vc, gc))
    return oc.transpose(1, 0, 3, 2, 4).reshape(B, S, H, DV)


def hgrn2_mixer(h, w_in, lower_bound, norm_gain, w_out):
    B, S, _ = h.shape
    q, f, i, g = jnp.split(h @ w_in, 4, axis=-1)
    q = jax.nn.silu(q)
    ff = f.astype(jnp.float32)
    log_f = jnp.logaddexp(jnp.log(lower_bound), jnp.log1p(-lower_bound) + jax.nn.log_sigmoid(ff))
    k = -jnp.expm1(log_f)
    H = HGRN_HEADS
    o = hgrn2_scan(q.reshape(B, S, H, HGRN_DK), k.reshape(B, S, H, HGRN_DK),
                   i.reshape(B, S, H, HGRN_DV), log_f.reshape(B, S, H, HGRN_DK))
    o = rmsnorm(o, norm_gain) * jax.nn.silu(g).reshape(B, S, H, HGRN_DV)
    return o.reshape(B, S, D_MODEL) @ w_out


def setup_inputs(seed: int = 0) -> dict:
    key = jax.random.key(seed)
    ks = iter(jax.random.split(key, 40))
    f32 = jnp.float32

    def w(shape, fan_in):
        return jax.random.normal(next(ks), shape, f32) * fan_in ** -0.5

    def gain(shape):
        return 1.0 + 0.02 * jax.random.normal(next(ks), shape, f32)

    x = jax.random.normal(next(ks), (BATCH, SEQ, D_MODEL), f32)
    p = jax.random.normal(next(ks), (DEPTH, BATCH, SEQ, PLE_DIM), f32)
    offs = jax.random.randint(next(ks), (BATCH, 1), 0, 1024, dtype=jnp.int32)
    positions = (offs + jnp.arange(SEQ, dtype=jnp.int32)[None, :]).astype(jnp.int32)
    return {
        "x": x,
        "p": p,
        "positions": positions,
        "ffn1_norm": gain((DEPTH, D_MODEL)),
        "ffn1_w_gate": w((DEPTH, D_MODEL, D_FF), D_MODEL),
        "ffn1_w_up": w((DEPTH, D_MODEL, D_FF), D_MODEL),
        "ffn1_w_down": w((DEPTH, D_FF, D_MODEL), D_FF),
        "mix_norm": gain((DEPTH, D_MODEL)),
        "ffn2_norm": gain((DEPTH, D_MODEL)),
        "ffn2_w_gate": w((DEPTH, D_MODEL, D_FF), D_MODEL),
        "ffn2_w_up": w((DEPTH, D_MODEL, D_FF), D_MODEL),
        "ffn2_w_down": w((DEPTH, D_FF, D_MODEL), D_FF),
        "ple_norm": gain((DEPTH, D_MODEL)),
        "ple_w_gate": w((DEPTH, D_MODEL, D_MODEL), D_MODEL),
        "ple_w_proj": w((DEPTH, PLE_DIM, D_MODEL), PLE_DIM),
        "ab_w_in": w((N_EVEN, D_MODEL, AB_IN_WIDTH), D_MODEL),
        "pool_w": w((N_EVEN, POOL_GROUPS, POOL_GROUP_DIM, POOL_GROUP_DIM), POOL_GROUP_DIM),
        "pool_scale": gain((N_EVEN, POOL_WIDTH)),
        "diff_lambda": 0.1 * jax.random.normal(next(ks), (N_EVEN, 4, DIFF_HEAD_DIM), f32),
        "diff_subln": gain((N_EVEN, 2 * DIFF_HEAD_DIM)),
        "ab_w_out": w((N_EVEN, AB_OUT_WIDTH, D_MODEL), AB_OUT_WIDTH),
        "hgrn_w_in": w((N_ODD, D_MODEL, 4 * D_MODEL), D_MODEL),
        "hgrn_lower_bounds": 1.0 + 0.1 * jax.random.normal(next(ks), (DEPTH, D_MODEL), f32),
        "hgrn_norm": gain((N_ODD, HGRN_DV)),
        "hgrn_w_out": w((N_ODD, D_MODEL, D_MODEL), D_MODEL),
        "final_norm": gain((D_MODEL,)),
    }


def reference(x, p, positions, ffn1_norm, ffn1_w_gate, ffn1_w_up, ffn1_w_down, mix_norm,
              ffn2_norm, ffn2_w_gate, ffn2_w_up, ffn2_w_down, ple_norm, ple_w_gate, ple_w_proj,
              ab_w_in, pool_w, pool_scale, diff_lambda, diff_subln, ab_w_out,
              hgrn_w_in, hgrn_lower_bounds, hgrn_norm, hgrn_w_out, final_norm):
    cos, sin = rope_tables(positions)
    lbs = jax.nn.softmax(hgrn_lower_bounds.astype(jnp.float32), axis=0)
    lbs = jnp.cumsum(lbs, axis=0) - lbs[0]
    for i in range(DEPTH):
        x = x + 0.5 * swiglu(rmsnorm(x, ffn1_norm[i]), ffn1_w_gate[i], ffn1_w_up[i], ffn1_w_down[i])
        h = rmsnorm(x, mix_norm[i])
        if i % 2 == 0:
            e = i // 2
            proj = h @ ab_w_in[e]
            u = proj[..., :POOL_WIDTH]
            q = proj[..., POOL_WIDTH:POOL_WIDTH + DIFF_WIDTH]
            k = proj[..., POOL_WIDTH + DIFF_WIDTH:POOL_WIDTH + 2 * DIFF_WIDTH]
            v = proj[..., POOL_WIDTH + 2 * DIFF_WIDTH:]
            lam_init = 0.8 - 0.6 * math.exp(-0.3 * i)
            a_out = multiscale_pool(u, pool_w[e], pool_scale[e])
            b_out = diff_attention(q, k, v, cos, sin, diff_lambda[e], diff_subln[e], lam_init)
            mix = jnp.concatenate([a_out, b_out], axis=-1) @ ab_w_out[e]
        else:
            o = i // 2
            mix = hgrn2_mixer(h, hgrn_w_in[o], lbs[i], hgrn_norm[o], hgrn_w_out[o])
        x = x + mix.astype(x.dtype)
        x = x + 0.5 * swiglu(rmsnorm(x, ffn2_norm[i]), ffn2_w_gate[i], ffn2_w_up[i], ffn2_w_down[i])
        gate = jax.nn.sigmoid(rmsnorm(x, ple_norm[i]) @ ple_w_gate[i])
        x = x + (p[i] @ ple_w_proj[i]) * gate
    return rmsnorm(x, final_norm)
```

```cpp
#include <hip/hip_runtime.h>
#include <hip/hip_bf16.h>
#include <hip/hip_cooperative_groups.h>
#include <cstdio>
#include <cstdint>
namespace cg = cooperative_groups;
__device__ __forceinline__ int otid() { int t = threadIdx.x; asm volatile("" : "+v"(t)); return t; }

namespace pg8 {
#define PG8_LAS __attribute__((address_space(3)))
typedef unsigned short bf16_t;
typedef short bf16x8 __attribute__((ext_vector_type(8)));
typedef float f32x4 __attribute__((ext_vector_type(4)));
typedef unsigned u32x4 __attribute__((ext_vector_type(4)));
typedef unsigned u32x2 __attribute__((ext_vector_type(2)));
constexpr int BM = 256, BK = 64, HALF = 128, HTB = HALF * BK * 2, STAGE_BYTES = 8 * HTB, NXCD = 8, WGM = 8;

__host__ __device__ __forceinline__ int lds_byte(int r, int c) { const int st = (r >> 4) * 2 + (c >> 5), rr = r & 15, cc = c & 31, ob = rr * 64 + cc * 2; return st * 1024 + (ob ^ (((ob >> 9) & 1) << 5)); }
__host__ __device__ __forceinline__ void stage_rc(int b, int& R, int& C) { const int st = b / 1024, sb = b % 1024, swz = sb ^ (((sb >> 9) & 1) << 5); R = (st >> 1) * 16 + swz / 64; C = (st & 1) * 32 + (swz % 64) / 2; }
__host__ __device__ __forceinline__ int perm32(int rho) { const int n = rho >> 4, i = rho & 15; return 8 * (i >> 2) + 4 * n + (i & 3); }

struct Unit { int pm, pn; };
struct Gemm { const bf16_t* A; const bf16_t* Bt; int M, N, K, lda, ldb; size_t apn; };

struct StaticOrder {
    int nM, nN, nwg, G, c;
    __host__ __device__ void init(int M, int N, int G_, int c_) { nM = M / BM; nN = N / BM; nwg = nM * nN; G = G_; c = c_; }
    __host__ __device__ bool next(int i, Unit& u) const {
        const long L = (long)i * G + c; if (L >= nwg) return false;
        int wgid = (int)L; { const int q = nwg / NXCD, r = nwg % NXCD, xcd = wgid % NXCD, off = wgid / NXCD; wgid = (xcd < r ? xcd * (q + 1) : r * (q + 1) + (xcd - r) * q) + off; }
        const int nig = WGM * nN, gid = wgid / nig, fm = gid * WGM, gsz = (nM - fm) < WGM ? (nM - fm) : WGM;
        u.pm = fm + ((wgid % nig) % gsz); u.pn = (wgid % nig) / gsz; return true;
    }
    __device__ __forceinline__ void a_ready(const Unit&) const {}
    __device__ __forceinline__ void done(const Unit&) const {}
};

__device__ __forceinline__ unsigned cvt_pk_bf16(float lo, float hi) { unsigned r; asm volatile("v_cvt_pk_bf16_f32 %0, %1, %2" : "=v"(r) : "v"(lo), "v"(hi)); return r; }
__device__ __forceinline__ float fsigmoid(float v) { return __builtin_amdgcn_rcpf(1.0f + __builtin_amdgcn_exp2f(-1.4426950408889634f * v)); }
__device__ __forceinline__ float fsilu(float v) { return v * fsigmoid(v); }


struct EpiSwiGLU {
    static constexpr bool PERM = true, AFTER_DRAIN = false, HAS_PRE = true;
    __device__ __forceinline__ void prefetch(const Unit& u, float (&pre)[2][4], int wr, int fr) const {
        const unsigned long long* sp = ssin + u.pm * BM + wr * 64 + fr;
#pragma unroll
        for (int ai = 0; ai < 2; ++ai)
#pragma unroll
            for (int m = 0; m < 4; ++m) pre[ai][m] = (float)sp[ai * HALF + m * 16] * (1.f / 1048576.f);
    }

    bf16_t* O; int ldc; const unsigned long long* ssin;
    __device__ __forceinline__ void operator()(const f32x4 (&acc)[2][2][4][2], const Unit& u, int wr, int wc, int fr_, int fq, const float (&pre)[2][4]) const {
        int fr = fr_; asm volatile("" : "+v"(fr));
        const int row0 = u.pm * BM + wr * 64 + fr, col0 = u.pn * HALF + wc * 32 + 8 * fq;
        float rs[2][4];
#pragma unroll
        for (int ai = 0; ai < 2; ++ai)
#pragma unroll
            for (int m = 0; m < 4; ++m) rs[ai][m] = rsqrtf(pre[ai][m] * (1.f / 2048.f) + 1e-6f);
#pragma unroll
        for (int ai = 0; ai < 2; ++ai)
#pragma unroll
            for (int m = 0; m < 4; ++m) { bf16_t* rowp = O + (size_t)(row0 + ai * HALF + m * 16) * ldc + col0; const float r = rs[ai][m];
                f32x4 g0 = acc[ai][0][m][0] * r, g1 = acc[ai][0][m][1] * r, u0 = acc[ai][1][m][0] * r, u1 = acc[ai][1][m][1] * r;
                f32x4 v0, v1;
#pragma unroll
                for (int i = 0; i < 4; ++i) { v0[i] = fsilu(g0[i]) * u0[i]; v1[i] = fsilu(g1[i]) * u1[i]; }
                u32x4 w; w.x = cvt_pk_bf16(v0[0], v0[1]); w.y = cvt_pk_bf16(v0[2], v0[3]); w.z = cvt_pk_bf16(v1[0], v1[1]); w.w = cvt_pk_bf16(v1[2], v1[3]);
                *(u32x4*)rowp = w; asm volatile("" ::: "memory"); }
    }
};
template <int MODE> struct EpiF32 {
    static constexpr bool PERM = true, AFTER_DRAIN = false, HAS_PRE = (MODE == 1);
    __device__ __forceinline__ void prefetch(const Unit& u, float (&pre)[2][4], int wr, int fr) const {
        const unsigned long long* sp = ((const unsigned long long*)(wsb + 131072) + 8192 * slot_in) + u.pm * BM + wr * 64 + fr;
#pragma unroll
        for (int ai = 0; ai < 2; ++ai)
#pragma unroll
            for (int m = 0; m < 4; ++m) pre[ai][m] = (float)sp[ai * HALF + m * 16] * (1.f / 1048576.f);
    }
    const float* basef; const bf16_t* baseb; float* outf; bf16_t* outb; const bf16_t* pe; unsigned char* wsb; int full, slot_out, slot_in;
    static constexpr int ldc = 2048;
    __device__ __forceinline__ void operator()(const f32x4 (&acc)[2][2][4][2], const Unit& u, int wr, int wc, int fr_, int fq, const float (&pre)[2][4]) const {
        int fr = fr_; asm volatile("" : "+v"(fr));
        const int row0 = u.pm * BM + wr * 64 + fr, col0 = u.pn * BM + wc * 32 + 8 * fq;
        const float scale = full ? 1.f : 0.5f;
        unsigned long long* ssout = (unsigned long long*)(wsb + 131072) + 8192 * slot_out;
        float rs[2][4];
        if (MODE == 1) {
#pragma unroll
            for (int ai = 0; ai < 2; ++ai)
#pragma unroll
                for (int m = 0; m < 4; ++m) rs[ai][m] = rsqrtf(pre[ai][m] * (1.f / 2048.f) + 1e-6f);
        }
        constexpr int MB = (MODE == 1) ? 2 : 4;
#pragma unroll
        for (int ai = 0; ai < 2; ++ai)
#pragma unroll
        for (int m0 = 0; m0 < 4; m0 += MB) {
            u32x4 bw[MB][2], pw[MB][2];
            if (MODE != 2) {
#pragma unroll
                for (int mm = 0; mm < MB; ++mm)
#pragma unroll
                    for (int bj = 0; bj < 2; ++bj) { const size_t o2 = (size_t)(row0 + ai * HALF + (m0 + mm) * 16) * ldc + col0 + bj * HALF;
                        if (!(MODE == 0 && basef)) bw[mm][bj] = *(const u32x4*)(baseb + o2);
                        if (MODE == 1) pw[mm][bj] = *(const u32x4*)(pe + o2); }
            }
#pragma unroll
            for (int mm = 0; mm < MB; ++mm) { const int m = m0 + mm, row = row0 + ai * HALF + m * 16; float ssq = 0.f;
#pragma unroll
                for (int bj = 0; bj < 2; ++bj) { const size_t o2 = (size_t)row * ldc + col0 + bj * HALF; const f32x4 a0 = acc[ai][bj][m][0], a1 = acc[ai][bj][m][1]; f32x4 r0, r1, b0, b1;
                    if (MODE != 2) {
                        if (MODE == 0 && basef) { b0 = *(const f32x4*)(basef + o2); b1 = *(const f32x4*)(basef + o2 + 4); }
                        else { const u32x4 w = bw[mm][bj];
                            b0 = (f32x4){__uint_as_float(w.x << 16), __uint_as_float(w.x & 0xffff0000u), __uint_as_float(w.y << 16), __uint_as_float(w.y & 0xffff0000u)};
                            b1 = (f32x4){__uint_as_float(w.z << 16), __uint_as_float(w.z & 0xffff0000u), __uint_as_float(w.w << 16), __uint_as_float(w.w & 0xffff0000u)}; } }
                    if (MODE == 0) { r0 = b0 + a0 * scale; r1 = b1 + a1 * scale; }
                    else if (MODE == 1) { const u32x4 w = pw[mm][bj]; const float rr = rs[ai][m];
                        const f32x4 p0 = (f32x4){__uint_as_float(w.x << 16), __uint_as_float(w.x & 0xffff0000u), __uint_as_float(w.y << 16), __uint_as_float(w.y & 0xffff0000u)};
                        const f32x4 p1 = (f32x4){__uint_as_float(w.z << 16), __uint_as_float(w.z & 0xffff0000u), __uint_as_float(w.w << 16), __uint_as_float(w.w & 0xffff0000u)};
#pragma unroll
                        for (int i = 0; i < 4; ++i) { r0[i] = b0[i] + p0[i] * fsigmoid(a0[i] * rr); r1[i] = b1[i] + p1[i] * fsigmoid(a1[i] * rr); } }
                    else { r0 = a0; r1 = a1; }
                    if (MODE == 1 && outf) { *(f32x4*)(outf + o2) = r0; *(f32x4*)(outf + o2 + 4) = r1; }
                    else { u32x4 w; w.x = cvt_pk_bf16(r0[0], r0[1]); w.y = cvt_pk_bf16(r0[2], r0[3]); w.z = cvt_pk_bf16(r1[0], r1[1]); w.w = cvt_pk_bf16(r1[2], r1[3]); *(u32x4*)(outb + o2) = w; }
                    if (MODE != 2) ssq += ((r0[0] * r0[0] + r0[1] * r0[1]) + (r0[2] * r0[2] + r0[3] * r0[3])) + ((r1[0] * r1[0] + r1[1] * r1[1]) + (r1[2] * r1[2] + r1[3] * r1[3])); }
                if (MODE != 2) { ssq += __shfl_xor(ssq, 16); ssq += __shfl_xor(ssq, 32); if (fq == 0) __hip_atomic_fetch_add(ssout + row, (unsigned long long)(ssq * 1048576.f + 0.5f), __ATOMIC_RELAXED, __HIP_MEMORY_SCOPE_AGENT); } }
            asm volatile("" ::: "memory"); }
    }
};
struct EpiPool {
    static constexpr bool PERM = true, AFTER_DRAIN = false, HAS_PRE = false;
    bf16_t* O; int ldc; const float* cs;
    __device__ __forceinline__ void operator()(const f32x4 (&acc)[2][2][4][2], const Unit& u, int wr, int wc, int fr_, int fq, const float (&pre)[2][4]) const {
        int fr = fr_; asm volatile("" : "+v"(fr));
        const int row0 = u.pm * BM + wr * 64 + fr, col0 = u.pn * BM + wc * 32 + 8 * fq;
#pragma unroll
        for (int bj = 0; bj < 2; ++bj) { const f32x4 s0 = *(const f32x4*)(cs + col0 + bj * HALF), s1 = *(const f32x4*)(cs + col0 + bj * HALF + 4);
#pragma unroll
            for (int ai = 0; ai < 2; ++ai)
#pragma unroll
                for (int m = 0; m < 4; ++m) { bf16_t* rowp = O + (size_t)(row0 + ai * HALF + m * 16) * ldc + col0 + bj * HALF;
                    const f32x4 v0 = acc[ai][bj][m][0] * s0, v1 = acc[ai][bj][m][1] * s1;
                    u32x4 w; w.x = cvt_pk_bf16(v0[0], v0[1]); w.y = cvt_pk_bf16(v0[2], v0[3]); w.z = cvt_pk_bf16(v1[0], v1[1]); w.w = cvt_pk_bf16(v1[2], v1[3]);
                    *(u32x4*)rowp = w; asm volatile("" ::: "memory"); } }
    }
};
struct EpiABin {
    static constexpr bool PERM = true, AFTER_DRAIN = false, HAS_PRE = true;
    __device__ __forceinline__ void prefetch(const Unit& u, float (&pre)[2][4], int wr, int fr) const {
        const unsigned long long* sp = ssin + u.pm * BM + wr * 64 + fr;
#pragma unroll
        for (int ai = 0; ai < 2; ++ai)
#pragma unroll
            for (int m = 0; m < 4; ++m) pre[ai][m] = (float)sp[ai * HALF + m * 16] * (1.f / 1048576.f);
    }

    float* U; bf16_t* Qh; const float* rope; const unsigned long long* ssin;
    __device__ __forceinline__ void operator()(const f32x4 (&acc)[2][2][4][2], const Unit& u, int wr, int wc, int fr_, int fq, const float (&pre)[2][4]) const {
        int fr = fr_; asm volatile("" : "+v"(fr));
        const int row0 = u.pm * BM + wr * 64 + fr;
        float rs[2][4];
#pragma unroll
        for (int ai = 0; ai < 2; ++ai)
#pragma unroll
            for (int m = 0; m < 4; ++m) rs[ai][m] = rsqrtf(pre[ai][m] * (1.f / 2048.f) + 1e-6f);
        if (u.pn < 4) {
            const int col0 = u.pn * BM + wc * 32 + 8 * fq;
#pragma unroll
            for (int ai = 0; ai < 2; ++ai)
#pragma unroll
                for (int m = 0; m < 4; ++m) { float* rowp = U + (size_t)(row0 + ai * HALF + m * 16) * 1024 + col0; const float r = rs[ai][m];
#pragma unroll
                    for (int bj = 0; bj < 2; ++bj) { *(f32x4*)(rowp + bj * HALF) = acc[ai][bj][m][0] * r; *(f32x4*)(rowp + bj * HALF + 4) = acc[ai][bj][m][1] * r; } }
            return;
        }
        const int kind = u.pn >> 2, h = u.pn & 3, b = u.pm >> 4;
        bf16_t* dst = Qh + (size_t)(kind - 1) * 8388608;
        const bool do_rope = (kind != 3) && (wc == 0);
#pragma unroll
        for (int ai = 0; ai < 2; ++ai)
#pragma unroll
            for (int m = 0; m < 4; ++m) { const int row = row0 + ai * HALF + m * 16, s = row & 4095;
                f32x4 c0, c1, s0, s1;
                if (do_rope) { const float* rp = rope + (size_t)row * 32 + 8 * (fq & 1); c0 = *(const f32x4*)rp; c1 = *(const f32x4*)(rp + 4); s0 = *(const f32x4*)(rp + 16); s1 = *(const f32x4*)(rp + 20); }
#pragma unroll
                for (int bj = 0; bj < 2; ++bj) { f32x4 v0 = acc[ai][bj][m][0] * rs[ai][m], v1 = acc[ai][bj][m][1] * rs[ai][m];
                    if (do_rope) {
#pragma unroll
                        for (int i = 0; i < 4; ++i) { const float p0 = __shfl_xor(v0[i], 32), p1 = __shfl_xor(v1[i], 32);
                            v0[i] = (fq < 2) ? (v0[i] * c0[i] - p0 * s0[i]) : (v0[i] * c0[i] + p0 * s0[i]);
                            v1[i] = (fq < 2) ? (v1[i] * c1[i] - p1 * s1[i]) : (v1[i] * c1[i] + p1 * s1[i]); } }
                    bf16_t* p = dst + ((size_t)(((b * 4 + h) * 2 + bj) * 4096 + s)) * 128 + wc * 32 + 8 * fq;
                    u32x4 w; w.x = cvt_pk_bf16(v0[0], v0[1]); w.y = cvt_pk_bf16(v0[2], v0[3]); w.z = cvt_pk_bf16(v1[0], v1[1]); w.w = cvt_pk_bf16(v1[2], v1[3]);
                    *(u32x4*)p = w; }
                asm volatile("" ::: "memory"); }
    }
};
struct EpiHin {
    static constexpr bool PERM = true, AFTER_DRAIN = false, HAS_PRE = true;
    __device__ __forceinline__ void prefetch(const Unit& u, float (&pre)[2][4], int wr, int fr) const {
        const unsigned long long* sp = ssin + u.pm * BM + wr * 64 + fr;
#pragma unroll
        for (int ai = 0; ai < 2; ++ai)
#pragma unroll
            for (int m = 0; m < 4; ++m) pre[ai][m] = (float)sp[ai * HALF + m * 16] * (1.f / 1048576.f);
    }

    bf16_t* Qs; float* LF; const float* lbs; const unsigned long long* ssin;
    __device__ __forceinline__ void operator()(const f32x4 (&acc)[2][2][4][2], const Unit& u, int wr, int wc, int fr_, int fq, const float (&pre)[2][4]) const {
        int fr = fr_; asm volatile("" : "+v"(fr));
        const int row0 = u.pm * BM + wr * 64 + fr, split = u.pn >> 3, col0 = (u.pn & 7) * BM + wc * 32 + 8 * fq;
        bf16_t* dst = Qs + (size_t)split * 16777216;
        float rs[2][4];
#pragma unroll
        for (int ai = 0; ai < 2; ++ai)
#pragma unroll
            for (int m = 0; m < 4; ++m) rs[ai][m] = rsqrtf(pre[ai][m] * (1.f / 2048.f) + 1e-6f);
#pragma unroll
        for (int bj = 0; bj < 2; ++bj) {
            f32x4 l0 = {0.f, 0.f, 0.f, 0.f}, l1 = l0;
            if (split == 1) { l0 = *(const f32x4*)(lbs + col0 + bj * HALF); l1 = *(const f32x4*)(lbs + col0 + bj * HALF + 4); }
#pragma unroll
            for (int ai = 0; ai < 2; ++ai)
#pragma unroll
                for (int m = 0; m < 4; ++m) { const size_t off = (size_t)(row0 + ai * HALF + m * 16) * 2048 + col0 + bj * HALF;
                    f32x4 v0 = acc[ai][bj][m][0] * rs[ai][m], v1 = acc[ai][bj][m][1] * rs[ai][m];
                    if (split == 0 || split == 3) {
#pragma unroll
                        for (int i = 0; i < 4; ++i) { v0[i] = fsilu(v0[i]); v1[i] = fsilu(v1[i]); }
                    } else if (split == 1) { f32x4 f0, f1;
#pragma unroll
                        for (int i = 0; i < 4; ++i) { const float sg0 = fsigmoid(v0[i]), sg1 = fsigmoid(v1[i]);
                            f0[i] = __logf(l0[i] + (1.f - l0[i]) * sg0); f1[i] = __logf(l1[i] + (1.f - l1[i]) * sg1);
                            v0[i] = (1.f - l0[i]) * fsigmoid(-v0[i]); v1[i] = (1.f - l1[i]) * fsigmoid(-v1[i]); }
                        *(f32x4*)(LF + off) = f0; *(f32x4*)(LF + off + 4) = f1; }
                    u32x4 w; w.x = cvt_pk_bf16(v0[0], v0[1]); w.y = cvt_pk_bf16(v0[2], v0[3]); w.z = cvt_pk_bf16(v1[0], v1[1]); w.w = cvt_pk_bf16(v1[2], v1[3]);
                    *(u32x4*)(dst + off) = w; asm volatile("" ::: "memory"); } }
    }
};

template <class Epi, class Sched, bool ALIGN_EPI = false, bool SP2 = false>
__device__ __forceinline__ void gemm_phase(PG8_LAS unsigned char* lds, const Gemm g, const Sched& S, const Epi& E) {
    const int tid = otid(), wid = __builtin_amdgcn_readfirstlane(tid >> 6), lane = tid & 63, wr = wid >> 2, wc = wid & 3, fr = lane & 15, fq = lane >> 4;
    const int K = g.K, nt = K / BK;
    unsigned voffA[2], voffB[2];
#pragma unroll
    for (int i = 0; i < 2; ++i) { int R, C; stage_rc(tid * 16 + i * 8192, R, C); const int Rb = Epi::PERM ? ((R & ~31) + perm32(R & 31)) : R;
        voffA[i] = (unsigned)(R * g.lda + C) * 2u; voffB[i] = (unsigned)(Rb * g.ldb + C) * 2u; }
    const size_t kstep = (size_t)(BK * 2);
    const size_t hstepA = (size_t)HALF * g.lda * 2, hstepB = (size_t)HALF * g.ldb * 2;
    const size_t tstepA = 2 * hstepA, tstepB = 2 * hstepB;
    const unsigned ldsw = (unsigned)wid * 1024u;
    const int aoff = lds_byte(wr * 64 + fr, fq * 8), boff = lds_byte(wc * 32 + fr, fq * 8);
#define PG8_SA(b, h) (((b) * 2 + (h)) * HTB)
#define PG8_SB(b, h) ((4 + (b) * 2 + (h)) * HTB)
#define PG8_STAGE(bufoff, gbase, voff) do { _Pragma("unroll") for (int _i = 0; _i < 2; ++_i) \
        __builtin_amdgcn_global_load_lds((const unsigned*)((const char*)(gbase) + (voff)[_i]), (PG8_LAS unsigned*)(lds + (bufoff) + ldsw + _i * 8192), 16, 0, 0); } while (0)
#define PG8_LDA(dst, b, h) do { _Pragma("unroll") for (int m = 0; m < 4; ++m) _Pragma("unroll") for (int k = 0; k < 2; ++k) dst[m][k] = *(const PG8_LAS bf16x8*)(lds + PG8_SA(b, h) + aoff + m * 2048 + k * 1024); } while (0)
#define PG8_LDB(dst, b, h) do { _Pragma("unroll") for (int n = 0; n < 2; ++n) _Pragma("unroll") for (int k = 0; k < 2; ++k) dst[n][k] = *(const PG8_LAS bf16x8*)(lds + PG8_SB(b, h) + boff + n * 2048 + k * 1024); } while (0)
#define PG8_MMA(ai, bj, At, Bt) do { __builtin_amdgcn_s_setprio(1); _Pragma("unroll") for (int m = 0; m < 4; ++m) _Pragma("unroll") for (int n = 0; n < 2; ++n) _Pragma("unroll") for (int k = 0; k < 2; ++k) \
        acc[ai][bj][m][n] = __builtin_amdgcn_mfma_f32_16x16x32_bf16(Bt[n][k], At[m][k], acc[ai][bj][m][n], 0, 0, 0); __builtin_amdgcn_s_setprio(0); } while (0)
#define PG8_WAIT_V(n) asm volatile("s_waitcnt vmcnt(" #n ")" ::: "memory")
#define PG8_WAIT_L(n) asm volatile("s_waitcnt lgkmcnt(" #n ")" ::: "memory")
#define PG8_BAR __builtin_amdgcn_s_barrier()
#define PG8_SCHED __builtin_amdgcn_sched_barrier(0)
    Unit cur, nxt; int ui = 0;
    if (!S.next(0, cur)) return;
    float pre[2][4] = {{0.f, 0.f, 0.f, 0.f}, {0.f, 0.f, 0.f, 0.f}};
    f32x4 acc[2][2][4][2];
#pragma unroll
    for (int a = 0; a < 2; ++a)
#pragma unroll
        for (int b = 0; b < 2; ++b)
#pragma unroll
            for (int m = 0; m < 4; ++m)
#pragma unroll
                for (int n = 0; n < 2; ++n) acc[a][b][m][n] = (f32x4){0.f, 0.f, 0.f, 0.f};
    bf16x8 At[4][2], B0[2][2], B1[2][2];
    const char* cA = (const char*)g.A + (size_t)cur.pm * tstepA + (size_t)cur.pn * g.apn; const char* cB = (const char*)g.Bt + (size_t)cur.pn * tstepB;
    S.a_ready(cur);
    if constexpr (SP2) {
        PG8_STAGE(PG8_SB(0, 0), cB, voffB); PG8_STAGE(PG8_SB(0, 1), cB + hstepB, voffB); PG8_STAGE(PG8_SA(0, 0), cA, voffA); PG8_STAGE(PG8_SA(0, 1), cA + hstepA, voffA);
        if (wr == 1) PG8_BAR;
        PG8_WAIT_V(2); PG8_BAR;
        PG8_STAGE(PG8_SB(1, 0), cB + kstep, voffB); PG8_STAGE(PG8_SA(1, 0), cA + kstep, voffA); PG8_STAGE(PG8_SB(1, 1), cB + hstepB + kstep, voffB);
        PG8_WAIT_V(6); PG8_BAR;
    } else {
        PG8_STAGE(PG8_SB(0, 0), cB, voffB); PG8_STAGE(PG8_SA(0, 0), cA, voffA); PG8_STAGE(PG8_SB(0, 1), cB + hstepB, voffB); PG8_STAGE(PG8_SA(0, 1), cA + hstepA, voffA);
        if (wr == 1) PG8_BAR;
        PG8_WAIT_V(4); PG8_BAR;
        PG8_STAGE(PG8_SB(1, 0), cB + kstep, voffB); PG8_STAGE(PG8_SA(1, 0), cA + kstep, voffA); PG8_STAGE(PG8_SB(1, 1), cB + hstepB + kstep, voffB);
        PG8_WAIT_V(6); PG8_BAR;
    }
    for (;;) {
        const bool has_next = S.next(ui + 1, nxt);
        const char* nA = has_next ? (const char*)g.A + (size_t)nxt.pm * tstepA + (size_t)nxt.pn * g.apn : cA; const char* nB = has_next ? (const char*)g.Bt + (size_t)nxt.pn * tstepB : cB;
        for (int t = 0; t < nt; t += 2) {
            const bool last = (t == nt - 2);
            const char* a1 = cA + (size_t)(t + 1) * kstep;
            const char* a2 = last ? nA : cA + (size_t)(t + 2) * kstep; const char* b2 = last ? nB : cB + (size_t)(t + 2) * kstep;
            const char* a3 = a2 + kstep; const char* b3 = b2 + kstep;
            if (last && has_next) S.a_ready(nxt);
            if constexpr (Epi::HAS_PRE) { if (last) E.prefetch(cur, pre, wr, fr); }
            if constexpr (SP2) {
            PG8_LDB(B0, 0, 0); PG8_LDB(B1, 0, 1); PG8_SCHED; PG8_LDA(At, 0, 0); PG8_STAGE(PG8_SA(1, 1), a1 + hstepA, voffA);
            PG8_WAIT_V(8); PG8_WAIT_L(0); PG8_BAR; PG8_MMA(0, 0, At, B0); PG8_MMA(0, 1, At, B1); PG8_BAR; PG8_SCHED;
            PG8_LDA(At, 0, 1); PG8_STAGE(PG8_SB(0, 0), b2, voffB); PG8_STAGE(PG8_SB(0, 1), b2 + hstepB, voffB); PG8_STAGE(PG8_SA(0, 0), a2, voffA);
            PG8_WAIT_V(8); PG8_WAIT_L(0); PG8_BAR; PG8_MMA(1, 0, At, B0); PG8_MMA(1, 1, At, B1); PG8_BAR; PG8_SCHED;
            PG8_LDB(B0, 1, 0); PG8_LDB(B1, 1, 1); PG8_SCHED; PG8_LDA(At, 1, 0); PG8_STAGE(PG8_SA(0, 1), a2 + hstepA, voffA);
            PG8_WAIT_V(8); PG8_WAIT_L(0); PG8_BAR; PG8_MMA(0, 0, At, B0); PG8_MMA(0, 1, At, B1); PG8_BAR; PG8_SCHED;
            PG8_LDA(At, 1, 1); PG8_STAGE(PG8_SB(1, 0), b3, voffB); PG8_STAGE(PG8_SB(1, 1), b3 + hstepB, voffB); PG8_STAGE(PG8_SA(1, 0), a3, voffA);
            PG8_WAIT_V(8); PG8_WAIT_L(0); PG8_BAR; PG8_MMA(1, 0, At, B0); PG8_MMA(1, 1, At, B1); PG8_BAR; PG8_SCHED;
            } else {
            PG8_LDB(B0, 0, 0); PG8_SCHED; PG8_LDA(At, 0, 0); PG8_STAGE(PG8_SA(1, 1), a1 + hstepA, voffA);
            PG8_WAIT_L(8); PG8_BAR; PG8_WAIT_L(0); PG8_MMA(0, 0, At, B0); PG8_BAR; PG8_SCHED;
            PG8_LDB(B1, 0, 1); PG8_STAGE(PG8_SB(0, 0), b2, voffB);
            PG8_BAR; PG8_WAIT_L(0); PG8_MMA(0, 1, At, B1); PG8_BAR;
            PG8_LDA(At, 0, 1); PG8_STAGE(PG8_SA(0, 0), a2, voffA);
            PG8_BAR; PG8_WAIT_L(0); PG8_MMA(1, 0, At, B0); PG8_BAR; PG8_SCHED;
            PG8_STAGE(PG8_SB(0, 1), b2 + hstepB, voffB);
            PG8_WAIT_V(6); PG8_BAR; PG8_MMA(1, 1, At, B1); PG8_BAR;
            PG8_LDB(B0, 1, 0); PG8_SCHED; PG8_LDA(At, 1, 0); PG8_STAGE(PG8_SA(0, 1), a2 + hstepA, voffA);
            PG8_WAIT_L(8); PG8_BAR; PG8_WAIT_L(0); PG8_MMA(0, 0, At, B0); PG8_BAR; PG8_SCHED;
            PG8_LDB(B1, 1, 1); PG8_STAGE(PG8_SB(1, 0), b3, voffB);
            PG8_BAR; PG8_WAIT_L(0); PG8_MMA(0, 1, At, B1); PG8_BAR;
            PG8_LDA(At, 1, 1); PG8_STAGE(PG8_SA(1, 0), a3, voffA);
            PG8_BAR; PG8_WAIT_L(0); PG8_MMA(1, 0, At, B0); PG8_BAR; PG8_SCHED;
            PG8_STAGE(PG8_SB(1, 1), b3 + hstepB, voffB);
            PG8_WAIT_V(6); PG8_BAR; PG8_MMA(1, 1, At, B1); PG8_BAR;
            }
        }
        if constexpr (ALIGN_EPI) { if (wr == 0) PG8_BAR; }
        if constexpr (!Epi::AFTER_DRAIN) { E(acc, cur, wr, wc, fr, fq, pre); S.done(cur); }
        if (!has_next) break;
#pragma unroll
        for (int a = 0; a < 2; ++a)
#pragma unroll
            for (int b = 0; b < 2; ++b)
#pragma unroll
                for (int m = 0; m < 4; ++m)
#pragma unroll
                    for (int n = 0; n < 2; ++n) acc[a][b][m][n] = (f32x4){0.f, 0.f, 0.f, 0.f};
        cur = nxt; cA = nA; cB = nB; ++ui;
        if constexpr (ALIGN_EPI) { if (wr == 1) PG8_BAR; }
    }
    PG8_WAIT_V(0);
    if constexpr (!ALIGN_EPI) { if (wr == 0) PG8_BAR; }
    PG8_BAR;
    if constexpr (Epi::AFTER_DRAIN) { E.fused(acc, cur, wr, wc, fr, fq, lds, wid, lane); S.done(cur); }
#undef PG8_SA
#undef PG8_SB
#undef PG8_STAGE
#undef PG8_LDA
#undef PG8_LDB
#undef PG8_MMA
#undef PG8_WAIT_V
#undef PG8_WAIT_L
#undef PG8_BAR
#undef PG8_SCHED
}
}

namespace attn {
constexpr int D = 128;
constexpr float THR = 8.f;
constexpr bool WSKIP = false;
constexpr float SCALE = 0.08838834764831845f;
constexpr int NW = 8, QBLK = 32, KVBLK = 64, QB = NW * QBLK;
constexpr int SHM_V = KVBLK * D * 2, SHM_K = KVBLK * D * 2;
constexpr int LDS_BYTES = 2 * SHM_V + 2 * SHM_K + NW * 64 * 4;
using bf16 = __hip_bfloat16;
typedef short bf16x8 __attribute__((ext_vector_type(8)));
typedef short s16x4 __attribute__((ext_vector_type(4)));
typedef float f32x16 __attribute__((ext_vector_type(16)));
typedef float f32x4 __attribute__((ext_vector_type(4)));
typedef unsigned u32x4 __attribute__((ext_vector_type(4)));
template <class A, class Bt> struct same_t { static constexpr bool v = false; };
template <class A> struct same_t<A, A> { static constexpr bool v = true; };

#define KSWZ(row, colB) ((row) * 256 + ((colB) ^ (((row) & 7) << 4)))
#define SBAR() __builtin_amdgcn_sched_barrier(0)
__device__ __forceinline__ int v_st(int k, int c) { const int kk = (k & ~0xC) | ((k & 4) << 1) | ((k & 8) >> 1); return ((kk >> 3) * 4 + (c >> 5)) * 512 + ((kk & 7) * 32 + (c & 31)) * 2; }
__device__ __forceinline__ int v_rd_base(int lane) { return ((lane & 3) << 3) | (((lane >> 2) & 3) << 6) | (((lane >> 4) & 1) << 5) | (((lane >> 5) & 1) << 8); }
constexpr int v_rd_off(int d0, int ks, int half) { return d0 * 512 + ks * 4096 + half * 2048; }
__device__ __forceinline__ int crow(int r, int hi) { return (r & 3) + 8 * (r >> 2) + 4 * hi; }
__device__ __forceinline__ unsigned cvtpk(float lo, float hi) {
    unsigned r; asm volatile("v_cvt_pk_bf16_f32 %0, %1, %2" : "=v"(r) : "v"(lo), "v"(hi)); return r;
}
__device__ __forceinline__ bf16x8 pack8(f32x4 a, f32x4 b) {
    u32x4 w = {cvtpk(a[0], a[1]), cvtpk(a[2], a[3]), cvtpk(b[0], b[1]), cvtpk(b[2], b[3])};
    return *reinterpret_cast<bf16x8*>(&w);
}
template <class T> __device__ __forceinline__ bf16x8 load8(const T* p) {
    if constexpr (same_t<T, float>::v) { return pack8(*(const f32x4*)p, *(const f32x4*)(p + 4)); }
    else { return *reinterpret_cast<const bf16x8*>(p); }
}
__device__ __forceinline__ void mask_tile(f32x16& p0, f32x16& p1, int dq, unsigned W) {
    const float NEG = -__builtin_inff();
#pragma unroll
    for (int r = 0; r < 16; ++r) {
        const int c = (r & 3) + 8 * (r >> 2);
        if ((unsigned)(dq - c) >= W) p0[r] = NEG;
        if ((unsigned)(dq - c - 32) >= W) p1[r] = NEG;
    }
}
__device__ __forceinline__ void partialSM(f32x16& p0, f32x16& p1, float& m_reg, float& mn, float& alpha) {
    float pmax = p0[0]; for (int r = 1; r < 16; ++r) pmax = fmaxf(pmax, p0[r]); for (int r = 0; r < 16; ++r) pmax = fmaxf(pmax, p1[r]);
    { auto rr = __builtin_amdgcn_permlane32_swap(__float_as_uint(pmax), __float_as_uint(pmax), false, false);
      pmax = fmaxf(__uint_as_float(rr[0]), __uint_as_float(rr[1])); }
    constexpr float C2 = 1.4426950408889634f * SCALE;
    if (__builtin_expect(__all((pmax - m_reg) * SCALE <= THR), 1)) { mn = m_reg; alpha = 1.f; }
    else { mn = fmaxf(m_reg, pmax); alpha = __builtin_amdgcn_exp2f((m_reg - mn) * C2); m_reg = mn; }
    const float mnL = -mn * C2;
    for (int r = 0; r < 16; ++r) p0[r] = fmaf(p0[r], C2, mnL); for (int r = 0; r < 16; ++r) p1[r] = fmaf(p1[r], C2, mnL);
    for (int r = 0; r < 16; ++r) p0[r] = __builtin_amdgcn_exp2f(p0[r]);
}
__device__ __forceinline__ void finishSM(f32x16& p0, f32x16& p1, float alpha, float& l_reg, bf16x8& pa0, bf16x8& pa1, bf16x8& pa2, bf16x8& pa3) {
    for (int r = 0; r < 16; ++r) p1[r] = __builtin_amdgcn_exp2f(p1[r]);
    float ps = 0; for (int r = 0; r < 16; ++r) ps += p0[r]; for (int r = 0; r < 16; ++r) ps += p1[r];
    { auto rr = __builtin_amdgcn_permlane32_swap(__float_as_uint(ps), __float_as_uint(ps), false, false);
      ps = __uint_as_float(rr[0]) + __uint_as_float(rr[1]); }
    l_reg = l_reg * alpha + ps;
#define PK4(P, B_, OUT) do { unsigned a0 = cvtpk(P[B_+0], P[B_+1]), a1 = cvtpk(P[B_+2], P[B_+3]);                          \
        unsigned b0 = cvtpk(P[B_+4], P[B_+5]), b1 = cvtpk(P[B_+6], P[B_+7]);                                             \
        auto r0 = __builtin_amdgcn_permlane32_swap(a0, b0, false, false); auto r1 = __builtin_amdgcn_permlane32_swap(a1, b1, false, false); \
        u32x4 w = {r0[0], r1[0], r0[1], r1[1]}; OUT = *reinterpret_cast<bf16x8*>(&w); } while (0)
    PK4(p0, 0, pa0); PK4(p0, 8, pa1); PK4(p1, 0, pa2); PK4(p1, 8, pa3);
#undef PK4
}
template <int KB, bool SK>
__device__ __forceinline__ void qkt(f32x16& p0, f32x16& p1, const char* K_lds, int r32, int hi, const bf16x8* qr, bool act) {
    if (SK && !act) { const float NEG = -__builtin_inff();
#pragma unroll
        for (int r = 0; r < 16; ++r) { p0[r] = NEG; p1[r] = NEG; } return; }
    p0 = f32x16{}; p1 = f32x16{};
    const char* kb[4];
#pragma unroll
    for (int dd = 0; dd < 4; ++dd) kb[dd] = K_lds + KB * SHM_K + KSWZ(r32, (dd * 16 + hi * 8) * 2);
#pragma unroll
    for (int d0 = 0; d0 < 8; ++d0) { const char* a = kb[d0 & 3] + (d0 >> 2) * 128;
        bf16x8 b0 = *reinterpret_cast<const bf16x8*>(a);
        bf16x8 b1 = *reinterpret_cast<const bf16x8*>(a + 32 * 256);
        p0 = __builtin_amdgcn_mfma_f32_32x32x16_bf16(b0, qr[d0], p0, 0, 0, 0);
        p1 = __builtin_amdgcn_mfma_f32_32x32x16_bf16(b1, qr[d0], p1, 0, 0, 0); }
}
template <int VB, bool SK>
__device__ __forceinline__ void pv_tile(f32x16* o, int vb0, bf16x8 pa0, bf16x8 pa1, bf16x8 pa2, bf16x8 pa3, bool act) {
    if (SK && !act) return;
#define TRRD(dst, off) asm volatile("ds_read_b64_tr_b16 %0, %1 offset:%2" : "=&v"(dst) : "v"(vb0), "i"(off) : "memory")
#define PV_D0(d0) do { s16x4 l0, l1, l2, l3, h0, h1, h2, h3; constexpr int b_ = VB * SHM_V + v_rd_off(d0, 0, 0);     \
        TRRD(l0, b_); TRRD(h0, b_ + 2048); TRRD(l1, b_ + 4096); TRRD(h1, b_ + 6144); TRRD(l2, b_ + 8192); TRRD(h2, b_ + 10240); TRRD(l3, b_ + 12288); TRRD(h3, b_ + 14336); \
        asm volatile("s_waitcnt lgkmcnt(0)" ::: "memory"); SBAR();                 \
        o[d0] = __builtin_amdgcn_mfma_f32_32x32x16_bf16(pa0, (bf16x8){l0[0], l0[1], l0[2], l0[3], h0[0], h0[1], h0[2], h0[3]}, o[d0], 0, 0, 0);   \
        o[d0] = __builtin_amdgcn_mfma_f32_32x32x16_bf16(pa1, (bf16x8){l1[0], l1[1], l1[2], l1[3], h1[0], h1[1], h1[2], h1[3]}, o[d0], 0, 0, 0);   \
        o[d0] = __builtin_amdgcn_mfma_f32_32x32x16_bf16(pa2, (bf16x8){l2[0], l2[1], l2[2], l2[3], h2[0], h2[1], h2[2], h2[3]}, o[d0], 0, 0, 0);   \
        o[d0] = __builtin_amdgcn_mfma_f32_32x32x16_bf16(pa3, (bf16x8){l3[0], l3[1], l3[2], l3[3], h3[0], h3[1], h3[2], h3[3]}, o[d0], 0, 0, 0); } while (0)
    PV_D0(0); PV_D0(1); PV_D0(2); PV_D0(3);
#undef PV_D0
#undef TRRD
}

template <class TIn, class TOut> struct BlockRef { const TIn* Q; const TIn* K; const TIn* V; TOut* O; int P0; };
template <class TIn> struct Seam {
    bf16x8 qr[8];
    bf16x8 st_v0, st_v1, st_k0, st_k1; f32x4 sf0, sf1, sf2, sf3;
    f32x4 tq[16];
};
__device__ __forceinline__ int swa_jlo(int P0, int W) { const int lowk = P0 - W + 1; return lowk > 0 ? lowk / KVBLK : 0; }
#define ROW(p, k0, rr) ((p) + (size_t)((k0) + (rr)) * D + sc)
#define VMW() asm volatile("s_waitcnt vmcnt(0)" ::: "memory")
#define VMWN(n) asm volatile("s_waitcnt vmcnt(%0)" :: "i"(n) : "memory")
#define SLOAD_H(Kp, Vp, k0) do { S.st_v0 = load8<TIn>(ROW(Vp, k0, sr)); S.st_v1 = load8<TIn>(ROW(Vp, k0, 32 + sr));              \
                         S.st_k0 = load8<TIn>(ROW(Kp, k0, sr)); S.st_k1 = load8<TIn>(ROW(Kp, k0, 32 + sr)); } while (0)
#define SWRITE_HK(bf) do { *(bf16x8*)(K_lds + (bf) * SHM_K + kws) = S.st_k0; *(bf16x8*)(K_lds + (bf) * SHM_K + kws + 32 * 256) = S.st_k1; } while (0)
#define SWRITE_HV(bf) do { *(bf16x8*)(V_lds + (bf) * SHM_V + vst0) = S.st_v0; *(bf16x8*)(V_lds + (bf) * SHM_V + vst1) = S.st_v1; } while (0)
#define SWRITE_H(bf) do { SWRITE_HV(bf); SWRITE_HK(bf); } while (0)
#define SLOAD_F(p, k0) do { S.sf0 = *(const f32x4*)ROW(p, k0, sr); S.sf1 = *(const f32x4*)(ROW(p, k0, sr) + 4);                \
                            S.sf2 = *(const f32x4*)ROW(p, k0, 32 + sr); S.sf3 = *(const f32x4*)(ROW(p, k0, 32 + sr) + 4); } while (0)
#define SWRITE_KF(bf) do { *(bf16x8*)(K_lds + (bf) * SHM_K + kws) = pack8(S.sf0, S.sf1); *(bf16x8*)(K_lds + (bf) * SHM_K + kws + 32 * 256) = pack8(S.sf2, S.sf3); } while (0)
#define SWRITE_VF(bf) do { *(bf16x8*)(V_lds + (bf) * SHM_V + vst0) = pack8(S.sf0, S.sf1); *(bf16x8*)(V_lds + (bf) * SHM_V + vst1) = pack8(S.sf2, S.sf3); } while (0)
template <class TIn, class TOut>
__device__ __forceinline__ void causal_swa_prime(const BlockRef<TIn, TOut>& cur, int W, char* lds, Seam<TIn>& S) {
    constexpr bool F32 = same_t<TIn, float>::v;
    const int tid = otid(), wid = __builtin_amdgcn_readfirstlane(tid >> 6), lane = tid & 63, r32 = lane & 31, hi = lane >> 5;
    const int sr = tid >> 4, sc = (tid & 15) * 8, kws = KSWZ(sr, sc * 2); char* K_lds = lds + 2 * SHM_V;
    const int kb0 = swa_jlo(cur.P0, W) * KVBLK;
    for (int d0 = 0; d0 < 8; ++d0) S.qr[d0] = load8<TIn>(cur.Q + (size_t)(wid * QBLK + r32) * D + d0 * 16 + hi * 8);
    if constexpr (F32) { SLOAD_F((const float*)cur.K, kb0); VMW(); SWRITE_KF(0); SBAR(); SLOAD_F((const float*)cur.V, kb0); }
    else { SLOAD_H(cur.K, cur.V, kb0); VMW(); SWRITE_HK(0); }
    __syncthreads();
}
template <class TIn, class TOut>
__device__ __forceinline__ void causal_swa_block(const BlockRef<TIn, TOut>& cur, const BlockRef<TIn, TOut>& nxt, int skv, int W, char* lds, Seam<TIn>& S) {
    constexpr bool F32 = same_t<TIn, float>::v;
    const int tid = otid(), wid = __builtin_amdgcn_readfirstlane(tid >> 6), lane = tid & 63, r32 = lane & 31, hi = lane >> 5;
    const int j_lo = swa_jlo(cur.P0, W);
    int j_hi = (cur.P0 + QB - 1) / KVBLK + 1; if (j_hi > skv / KVBLK) j_hi = skv / KVBLK;
    const int NT = j_hi - j_lo;
    const int kbn = swa_jlo(nxt.P0, W) * KVBLK;
    const int qlo = cur.P0 + wid * QBLK, qm = qlo + r32 - 4 * hi;
    char* V_lds = lds; char* K_lds = lds + 2 * SHM_V;
    float* ws = (float*)(lds + 2 * SHM_V + 2 * SHM_K) + wid * 64; float* li_l = ws, * al_l = ws + 32;
    float m_reg = -1e30f, l_reg = 0; f32x16 o[4] = {};
    const int sr = tid >> 4, sc = (tid & 15) * 8, vst0 = v_st(sr, sc), vst1 = v_st(32 + sr, sc), kws = KSWZ(sr, sc * 2);
    const int vb0 = (int)(uintptr_t)V_lds + v_rd_base(lane);
    const TIn* Kh = cur.K; const TIn* Vh = cur.V;
#define RESC(a) do { if (__any((a) < 1.f)) { if (hi == 0) al_l[r32] = (a); asm volatile("s_waitcnt lgkmcnt(0)" ::: "memory");              \
                     for (int d_ = 0; d_ < 4; ++d_) for (int r = 0; r < 16; ++r) o[d_][r] *= al_l[crow(r, hi)]; } } while (0)
#define KBASE(t) ((j_lo + (t)) * KVBLK)
#define ACT(t) (KBASE(t) <= qlo + QBLK - 1 && KBASE(t) + KVBLK - 1 >= qlo - W + 1)
#define MASKT(P0_, P1_, t) do { const int kb_ = KBASE(t); if ((!SK || ACT(t)) && (kb_ + KVBLK - 1 > qlo || kb_ <= qlo + QBLK - 1 - W)) mask_tile(P0_, P1_, qm - kb_, (unsigned)W); } while (0)
    constexpr int NQL = F32 ? 16 : 8;
    constexpr bool SK = WSKIP && !F32;
#define SEAM_K0() do { VMWN(NQL); if constexpr (F32) { SWRITE_KF(0); SBAR(); SLOAD_F((const float*)nxt.V, kbn); } else { SWRITE_HK(0); } SBAR(); } while (0)
    f32x16 pA0, pA1, pB0, pB1; float mnA, mnB, alA, alB; bf16x8 pa0, pa1, pa2, pa3;
    if constexpr (F32) { VMW(); SWRITE_VF(0); SBAR(); } else { SWRITE_HV(0); SBAR(); }
    if (NT > 1) { if constexpr (F32) SLOAD_F((const float*)Kh, KBASE(1)); else SLOAD_H(Kh, Vh, KBASE(1)); }
    SBAR(); qkt<0, SK>(pA0, pA1, K_lds, r32, hi, S.qr, ACT(0));
    if constexpr (F32) { if (NT > 1) { VMW(); SWRITE_KF(1); SBAR(); SLOAD_F((const float*)Vh, KBASE(1)); } }
    MASKT(pA0, pA1, 0); partialSM(pA0, pA1, m_reg, mnA, alA);
    if (NT > 1) { VMW(); if constexpr (F32) { SWRITE_VF(1); SBAR(); if (NT > 2) SLOAD_F((const float*)Kh, KBASE(2)); } else SWRITE_H(1); }
    __syncthreads();
#define HALF_STEP(PX0, PX1, mnX, alX, PY0, PY1, alY, t, KB, VB, SB) do {                                                      \
        SBAR(); qkt<KB, SK>(PX0, PX1, K_lds, r32, hi, S.qr, ACT(t));                                             \
        finishSM(PY0, PY1, alY, l_reg, pa0, pa1, pa2, pa3); SBAR();                                                           \
        if ((t) + 1 < NT) { if constexpr (F32) { VMW(); SWRITE_KF(SB); SBAR(); SLOAD_F((const float*)Vh, KBASE((t) + 1)); }  \
                            else { SLOAD_H(Kh, Vh, KBASE((t) + 1)); } SBAR(); }                                               \
        pv_tile<VB, SK>(o, vb0, pa0, pa1, pa2, pa3, ACT((t) - 1)); MASKT(PX0, PX1, (t)); partialSM(PX0, PX1, m_reg, mnX, alX);                                        \
        __syncthreads();                                                                                                      \
        if ((t) + 1 < NT) { VMW(); if constexpr (F32) { SWRITE_VF(SB); SBAR(); if ((t) + 2 < NT) SLOAD_F((const float*)Kh, KBASE((t) + 2)); } \
                            else { SWRITE_H(SB); } }                                                                          \
        RESC(alX); __syncthreads(); } while (0)
    for (int t = 1; t + 1 < NT; t += 2) {
        HALF_STEP(pB0, pB1, mnB, alB, pA0, pA1, alA, t, 1, 0, 0);
        HALF_STEP(pA0, pA1, mnA, alA, pB0, pB1, alB, t + 1, 0, 1, 1);
    }
    const bool even = (NT & 1) == 0;
    if (even) { SBAR(); qkt<1, SK>(pB0, pB1, K_lds, r32, hi, S.qr, ACT(NT - 1)); SBAR(); }
#define QROW(e) (nxt.Q + (size_t)(wid * QBLK + r32) * D + ((e) >> 1) * 16 + hi * 8 + ((e) & 1) * 4)
    if constexpr (F32) { SLOAD_F((const float*)nxt.K, kbn); SBAR();
#pragma unroll
        for (int e = 0; e < 8; ++e) S.tq[e] = *(const f32x4*)QROW(e); }
    else { SLOAD_H(nxt.K, nxt.V, kbn); SBAR();
#pragma unroll
        for (int d0 = 0; d0 < 8; ++d0) S.qr[d0] = load8<TIn>(nxt.Q + (size_t)(wid * QBLK + r32) * D + d0 * 16 + hi * 8); }
    SBAR();
    finishSM(pA0, pA1, alA, l_reg, pa0, pa1, pa2, pa3); SBAR();
    if constexpr (F32) {
#pragma unroll
        for (int e = 8; e < 16; ++e) S.tq[e] = *(const f32x4*)QROW(e); SBAR(); }
#undef QROW
    pv_tile<0, SK>(o, vb0, pa0, pa1, pa2, pa3, ACT(even ? NT - 2 : NT - 1));
    if (even) { MASKT(pB0, pB1, NT - 1); partialSM(pB0, pB1, m_reg, mnB, alB); __syncthreads(); RESC(alB);
        finishSM(pB0, pB1, alB, l_reg, pa0, pa1, pa2, pa3); SBAR(); pv_tile<1, SK>(o, vb0, pa0, pa1, pa2, pa3, ACT(NT - 1)); }
    SBAR(); SEAM_K0();
    if (hi == 0) li_l[r32] = l_reg; asm volatile("s_waitcnt lgkmcnt(0)" ::: "memory");
    float rli[16];
#pragma unroll
    for (int r = 0; r < 16; ++r) rli[r] = __builtin_amdgcn_rcpf(li_l[crow(r, hi)]);
    TOut* Ow = cur.O + (size_t)(wid * QBLK) * D;
#pragma unroll
    for (int r = 0; r < 16; ++r) { const int orow = crow(r, hi);
#pragma unroll
        for (int d0 = 0; d0 < 4; ++d0) { const float v = o[d0][r] * rli[r];
            if constexpr (same_t<TOut, float>::v) { Ow[(size_t)orow * D + d0 * 32 + r32] = v; }
            else { const float vn = __shfl_xor(v, 1);
                   if ((r32 & 1) == 0) *(unsigned*)(Ow + (size_t)orow * D + d0 * 32 + r32) = cvtpk(v, vn); } } }
    if constexpr (F32) {
#pragma unroll
        for (int d0 = 0; d0 < 8; ++d0) S.qr[d0] = pack8(S.tq[2 * d0], S.tq[2 * d0 + 1]); }
    __syncthreads();
#undef RESC
#undef KBASE
#undef ACT
#undef MASKT
#undef SEAM_K0
#undef HALF_STEP
}
#undef ROW
#undef VMW
#undef VMWN
#undef SLOAD_H
#undef SWRITE_HK
#undef SWRITE_HV
#undef SWRITE_H
#undef SLOAD_F
#undef SWRITE_KF
#undef SWRITE_VF

}

typedef unsigned short bf16_t;
typedef float f32x4 __attribute__((ext_vector_type(4)));
typedef float f32x16 __attribute__((ext_vector_type(16)));
typedef short bf16x8 __attribute__((ext_vector_type(8)));
typedef unsigned u32x4 __attribute__((ext_vector_type(4)));
typedef unsigned u32x2 __attribute__((ext_vector_type(2)));

constexpr int SEQ = 4096, MTOK = 8192, DM = 2048, DFF = 5632, PLED = 256;
constexpr size_t MiB = 1u << 20;
constexpr size_t WS_CTL = 0, WS_ROPE = 1, WS_WGU1 = 2, WS_WD1 = 46, WS_WGU2 = 68, WS_WD2 = 112, WS_WPG = 134, WS_WPE = 142, WS_WPOOL = 143,
                 WS_WMIXIN = 144, WS_WMIXOUT = 176, WS_PB = 184, WS_H = 192, WS_PE = 224, WS_GU = 288,
                 WS_U = 376, WS_QH = 408, WS_KH = 424, WS_VH = 440, WS_OH = 456, WS_DP = 488, WS_CC = 504,
                 WS_OHG = 288, WS_DEC = 320, WS_LF = 376, WS_QS = 440, WS_KB = 472, WS_VB = 504, WS_GS = 536, WS_LT = 568, WS_END = 696;
constexpr int CTL_LAM = 0, CTL_LBS = 1024;
constexpr int LDS_BYTES = 131072 + 64;
constexpr size_t CTL_BAR_BYTE = 65536, CTL_BAR_BYTES = 16384, CTL_ZERO_BYTES = 65536 + 9 * 65536;
constexpr int NPH = 22;
constexpr size_t CTL_SS_BYTE = 131072;

__device__ __forceinline__ float wave_sum(float v) {
#pragma unroll
    for (int o = 1; o < 64; o <<= 1) v += __shfl_xor(v, o);
    return v;
}
__device__ __forceinline__ unsigned pk2(float lo, float hi) { return pg8::cvt_pk_bf16(lo, hi); }
__device__ __forceinline__ bf16_t f2bf(float v) { return (bf16_t)(pg8::cvt_pk_bf16(v, 0.f) & 0xffffu); }
__device__ __forceinline__ float bflo(unsigned w) { return __uint_as_float(w << 16); }
__device__ __forceinline__ float bfhi(unsigned w) { return __uint_as_float(w & 0xffff0000u); }
#define LDS_WAIT() asm volatile("s_waitcnt lgkmcnt(0)" ::: "memory")

struct ConvJob { const float* W; const float* ksc; bf16_t* dst; int K, N, ldd, mode, start, pad; };
__device__ __forceinline__ int conv_find(const ConvJob* tab, int g) { int j = 0;
#pragma nounroll
    while (j < 13 && g >= tab[j + 1].start) ++j;
    return j; }
__device__ __forceinline__ void conv_load(const ConvJob* tab, int g, f32x4 (&v)[8], int lane) {
    const ConvJob jb = tab[conv_find(tab, g)];
    const int it = g - jb.start, nq4 = jb.N >> 8, q = it >> 3, w = it & 7, kq = q / nq4, nq = q - kq * nq4, kb = 2 * kq + (w >> 2), nb = 4 * nq + (w & 3);
    const float* wp = jb.W + (size_t)((kb << 5) + (lane >> 4)) * jb.N + (nb << 6) + (lane & 15) * 4;
#pragma unroll
    for (int r = 0; r < 8; ++r) v[r] = *(const f32x4*)(wp + (size_t)(4 * r) * jb.N);
}
__device__ __forceinline__ void conv_proc(const ConvJob* tab, int g, const f32x4 (&v)[8], float* scr, int lane) {
    const ConvJob jb = tab[conv_find(tab, g)];
    const int it = g - jb.start, nq4 = jb.N >> 8, q = it >> 3, w = it & 7, kq = q / nq4, nq = q - kq * nq4, kb = 2 * kq + (w >> 2), nb = 4 * nq + (w & 3), k0 = kb << 5, n0 = nb << 6;
    const int drow0 = jb.mode == 0 ? n0 : (((n0 >> 7) << 8) + (n0 & 127) + (jb.mode == 2 ? 128 : 0));
#pragma unroll
    for (int r = 0; r < 8; ++r) *(f32x4*)(scr + (4 * r + (lane >> 4)) * 68 + (lane & 15) * 4) = v[r];
    LDS_WAIT();
    bf16_t* dp = jb.dst + (size_t)(drow0 + lane) * jb.ldd + k0;
#pragma unroll
    for (int c = 0; c < 4; ++c) { const float* s = scr + (8 * c) * 68 + lane;
        f32x4 ka = {1.f, 1.f, 1.f, 1.f}, kb2 = ka; if (jb.ksc) { ka = *(const f32x4*)(jb.ksc + k0 + 8 * c); kb2 = *(const f32x4*)(jb.ksc + k0 + 8 * c + 4); }
        u32x4 o; o.x = pk2(s[0 * 68] * ka[0], s[1 * 68] * ka[1]); o.y = pk2(s[2 * 68] * ka[2], s[3 * 68] * ka[3]); o.z = pk2(s[4 * 68] * kb2[0], s[5 * 68] * kb2[1]); o.w = pk2(s[6 * 68] * kb2[2], s[7 * 68] * kb2[3]);
        *(u32x4*)(dp + 8 * c) = o; }
    LDS_WAIT();
}

__device__ __forceinline__ void prep_rows(const float* __restrict__ src, bf16_t* __restrict__ xb, unsigned long long* __restrict__ ss0, int gw, int NGW, int lane) {
    for (int m = gw; m < MTOK; m += NGW) {
        const f32x4* xr = (const f32x4*)(src + (size_t)m * DM) + lane;
        f32x4 v[8]; float s = 0.f;
#pragma unroll
        for (int j = 0; j < 8; ++j) { v[j] = xr[64 * j]; s += (v[j].x * v[j].x + v[j].y * v[j].y) + (v[j].z * v[j].z + v[j].w * v[j].w); }
        s = wave_sum(s);
        if (lane == 0) ss0[m] = (unsigned long long)(s * 1048576.f + 0.5f);
#pragma unroll
        for (int j = 0; j < 8; ++j) { u32x2 w; w.x = pk2(v[j].x, v[j].y); w.y = pk2(v[j].z, v[j].w); ((u32x2*)(xb + (size_t)m * DM))[lane + 64 * j] = w; }
    }
}
__device__ __forceinline__ void final_rows(float* x, const float* __restrict__ gain, const unsigned long long* ss, int gw, int NGW, int lane) {
    for (int m = gw; m < MTOK; m += NGW) {
        const float rstd = rsqrtf((float)ss[m] * (1.f / 1048576.f) * (1.f / DM) + 1e-6f);
        f32x4* xr = (f32x4*)(x + (size_t)m * DM) + lane;
#pragma unroll
        for (int j = 0; j < 8; ++j) { const f32x4 g = ((const f32x4*)gain)[lane + 64 * j]; xr[64 * j] = xr[64 * j] * rstd * g; }
    }
}

__device__ __forceinline__ void pool_diff(const float* __restrict__ U, bf16_t* __restrict__ Dp, int blk, int nblk, int tid) {
    const int half = tid >> 8, c4 = tid & 255, g = c4 >> 6, w = 2 << g;
    for (int un = blk * 2 + half; un < MTOK / 16; un += nblk * 2) {
        const int row0 = un * 16, s0 = row0 & (SEQ - 1);
        const float* up = U + (size_t)row0 * 1024 + c4 * 4;
        f32x4 sum = {0.f, 0.f, 0.f, 0.f};
        for (int j = 1; j <= w; ++j) if (s0 - j >= 0) sum += *(const f32x4*)(up - (ptrdiff_t)j * 1024);
#pragma unroll 4
        for (int i = 0; i < 16; ++i) {
            const int s = s0 + i; const f32x4 cur = *(const f32x4*)(up + (ptrdiff_t)i * 1024);
            sum += cur; if (s - w >= 0) sum -= *(const f32x4*)(up + (ptrdiff_t)(i - w) * 1024);
            const float inv = 1.f / (float)((s + 1) < w ? (s + 1) : w);
            const f32x4 d = sum * inv - cur;
            u32x2 o; o.x = pk2(d.x, d.y); o.y = pk2(d.z, d.w);
            *(u32x2*)(Dp + (size_t)(row0 + i) * 1024 + c4 * 4) = o;
        }
    }
}

__device__ __forceinline__ void attn_combine(const bf16_t* __restrict__ Oh, const float* __restrict__ subln, const float* lamp, bf16_t* __restrict__ CC, int gw, int NGW, int lane) {
    const float lam = *lamp;
    const int vh = lane >> 5, e = (lane & 31) * 4;
    const f32x4 g = *(const f32x4*)(subln + vh * 128 + e);
    for (int it = gw; it < MTOK * 4; it += NGW) {
        const int row = it >> 2, h = it & 3, b = row >> 12, s = row & (SEQ - 1);
        const size_t base0 = ((size_t)((((b * 4 + h) * 2 + 0) * 2 + vh) * SEQ + s)) * 128 + e;
        const size_t base1 = ((size_t)((((b * 4 + h) * 2 + 1) * 2 + vh) * SEQ + s)) * 128 + e;
        const u32x2 a = *(const u32x2*)(Oh + base0), c = *(const u32x2*)(Oh + base1);
        f32x4 o; o.x = bflo(a.x) - lam * bflo(c.x); o.y = bfhi(a.x) - lam * bfhi(c.x); o.z = bflo(a.y) - lam * bflo(c.y); o.w = bfhi(a.y) - lam * bfhi(c.y);
        const float ss = wave_sum((o.x * o.x + o.y * o.y) + (o.z * o.z + o.w * o.w));
        const float rstd = rsqrtf(ss * (1.f / 256.f) + 1e-5f) * 0.8f;
        o = o * rstd * g;
        u32x2 w; w.x = pk2(o.x, o.y); w.y = pk2(o.z, o.w);
        *(u32x2*)(CC + (size_t)row * DM + 1024 + h * 256 + vh * 128 + e) = w;
    }
}

__device__ __forceinline__ int tsw_wr(int d, int t) { return d * 72 + (t ^ (((d >> 3) & 7) << 3)); }
__device__ __forceinline__ int tsw_rd(int row, int c8) { return row * 72 + ((c8 ^ ((row >> 3) & 7)) << 3); }
__device__ __forceinline__ void lds_barrier() { asm volatile("s_waitcnt lgkmcnt(0)\n\ts_barrier" ::: "memory"); }
struct HgrnIn { f32x4 lf[4]; u32x4 a[2], b[2], c[2]; };
template <bool THREE> __device__ __forceinline__ void hgrn_load(HgrnIn& in, const float* __restrict__ LF, const bf16_t* __restrict__ A, const bf16_t* __restrict__ B, const bf16_t* __restrict__ C, int item, int tid) {
    const int bh = item >> 6, c = item & 63, b = bh >> 4, h = bh & 15, r0 = b * SEQ + c * 64, cb = h * 128;
#pragma unroll
    for (int r = 0; r < 4; ++r) { const int i = tid + 512 * r, t = i >> 5, c4 = i & 31; in.lf[r] = *(const f32x4*)(LF + (size_t)(r0 + t) * DM + cb + c4 * 4); }
#pragma unroll
    for (int r = 0; r < 2; ++r) { const int i = tid + 512 * r, t = i >> 4, d8 = (i & 15) * 8; const size_t go = (size_t)(r0 + t) * DM + cb + d8;
        in.a[r] = *(const u32x4*)(A + go); in.b[r] = *(const u32x4*)(B + go); if (THREE) in.c[r] = *(const u32x4*)(C + go); }
}
__device__ __forceinline__ void hgrn_prep(const HgrnIn& in, float* G, float* tot, int tid) {
#pragma unroll
    for (int r = 0; r < 4; ++r) { const int i = tid + 512 * r, t = i >> 5, c4 = i & 31; *(f32x4*)(G + t * 128 + c4 * 4) = in.lf[r]; }
    lds_barrier();
    const int col = tid & 127, q = tid >> 7; float* gp = G + (16 * q) * 128 + col;
    { float a = 0.f;
#pragma unroll
      for (int t = 0; t < 16; ++t) { a += gp[t * 128]; gp[t * 128] = a; }
      tot[q * 128 + col] = a; }
    lds_barrier();
    { float off = 0.f;
#pragma unroll
      for (int qq = 0; qq < 3; ++qq) off += (qq < q) ? tot[qq * 128 + col] : 0.f;
#pragma unroll
      for (int t = 0; t < 16; ++t) gp[t * 128] += off; }
    lds_barrier();
}
__device__ __forceinline__ void hgrn_passA(unsigned char* lds, const float* __restrict__ LF, const bf16_t* __restrict__ Kb, const bf16_t* __restrict__ Vb,
                                           bf16_t* __restrict__ LT, float* __restrict__ DEC, int blk, int nblk, int tid, int wave, int lane) {
    float* G = (float*)lds; bf16_t* khT = (bf16_t*)(lds + 32768); bf16_t* vT = (bf16_t*)(lds + 32768 + 18432);
    HgrnIn in;
    { int b0 = blk; asm volatile("" : "+s"(b0)); if (b0 < 2048) hgrn_load<false>(in, LF, Kb, Vb, Vb, b0, tid); }
    for (int item = blk; item < 2048; item += nblk) {
        hgrn_prep(in, G, (float*)(lds + 69632), tid);
        if (tid < 128) DEC[item * 128 + tid] = __expf(G[63 * 128 + tid]);
#pragma unroll
        for (int r = 0; r < 2; ++r) { const int i = tid + 512 * r, t = i >> 4, d8 = (i & 15) * 8;
            const u32x4 kk = in.a[r], vv = in.b[r];
#pragma unroll
            for (int j = 0; j < 4; ++j) { const unsigned kw = kk[j], vw = vv[j]; const int d = d8 + 2 * j;
                const float k0 = bflo(kw) * __expf(G[63 * 128 + d] - G[t * 128 + d]), k1 = bfhi(kw) * __expf(G[63 * 128 + d + 1] - G[t * 128 + d + 1]);
                khT[tsw_wr(d, t)] = f2bf(k0); khT[tsw_wr(d + 1, t)] = f2bf(k1);
                vT[tsw_wr(d, t)] = (bf16_t)(vw & 0xffffu); vT[tsw_wr(d + 1, t)] = (bf16_t)(vw >> 16); } }
        if (item + nblk < 2048) hgrn_load<false>(in, LF, Kb, Vb, Vb, item + nblk, tid);
        lds_barrier();
        const int r = lane & 31, hq = lane >> 5, et = wave >> 1, dt0 = (wave & 1) * 2;
        f32x16 acc0 = {}, acc1 = {};
#pragma unroll
        for (int kk = 0; kk < 4; ++kk) {
            const bf16x8 av = *(const bf16x8*)(vT + tsw_rd(et * 32 + r, kk * 2 + hq));
            const bf16x8 b0 = *(const bf16x8*)(khT + tsw_rd(dt0 * 32 + r, kk * 2 + hq));
            const bf16x8 b1 = *(const bf16x8*)(khT + tsw_rd((dt0 + 1) * 32 + r, kk * 2 + hq));
            acc0 = __builtin_amdgcn_mfma_f32_32x32x16_bf16(av, b0, acc0, 0, 0, 0);
            acc1 = __builtin_amdgcn_mfma_f32_32x32x16_bf16(av, b1, acc1, 0, 0, 0); }
        bf16_t* Lp = LT + (size_t)item * 16384;
#pragma unroll
        for (int reg = 0; reg < 16; ++reg) { const int e = et * 32 + (reg & 3) + 8 * (reg >> 2) + 4 * hq;
            const float n0 = __shfl_xor(acc0[reg], 1), n1 = __shfl_xor(acc1[reg], 1);
            if ((r & 1) == 0) { *(unsigned*)(Lp + e * 128 + dt0 * 32 + r) = pk2(acc0[reg], n0); *(unsigned*)(Lp + e * 128 + (dt0 + 1) * 32 + r) = pk2(acc1[reg], n1); } }
        lds_barrier();
    }
}
__device__ __forceinline__ void hgrn_scan(bf16_t* LT, const float* __restrict__ DEC, int gtid, int nthreads) {
    for (int base = gtid; base < 32 * 8192; base += 2 * nthreads) {
        float S[2][2] = {{0.f, 0.f}, {0.f, 0.f}}; unsigned* p[2]; const float* dp[2];
#pragma unroll
        for (int u = 0; u < 2; ++u) { int idx = base + u * nthreads; if (idx >= 32 * 8192) idx = base; const int bh = idx >> 13, ed = (idx & 8191) * 2;
            p[u] = (unsigned*)(LT + (size_t)bh * 64 * 16384 + ed); dp[u] = DEC + bh * 64 * 128 + (ed & 127); }
#pragma nounroll
        for (int cb = 0; cb < 64; cb += 16) {
            unsigned L[16][2]; float d0[16][2], d1[16][2];
#pragma unroll
            for (int j = 0; j < 16; ++j)
#pragma unroll
                for (int u = 0; u < 2; ++u) { L[j][u] = p[u][(size_t)(cb + j) * 8192]; const float* q = dp[u] + (cb + j) * 128; d0[j][u] = q[0]; d1[j][u] = q[1]; }
#pragma unroll
            for (int j = 0; j < 16; ++j) { const size_t o = (size_t)(cb + j) * 8192;
                p[0][o] = pk2(S[0][0], S[0][1]); p[1][o] = pk2(S[1][0], S[1][1]);
#pragma unroll
                for (int u = 0; u < 2; ++u) { S[u][0] = d0[j][u] * S[u][0] + bflo(L[j][u]); S[u][1] = d1[j][u] * S[u][1] + bfhi(L[j][u]); } }
        }
    }
}
__device__ __forceinline__ void hgrn_passC(unsigned char* lds, const float* __restrict__ LF, const bf16_t* __restrict__ Qs, const bf16_t* __restrict__ Kb, const bf16_t* __restrict__ Vb,
                                           const bf16_t* __restrict__ Gs, const bf16_t* __restrict__ ST, const float* __restrict__ gain, bf16_t* __restrict__ OHG,
                                           int blk, int nblk, int tid, int wave, int lane) {
    float* G = (float*)lds; bf16_t* qt = (bf16_t*)(lds + 32768); bf16_t* kt = (bf16_t*)(lds + 50176); bf16_t* vT = (bf16_t*)(lds + 67584);
    bf16_t* Ab = (bf16_t*)(lds + 86016); float* osm = (float*)(lds + 95232);
    HgrnIn in;
    { int b0 = blk; asm volatile("" : "+s"(b0)); if (b0 < 2048) hgrn_load<true>(in, LF, Qs, Kb, Vb, b0, tid); }
    for (int item = blk; item < 2048; item += nblk) {
        const int bh = item >> 6, c = item & 63, b = bh >> 4, h = bh & 15, r0 = b * SEQ + c * 64, cb = h * 128;
        u32x4 sreg[8]; { const bf16_t* Sp0 = ST + (size_t)item * 16384 + (size_t)((wave & 3) * 32 + (lane & 31)) * 128 + (lane >> 5) * 8;
#pragma unroll
            for (int kk = 0; kk < 8; ++kk) sreg[kk] = *(const u32x4*)(Sp0 + kk * 16); }
        const size_t gog = (size_t)(r0 + (tid >> 3)) * DM + cb + (tid & 7) * 16;
        const u32x4 ga = *(const u32x4*)(Gs + gog), gb = *(const u32x4*)(Gs + gog + 8);
        hgrn_prep(in, G, (float*)(lds + 129024), tid);
#pragma unroll
        for (int rr = 0; rr < 2; ++rr) { const int i = tid + 512 * rr, t = i >> 4, d8 = (i & 15) * 8;
            const u32x4 qq = in.a[rr], kk = in.b[rr], vv = in.c[rr];
            u32x4 qo, ko;
#pragma unroll
            for (int j = 0; j < 4; ++j) { const int d = d8 + 2 * j; const float g0 = G[t * 128 + d], g1 = G[t * 128 + d + 1];
                qo[j] = pk2(bflo(qq[j]) * __expf(g0), bfhi(qq[j]) * __expf(g1));
                ko[j] = pk2(bflo(kk[j]) * __expf(-g0), bfhi(kk[j]) * __expf(-g1));
                vT[tsw_wr(d, t)] = (bf16_t)(vv[j] & 0xffffu); vT[tsw_wr(d + 1, t)] = (bf16_t)(vv[j] >> 16); }
            *(u32x4*)(qt + t * 136 + d8) = qo; *(u32x4*)(kt + t * 136 + d8) = ko; }
        if (item + nblk < 2048) hgrn_load<true>(in, LF, Qs, Kb, Vb, item + nblk, tid);
        lds_barrier();
        const int r = lane & 31, hq = lane >> 5;
        if (wave < 4) { const int tt = wave >> 1, st = wave & 1; f32x16 acc = {};
#pragma unroll
            for (int kk = 0; kk < 8; ++kk) {
                const bf16x8 av = *(const bf16x8*)(qt + (tt * 32 + r) * 136 + kk * 16 + hq * 8);
                const bf16x8 bv = *(const bf16x8*)(kt + (st * 32 + r) * 136 + kk * 16 + hq * 8);
                acc = __builtin_amdgcn_mfma_f32_32x32x16_bf16(av, bv, acc, 0, 0, 0); }
#pragma unroll
            for (int reg = 0; reg < 16; ++reg) { const int t = tt * 32 + (reg & 3) + 8 * (reg >> 2) + 4 * hq, s = st * 32 + r;
                Ab[t * 72 + s] = f2bf(s <= t ? acc[reg] : 0.f); } }
        lds_barrier();
        { const int tt = wave >> 2, et = wave & 3; f32x16 acc = {};
#pragma unroll
            for (int kk = 0; kk < 8; ++kk) {
                const bf16x8 av = *(const bf16x8*)(qt + (tt * 32 + r) * 136 + kk * 16 + hq * 8);
                const u32x4 bw = sreg[kk];
                acc = __builtin_amdgcn_mfma_f32_32x32x16_bf16(av, *(const bf16x8*)&bw, acc, 0, 0, 0); }
#pragma unroll
            for (int kk = 0; kk < 4; ++kk) {
                const bf16x8 av = *(const bf16x8*)(Ab + (tt * 32 + r) * 72 + kk * 16 + hq * 8);
                const bf16x8 bv = *(const bf16x8*)(vT + tsw_rd(et * 32 + r, kk * 2 + hq));
                acc = __builtin_amdgcn_mfma_f32_32x32x16_bf16(av, bv, acc, 0, 0, 0); }
#pragma unroll
            for (int reg = 0; reg < 16; ++reg) { const int t = tt * 32 + (reg & 3) + 8 * (reg >> 2) + 4 * hq; osm[t * 132 + et * 32 + r] = acc[reg]; } }
        lds_barrier();
        { const int row = tid >> 3, j = tid & 7; f32x4 o[4]; float ss = 0.f;
#pragma unroll
            for (int q = 0; q < 4; ++q) { o[q] = *(const f32x4*)(osm + row * 132 + j * 16 + q * 4); ss += (o[q].x * o[q].x + o[q].y * o[q].y) + (o[q].z * o[q].z + o[q].w * o[q].w); }
            ss += __shfl_xor(ss, 1); ss += __shfl_xor(ss, 2); ss += __shfl_xor(ss, 4);
            const float rstd = rsqrtf(ss * (1.f / 128.f) + 1e-6f);
            const size_t go = (size_t)(r0 + row) * DM + cb + j * 16;
            u32x4 wa, wb;
#pragma unroll
            for (int q = 0; q < 4; ++q) { const f32x4 gn = *(const f32x4*)(gain + j * 16 + q * 4); const f32x4 v = o[q] * rstd * gn;
                const unsigned g01 = q < 2 ? ga[2 * q] : gb[2 * (q - 2)], g23 = q < 2 ? ga[2 * q + 1] : gb[2 * (q - 2) + 1];
                const unsigned w0 = pk2(v.x * bflo(g01), v.y * bfhi(g01)), w1 = pk2(v.z * bflo(g23), v.w * bfhi(g23));
                if (q < 2) { wa[2 * q] = w0; wa[2 * q + 1] = w1; } else { wb[2 * (q - 2)] = w0; wb[2 * (q - 2) + 1] = w1; } }
            *(u32x4*)(OHG + go) = wa; *(u32x4*)(OHG + go + 8) = wb; }
        lds_barrier();
    }
}

typedef attn::BlockRef<attn::bf16, attn::bf16> ABR;
__device__ __forceinline__ ABR attn_ref(int L, int pass, const attn::bf16* Qh, const attn::bf16* Kh, const attn::bf16* Vh, attn::bf16* Oh) {
    const int qh = L >> 3, x = L & 7, qb = pass ? 15 - x : x, bhc = qh >> 1, bh = qh >> 2, vh = qh & 1;
    ABR r;
    r.Q = Qh + ((size_t)bhc * SEQ + (size_t)qb * 256) * 128; r.K = Kh + (size_t)bhc * SEQ * 128; r.V = Vh + (size_t)(bh * 2 + vh) * SEQ * 128;
    r.O = Oh + ((size_t)qh * SEQ + (size_t)qb * 256) * 128; r.P0 = qb * 256;
    return r;
}
__device__ __forceinline__ void attn_phase(char* lds, const attn::bf16* Qh, const attn::bf16* Kh, const attn::bf16* Vh, attn::bf16* Oh, int blk, int nblk) {
    constexpr int NITEMS = 256, W = 1 << 20;
    int L = (nblk == 256) ? ((blk & 7) * 32 + (blk >> 3)) : blk; if (L >= NITEMS) return;
    int pass = 0; ABR cur = attn_ref(L, 0, Qh, Kh, Vh, Oh);
    attn::Seam<attn::bf16> S;
    attn::causal_swa_prime<attn::bf16, attn::bf16>(cur, W, lds, S);
    for (;;) {
        const bool more_pass = pass == 0, more_item = L + nblk < NITEMS, last = !more_pass && !more_item;
        int passn = pass + 1, Ln = L;
        if (!more_pass) { passn = 0; Ln = more_item ? L + nblk : L; }
        const ABR nxt = last ? cur : attn_ref(Ln, passn, Qh, Kh, Vh, Oh);
        attn::causal_swa_block<attn::bf16, attn::bf16>(cur, nxt, SEQ, W, lds, S);
        if (last) break;
        cur = nxt; pass = passn; L = Ln;
    }
}

#define XB_TMO      128
#define XB_XCNT(j)  (256  + 64 * (j))
#define XB_XSUB(j)  (1280 + 64 * (j))
#define XB_XGEN(j)  (2304 + 64 * (j))
#define XB_TOP      3328
#define XB_TOPGEN   3392
#define XCD_BAR_WORDS 3456
#define XB_SPIN_CAP (1u << 18)

__device__ __forceinline__ unsigned xb_ld(unsigned* p)              { return __hip_atomic_load(p, __ATOMIC_RELAXED, __HIP_MEMORY_SCOPE_AGENT); }
__device__ __forceinline__ unsigned xb_add(unsigned* p, unsigned v) { return __hip_atomic_fetch_add(p, v, __ATOMIC_RELAXED, __HIP_MEMORY_SCOPE_AGENT); }
__device__ __forceinline__ unsigned xb_xcc_id() { return (unsigned)__builtin_amdgcn_s_getreg((3 << 11) | 20) & 0xFu; }
#define XB_SPIN(cond, bar) do { unsigned _sp = 0; while (cond) { __builtin_amdgcn_s_sleep(1); \
    if ((++_sp & 255u) == 0u) { if (xb_ld(&(bar)[XB_TMO])) break; if (_sp > XB_SPIN_CAP) { atomicAdd(&(bar)[XB_TMO], 1u); break; } } } } while (0)

struct XcdBarrier {
    unsigned* bar; unsigned x;
    volatile unsigned* st;
};

__device__ __forceinline__ XcdBarrier xcd_barrier_post(unsigned* bar, volatile unsigned* st) {
    XcdBarrier b; b.bar = bar; b.x = xb_xcc_id(); b.st = st;
    if (otid() == 0) (void)xb_add(&bar[XB_XCNT(b.x)], 1u);
    return b;
}
__device__ __forceinline__ void xcd_barrier_complete(unsigned* bar, unsigned x, unsigned& nloc, unsigned& nx) {
    const unsigned G = gridDim.x * gridDim.y * gridDim.z;
    unsigned sum, cnt, mine, sp = 0u;
    for (;;) {
        sum = 0u; cnt = 0u; mine = 0u;
#pragma unroll
        for (unsigned j = 0; j < 16; ++j) { const unsigned c = xb_ld(&bar[XB_XCNT(j)]); sum += c; cnt += (c > 0u) ? 1u : 0u; mine = (j == x) ? c : mine; }
        if (sum == G) break;
        __builtin_amdgcn_s_sleep(1);
        if ((++sp & 255u) == 0u) { if (xb_ld(&bar[XB_TMO])) break; if (sp > XB_SPIN_CAP) { atomicAdd(&bar[XB_TMO], 1u); break; } }
    }
    nloc = mine > 0u ? mine : 1u; nx = cnt > 0u ? cnt : 1u;
}

__device__ __forceinline__ void xcd_barrier(const XcdBarrier& b) {
    asm volatile("s_waitcnt vmcnt(0)" ::: "memory");
    __syncthreads();
    if (otid() == 0) {
        unsigned* bar = b.bar;
        __builtin_amdgcn_s_waitcnt(0);
        unsigned nloc = b.st[0], nx = b.st[1];
        if (nloc == 0u) { xcd_barrier_complete(bar, b.x, nloc, nx); b.st[0] = nloc; b.st[1] = nx; }
        const unsigned old = xb_add(&bar[XB_XSUB(b.x)], 1u);
        const unsigned gen = old / nloc;
        if (old + 1u == (gen + 1u) * nloc) {
            __builtin_amdgcn_fence(__ATOMIC_RELEASE, "agent");
            asm volatile("s_waitcnt vmcnt(0)" ::: "memory");
            const unsigned og = xb_add(&bar[XB_TOP], 1u);
            const unsigned tg = og / nx;
            if (og + 1u == (tg + 1u) * nx) xb_add(&bar[XB_TOPGEN], 1u);
            else XB_SPIN(xb_ld(&bar[XB_TOPGEN]) == tg, bar);
            __builtin_amdgcn_fence(__ATOMIC_ACQUIRE, "agent");
            xb_add(&bar[XB_XGEN(b.x)], 1u);
            asm volatile("s_waitcnt vmcnt(0)" ::: "memory");
        } else {
            XB_SPIN(xb_ld(&bar[XB_XGEN(b.x)]) == gen, bar);
            __builtin_amdgcn_fence(__ATOMIC_ACQUIRE, "agent");
            asm volatile("s_waitcnt vmcnt(0)" ::: "memory");
        }
    }
    __syncthreads();
}

__device__ __forceinline__ int opq(int i) { asm volatile("" : "+s"(i)); return i; }
#define inptr(i) (a.in[opq(i)])
struct Args { const void* in[26]; float* out; unsigned char* ws; int ph_lo, ph_hi; };

__device__ __forceinline__ void convert_layer(const Args& a, unsigned char* ws, int l, unsigned jobmask, unsigned char* lds, int tid, int wave, int gw, int NGW, int lane) {
    ConvJob* tab = (ConvJob*)(lds + 8 * 8704);
    if (tid == 0) { int start = 0;
#pragma nounroll
        for (int j = 0; j < 14; ++j) {
            const float* W = nullptr; const float* ksc = nullptr; int K = 0, N = 0, ldd = 0, mode = 0; bf16_t* dst = nullptr;
            switch (j) {
                case 0: W = (const float*)inptr(4) + (size_t)l * DM * DFF; K = DM; N = DFF; dst = (bf16_t*)(ws + WS_WGU1 * MiB); ldd = DM; mode = 1; ksc = (const float*)inptr(3) + l * DM; break;
                case 1: W = (const float*)inptr(5) + (size_t)l * DM * DFF; K = DM; N = DFF; dst = (bf16_t*)(ws + WS_WGU1 * MiB); ldd = DM; mode = 2; ksc = (const float*)inptr(3) + l * DM; break;
                case 2: W = (const float*)inptr(6) + (size_t)l * DM * DFF; K = DFF; N = DM; dst = (bf16_t*)(ws + WS_WD1 * MiB); ldd = DFF; break;
                case 3: W = (const float*)inptr(9) + (size_t)l * DM * DFF; K = DM; N = DFF; dst = (bf16_t*)(ws + WS_WGU2 * MiB); ldd = DM; mode = 1; ksc = (const float*)inptr(8) + l * DM; break;
                case 4: W = (const float*)inptr(10) + (size_t)l * DM * DFF; K = DM; N = DFF; dst = (bf16_t*)(ws + WS_WGU2 * MiB); ldd = DM; mode = 2; ksc = (const float*)inptr(8) + l * DM; break;
                case 5: W = (const float*)inptr(11) + (size_t)l * DM * DFF; K = DFF; N = DM; dst = (bf16_t*)(ws + WS_WD2 * MiB); ldd = DFF; break;
                case 6: W = (const float*)inptr(13) + (size_t)l * DM * DM; K = DM; N = DM; dst = (bf16_t*)(ws + WS_WPG * MiB); ldd = DM; ksc = (const float*)inptr(12) + l * DM; break;
                case 7: W = (const float*)inptr(14) + (size_t)l * PLED * DM; K = PLED; N = DM; dst = (bf16_t*)(ws + WS_WPE * MiB); ldd = PLED; break;
                case 8: if (l == 0) { W = (const float*)inptr(15); K = DM; N = 4096; } else { W = (const float*)inptr(21); K = DM; N = 8192; } dst = (bf16_t*)(ws + WS_WMIXIN * MiB); ldd = DM; ksc = (const float*)inptr(7) + l * DM; break;
                case 9: W = (const float*)(l == 0 ? inptr(20) : inptr(24)); K = DM; N = DM; dst = (bf16_t*)(ws + WS_WMIXOUT * MiB); ldd = DM; break;
                default: if (l == 0) { const int g = j - 10; W = (const float*)inptr(16) + (size_t)g * 65536; K = 256; N = 256; dst = (bf16_t*)(ws + WS_WPOOL * MiB) + (size_t)g * 65536; ldd = 256; } else { W = (const float*)inptr(16); K = 0; N = 64; dst = (bf16_t*)(ws + WS_WPOOL * MiB); ldd = 256; } break;
            }
            if (!((jobmask >> j) & 1u)) K = 0;
            ConvJob jb; jb.W = W; jb.ksc = ksc; jb.dst = dst; jb.K = K; jb.N = N; jb.ldd = ldd; jb.mode = mode; jb.start = start; jb.pad = 0;
            tab[j] = jb; start += (K >> 5) * (N >> 6);
        }
        tab[14].start = start;
    }
    __syncthreads();
    const int total = tab[14].start; float* scr = (float*)(lds + wave * 8704);
    f32x4 va[8], vb[8];
    int g0 = gw; if (g0 < total) conv_load(tab, g0, va, lane);
#pragma nounroll
    for (;;) {
        if (g0 >= total) break;
        const int g1 = g0 + NGW; if (g1 < total) conv_load(tab, g1, vb, lane);
        conv_proc(tab, g0, va, scr, lane);
        if (g1 >= total) break;
        g0 = g1 + NGW; if (g0 < total) conv_load(tab, g0, va, lane);
        conv_proc(tab, g1, vb, scr, lane);
    }
    __syncthreads();
}
#ifndef KMASK
#define KMASK 0xFFF
#endif
#define KON(k) if constexpr (((KMASK) >> (k)) & 1)
#define LOCAL_IDS const int tid = otid(), lane = tid & 63, wave = __builtin_amdgcn_readfirstlane(tid >> 6), gw = blk * 8 + wave; (void)gw; (void)lane
__global__ void __launch_bounds__(512, 2) mega_fwd(Args a) {
    extern __shared__ __attribute__((aligned(16))) unsigned char lds[];
    cg::grid_group grid = cg::this_grid();
    const int G = gridDim.x, blk = blockIdx.x, NGW = G * 8;
    volatile unsigned* bst = (volatile unsigned*)(lds + 131072);
    if (otid() < 2) bst[otid()] = 0u;
    __syncthreads();
    XcdBarrier xbar = xcd_barrier_post((unsigned*)(a.ws + CTL_BAR_BYTE), bst);
    for (int ph = a.ph_lo; ph < a.ph_hi; ++ph) {
        size_t zoff = 0; asm volatile("" : "+s"(zoff));
        unsigned char* ws = a.ws + zoff; float* out = a.out + zoff;
        float* ctl = (float*)(ws + WS_CTL * MiB);
        float* rope = (float*)(ws + WS_ROPE * MiB);
        bf16_t* Hb = (bf16_t*)(ws + WS_H * MiB);
        bf16_t* GU = (bf16_t*)(ws + WS_GU * MiB);
        bf16_t* PE = (bf16_t*)(ws + WS_PE * MiB);
        bf16_t* PB = (bf16_t*)(ws + WS_PB * MiB);
        int kind = 0, l = 0, sub = 0;
        if (ph > 0) { l = ph >= 11 ? 1 : 0; const int r = ph - (l ? 11 : 1);
            const unsigned long long kk = l ? 0x37212BA9821ULL : 0x3721265421ULL, ss = l ? 0x40112000000ULL : 0x3011200000ULL;
            kind = (int)((kk >> (4 * r)) & 15ULL); sub = (int)((ss >> (4 * r)) & 15ULL); }
        unsigned long long* SS = (unsigned long long*)(ws + CTL_SS_BYTE);
#ifdef DUPMASK
        const int nrep = (((DUPMASK) >> kind) & 1) && kind != 2 && kind != 7 && kind != 10 && !(kind == 3 && sub == 4) ? 2 : 1;
#else
        const int nrep = 1;
#endif
        for (int rep = 0; rep < nrep; ++rep)
        switch (kind) {
        case 0: KON(0) {
            LOCAL_IDS;
            convert_layer(a, ws, 0, G == 256 ? 0x3FDBu : 0x3FFFu, lds, tid, wave, gw, NGW, lane);
            for (int i = blk * 512 + tid; i < 8 * 8192; i += G * 512) SS[8192 + i] = 0ull;
            { const f32x4* p4 = (const f32x4*)inptr(1); u32x2* o = (u32x2*)PB; const int n4 = 2 * MTOK * PLED / 4;
              for (int i = blk * 512 + tid; i < n4; i += G * 512) { const f32x4 v = p4[i]; u32x2 w; w.x = pk2(v.x, v.y); w.y = pk2(v.z, v.w); o[i] = w; } }
            { const int* pos = (const int*)inptr(2);
              for (int i = blk * 512 + tid; i < MTOK * 16; i += G * 512) { const int row = i >> 4, j = i & 15;
                  const float inv_freq = exp2f(-(float)j * (18.931568569324174f / 16.f));
                  const float ang = (float)pos[row] * inv_freq;
                  double rev = (double)ang * 0.15915494309189535; rev -= floor(rev);
                  const float rf = (float)rev;
                  rope[row * 32 + j] = __builtin_amdgcn_cosf(rf); rope[row * 32 + 16 + j] = __builtin_amdgcn_sinf(rf); } }
            if (blk == 0) {
                if (wave == 0) { const float* lp = (const float*)inptr(18); float s1 = 0.f, s2 = 0.f;
                    for (int i = lane; i < 128; i += 64) { s1 += lp[i] * lp[128 + i]; s2 += lp[256 + i] * lp[384 + i]; }
                    s1 = wave_sum(s1); s2 = wave_sum(s2);
                    if (lane == 0) ctl[CTL_LAM] = expf(s1) - expf(s2) + 0.2f; }
                const float* lb = (const float*)inptr(22);
                for (int i = tid; i < DM; i += 512) { const float b0 = lb[i], b1 = lb[DM + i], mx = fmaxf(b0, b1), e0 = expf(b0 - mx), e1 = expf(b1 - mx); ctl[CTL_LBS + i] = e1 / (e0 + e1); }
            }
            prep_rows((const float*)inptr(0), (bf16_t*)(ws + WS_LT * MiB), SS, gw, NGW, lane);
        } break;
        case 1: KON(1) {
            { pg8::Gemm g{sub ? Hb : (const bf16_t*)(ws + WS_LT * MiB), (const bf16_t*)(ws + (sub ? WS_WGU2 : WS_WGU1) * MiB), MTOK, 2 * DFF, DM, DM, DM, 0}; pg8::StaticOrder S; S.init(MTOK, 2 * DFF, G, blk);
              pg8::EpiSwiGLU E{GU, DFF, SS + 8192 * (4 * l + (sub ? 2 : 0))};
              pg8::gemm_phase<pg8::EpiSwiGLU, pg8::StaticOrder, true, true>((PG8_LAS unsigned char*)lds, g, S, E); }
            if (sub) { pg8::Gemm g{PB + (size_t)l * MTOK * PLED, (const bf16_t*)(ws + WS_WPE * MiB), MTOK, DM, PLED, PLED, PLED, 0}; asm volatile("" : "+s"(g.K)); pg8::StaticOrder S; S.init(MTOK, DM, G, blk);
              pg8::EpiF32<2> E{nullptr, nullptr, nullptr, PE, nullptr, ws, 1, 0, 0};
              pg8::gemm_phase<pg8::EpiF32<2>, pg8::StaticOrder, true, true>((PG8_LAS unsigned char*)lds, g, S, E); }
            if (G == 256 && blk >= 128) { LOCAL_IDS; convert_layer(a, ws, l, sub ? 0x20u : 0x4u, lds, tid, wave, (blk - 128) * 8 + wave, 128 * 8, lane); }
        } break;
        case 2: KON(2) {
            pg8::Gemm g; const float* basef = (l == 0 && sub == 0) ? (const float*)inptr(0) : nullptr;
            const bf16_t* baseb = (l == 1 && sub == 0) ? (const bf16_t*)(ws + WS_LT * MiB) : Hb;
            if (sub == 2) { g = pg8::Gemm{(const bf16_t*)(ws + (l ? WS_OHG : WS_CC) * MiB), (const bf16_t*)(ws + WS_WMIXOUT * MiB), MTOK, DM, DM, DM, DM, 0}; }
            else { g = pg8::Gemm{GU, (const bf16_t*)(ws + (sub ? WS_WD2 : WS_WD1) * MiB), MTOK, DM, DFF, DFF, DFF, 0}; }
            pg8::StaticOrder S; S.init(MTOK, DM, G, blk);
            pg8::EpiF32<0> E{basef, baseb, nullptr, Hb, nullptr, ws, sub == 2 ? 1 : 0, 4 * l + (sub == 0 ? 1 : sub == 2 ? 2 : 3), 0};
            pg8::gemm_phase<pg8::EpiF32<0>, pg8::StaticOrder, true, true>((PG8_LAS unsigned char*)lds, g, S, E);
        } break;
        case 3: KON(3) {
            LOCAL_IDS;
            if (sub == 3) convert_layer(a, ws, 1, G == 256 ? 0x3FDBu : 0x3FFFu, lds, tid, wave, gw, NGW, lane);
            else final_rows(out, (const float*)inptr(25), SS + 8192 * 8, gw, NGW, lane);
        } break;
        case 4: KON(4) {
            pg8::Gemm g{Hb, (const bf16_t*)(ws + WS_WMIXIN * MiB), MTOK, 4096, DM, DM, DM, 0}; pg8::StaticOrder S; S.init(MTOK, 4096, G, blk);
            pg8::EpiABin E{(float*)(ws + WS_U * MiB), (bf16_t*)(ws + WS_QH * MiB), rope, SS + 8192 * 1};
            pg8::gemm_phase<pg8::EpiABin, pg8::StaticOrder, true, true>((PG8_LAS unsigned char*)lds, g, S, E);
        } break;
        case 5: KON(5) {
            { LOCAL_IDS; pool_diff((const float*)(ws + WS_U * MiB), (bf16_t*)(ws + WS_DP * MiB), blk, G, tid); }
            attn_phase((char*)lds, (const attn::bf16*)(ws + WS_QH * MiB), (const attn::bf16*)(ws + WS_KH * MiB), (const attn::bf16*)(ws + WS_VH * MiB), (attn::bf16*)(ws + WS_OH * MiB), blk, G);
        } break;
        case 6: KON(6) {
            { pg8::Gemm g{(const bf16_t*)(ws + WS_DP * MiB), (const bf16_t*)(ws + WS_WPOOL * MiB), MTOK, 1024, 256, 1024, 256, 512}; asm volatile("" : "+s"(g.K)); pg8::StaticOrder S; S.init(MTOK, 1024, G, blk);
              pg8::EpiPool E{(bf16_t*)(ws + WS_CC * MiB), DM, (const float*)inptr(17)};
              pg8::gemm_phase<pg8::EpiPool, pg8::StaticOrder, true, true>((PG8_LAS unsigned char*)lds, g, S, E); }
            LOCAL_IDS;
            attn_combine((const bf16_t*)(ws + WS_OH * MiB), (const float*)inptr(19), ctl + CTL_LAM, (bf16_t*)(ws + WS_CC * MiB), gw, NGW, lane);
        } break;
        case 7: KON(7) {
            pg8::Gemm g{Hb, (const bf16_t*)(ws + WS_WPG * MiB), MTOK, DM, DM, DM, DM, 0}; pg8::StaticOrder S; S.init(MTOK, DM, G, blk);
            pg8::EpiF32<1> E{nullptr, Hb, l ? out : nullptr, (bf16_t*)(ws + WS_LT * MiB), PE, ws, 1, 4 * l + 4, 4 * l + 3};
            pg8::gemm_phase<pg8::EpiF32<1>, pg8::StaticOrder, true, true>((PG8_LAS unsigned char*)lds, g, S, E);
        } break;
        case 8: KON(8) {
            pg8::Gemm g{Hb, (const bf16_t*)(ws + WS_WMIXIN * MiB), MTOK, 8192, DM, DM, DM, 0}; pg8::StaticOrder S; S.init(MTOK, 8192, G, blk);
            pg8::EpiHin E{(bf16_t*)(ws + WS_QS * MiB), (float*)(ws + WS_LF * MiB), ctl + CTL_LBS, SS + 8192 * 5};
            pg8::gemm_phase<pg8::EpiHin, pg8::StaticOrder, true, true>((PG8_LAS unsigned char*)lds, g, S, E);
        } break;
        case 9: KON(9) { LOCAL_IDS; hgrn_passA(lds, (const float*)(ws + WS_LF * MiB), (const bf16_t*)(ws + WS_KB * MiB), (const bf16_t*)(ws + WS_VB * MiB), (bf16_t*)(ws + WS_LT * MiB), (float*)(ws + WS_DEC * MiB), blk, G, tid, wave, lane); } break;
        case 10: KON(10) { LOCAL_IDS; hgrn_scan((bf16_t*)(ws + WS_LT * MiB), (const float*)(ws + WS_DEC * MiB), blk * 512 + tid, G * 512); } break;
        case 11: KON(11) { LOCAL_IDS; hgrn_passC(lds, (const float*)(ws + WS_LF * MiB), (const bf16_t*)(ws + WS_QS * MiB), (const bf16_t*)(ws + WS_KB * MiB), (const bf16_t*)(ws + WS_VB * MiB), (const bf16_t*)(ws + WS_GS * MiB),
                            (const bf16_t*)(ws + WS_LT * MiB), (const float*)inptr(23), (bf16_t*)(ws + WS_OHG * MiB), blk, G, tid, wave, lane); } break;
        default: break;
        }
#ifdef DUPSYNC
        for (int srep = 0; srep < 2; ++srep)
#endif
        if (ph + 1 < a.ph_hi) {
            { int phh = a.ph_hi; asm volatile("" : "+s"(phh)); if (phh > 1000) grid.sync(); }
            xcd_barrier(xbar);
        }
    }
}

#ifndef MK_MULTI
#define MK_MULTI 0
#endif
extern "C" void kernel_launch(void* const* d_in, const int* in_sizes, int n_in, void* d_out, int out_size, void* d_ws, size_t ws_size, hipStream_t stream) {
    static int grid = 0;
    if (grid == 0) {
        if (n_in != 26 || out_size != MTOK * DM || ws_size < WS_END * MiB) { fprintf(stderr, "kernel_launch: unexpected shapes (n_in %d, out %d, ws %zu)\n", n_in, out_size, ws_size); grid = -1; return; }
        int dev = 0, cus = 0, per_cu = 0;
        (void)hipGetDevice(&dev); (void)hipDeviceGetAttribute(&cus, hipDeviceAttributeMultiprocessorCount, dev);
        (void)hipFuncSetAttribute((const void*)mega_fwd, hipFuncAttributeMaxDynamicSharedMemorySize, LDS_BYTES);
        (void)hipOccupancyMaxActiveBlocksPerMultiprocessor(&per_cu, (const void*)mega_fwd, 512, LDS_BYTES);
        if (per_cu < 1) { fprintf(stderr, "kernel_launch: occupancy query says %d blocks per CU\n", per_cu); per_cu = 1; }
        (void)hipGetLastError();
        grid = cus > 0 ? cus : 256;
    }
    if (grid < 0) return;
    (void)hipMemsetAsync((char*)d_ws + CTL_BAR_BYTE, 0, CTL_BAR_BYTES, stream);
    Args a{};
    for (int i = 0; i < 26; ++i) a.in[i] = d_in[i];
    a.out = (float*)d_out; a.ws = (unsigned char*)d_ws;
#if MK_MULTI
    for (int ph = 0; ph < NPH; ++ph) { a.ph_lo = ph; a.ph_hi = ph + 1; hipLaunchKernelGGL(mega_fwd, dim3(grid), dim3(512), LDS_BYTES, stream, a); }
#else
    a.ph_lo = 0; a.ph_hi = NPH;
    void* args[] = {&a};
    hipError_t e = hipLaunchCooperativeKernel((const void*)mega_fwd, dim3(grid), dim3(512), args, LDS_BYTES, stream);
    if (e != hipSuccess) fprintf(stderr, "cooperative launch failed: %s (grid %d)\n", hipGetErrorString(e), grid);
#ifdef PROBE_LIST
    { const int plist[] = PROBE_LIST;
      for (int p : plist) { Args a2 = a; a2.out = (float*)((char*)d_ws + WS_LT * MiB); a2.ph_lo = p; a2.ph_hi = p + 1; void* args2[] = {&a2};
          (void)hipLaunchCooperativeKernel((const void*)mega_fwd, dim3(grid), dim3(512), args2, LDS_BYTES, stream); } }
#endif
#endif
}
```

```cpp
#include <hip/hip_runtime.h>
#include <hip/hip_bf16.h>
#include <hip/hip_cooperative_groups.h>
#include <cstdio>
#include <cstdint>
namespace cg = cooperative_groups;
__device__ __forceinline__ int otid() { int t = threadIdx.x; asm volatile("" : "+v"(t)); return t; }

namespace pg8 {
#define PG8_LAS __attribute__((address_space(3)))
typedef unsigned short bf16_t;
typedef short bf16x8 __attribute__((ext_vector_type(8)));
typedef float f32x4 __attribute__((ext_vector_type(4)));
typedef unsigned u32x4 __attribute__((ext_vector_type(4)));
typedef unsigned u32x2 __attribute__((ext_vector_type(2)));
constexpr int BM = 256, BK = 64, HALF = 128, HTB = HALF * BK * 2, STAGE_BYTES = 8 * HTB, NXCD = 8, WGM = 8;

__host__ __device__ __forceinline__ int lds_byte(int r, int c) { const int st = (r >> 4) * 2 + (c >> 5), rr = r & 15, cc = c & 31, ob = rr * 64 + cc * 2; return st * 1024 + (ob ^ (((ob >> 9) & 1) << 5)); }
__host__ __device__ __forceinline__ void stage_rc(int b, int& R, int& C) { const int st = b / 1024, sb = b % 1024, swz = sb ^ (((sb >> 9) & 1) << 5); R = (st >> 1) * 16 + swz / 64; C = (st & 1) * 32 + (swz % 64) / 2; }
__host__ __device__ __forceinline__ int perm32(int rho) { const int n = rho >> 4, i = rho & 15; return 8 * (i >> 2) + 4 * n + (i & 3); }

struct Unit { int pm, pn; };
struct Gemm { const bf16_t* A; const bf16_t* Bt; int M, N, K, lda, ldb; size_t apn; };

struct StaticOrder {
    int nM, nN, nwg, G, c;
    __host__ __device__ void init(int M, int N, int G_, int c_) { nM = M / BM; nN = N / BM; nwg = nM * nN; G = G_; c = c_; }
    __host__ __device__ bool next(int i, Unit& u) const {
        const long L = (long)i * G + c; if (L >= nwg) return false;
        int wgid = (int)L; { const int q = nwg / NXCD, r = nwg % NXCD, xcd = wgid % NXCD, off = wgid / NXCD; wgid = (xcd < r ? xcd * (q + 1) : r * (q + 1) + (xcd - r) * q) + off; }
        const int nig = WGM * nN, gid = wgid / nig, fm = gid * WGM, gsz = (nM - fm) < WGM ? (nM - fm) : WGM;
        u.pm = fm + ((wgid % nig) % gsz); u.pn = (wgid % nig) / gsz; return true;
    }
    __device__ __forceinline__ void a_ready(const Unit&) const {}
    __device__ __forceinline__ void done(const Unit&) const {}
};

__device__ __forceinline__ unsigned cvt_pk_bf16(float lo, float hi) { unsigned r; asm volatile("v_cvt_pk_bf16_f32 %0, %1, %2" : "=v"(r) : "v"(lo), "v"(hi)); return r; }
__device__ __forceinline__ float fsigmoid(float v) { return __builtin_amdgcn_rcpf(1.0f + __builtin_amdgcn_exp2f(-1.4426950408889634f * v)); }
__device__ __forceinline__ float fsilu(float v) { return v * fsigmoid(v); }


struct EpiSwiGLU {
    static constexpr bool PERM = true, AFTER_DRAIN = false, HAS_PRE = true;
    __device__ __forceinline__ void prefetch(const Unit& u, float (&pre)[2][4], int wr, int fr) const {
        const unsigned long long* sp = ssin + u.pm * BM + wr * 64 + fr;
#pragma unroll
        for (int ai = 0; ai < 2; ++ai)
#pragma unroll
            for (int m = 0; m < 4; ++m) pre[ai][m] = (float)sp[ai * HALF + m * 16] * (1.f / 1048576.f);
    }

    bf16_t* O; int ldc; const unsigned long long* ssin;
    __device__ __forceinline__ void operator()(const f32x4 (&acc)[2][2][4][2], const Unit& u, int wr, int wc, int fr_, int fq, const float (&pre)[2][4]) const {
        int fr = fr_; asm volatile("" : "+v"(fr));
        const int row0 = u.pm * BM + wr * 64 + fr, col0 = u.pn * HALF + wc * 32 + 8 * fq;
        float rs[2][4];
#pragma unroll
        for (int ai = 0; ai < 2; ++ai)
#pragma unroll
            for (int m = 0; m < 4; ++m) rs[ai][m] = rsqrtf(pre[ai][m] * (1.f / 2048.f) + 1e-6f);
#pragma unroll
        for (int ai = 0; ai < 2; ++ai)
#pragma unroll
            for (int m = 0; m < 4; ++m) { bf16_t* rowp = O + (size_t)(row0 + ai * HALF + m * 16) * ldc + col0; const float r = rs[ai][m];
                f32x4 g0 = acc[ai][0][m][0] * r, g1 = acc[ai][0][m][1] * r, u0 = acc[ai][1][m][0] * r, u1 = acc[ai][1][m][1] * r;
                f32x4 v0, v1;
#pragma unroll
                for (int i = 0; i < 4; ++i) { v0[i] = fsilu(g0[i]) * u0[i]; v1[i] = fsilu(g1[i]) * u1[i]; }
                u32x4 w; w.x = cvt_pk_bf16(v0[0], v0[1]); w.y = cvt_pk_bf16(v0[2], v0[3]); w.z = cvt_pk_bf16(v1[0], v1[1]); w.w = cvt_pk_bf16(v1[2], v1[3]);
                *(u32x4*)rowp = w; asm volatile("" ::: "memory"); }
    }
};
template <int MODE> struct EpiF32 {
    static constexpr bool PERM = true, AFTER_DRAIN = false, HAS_PRE = (MODE == 1);
    __device__ __forceinline__ void prefetch(const Unit& u, float (&pre)[2][4], int wr, int fr) const {
        const unsigned long long* sp = ((const unsigned long long*)(wsb + 131072) + 8192 * slot_in) + u.pm * BM + wr * 64 + fr;
#pragma unroll
        for (int ai = 0; ai < 2; ++ai)
#pragma unroll
            for (int m = 0; m < 4; ++m) pre[ai][m] = (float)sp[ai * HALF + m * 16] * (1.f / 1048576.f);
    }
    const float* basef; const bf16_t* baseb; float* outf; bf16_t* outb; const bf16_t* pe; unsigned char* wsb; int full, slot_out, slot_in;
    static constexpr int ldc = 2048;
    __device__ __forceinline__ void operator()(const f32x4 (&acc)[2][2][4][2], const Unit& u, int wr, int wc, int fr_, int fq, const float (&pre)[2][4]) const {
        int fr = fr_; asm volatile("" : "+v"(fr));
        const int row0 = u.pm * BM + wr * 64 + fr, col0 = u.pn * BM + wc * 32 + 8 * fq;
        const float scale = full ? 1.f : 0.5f;
        unsigned long long* ssout = (unsigned long long*)(wsb + 131072) + 8192 * slot_out;
        float rs[2][4];
        if (MODE == 1) {
#pragma unroll
            for (int ai = 0; ai < 2; ++ai)
#pragma unroll
                for (int m = 0; m < 4; ++m) rs[ai][m] = rsqrtf(pre[ai][m] * (1.f / 2048.f) + 1e-6f);
        }
        constexpr int MB = (MODE == 1) ? 2 : 4;
#pragma unroll
        for (int ai = 0; ai < 2; ++ai)
#pragma unroll
        for (int m0 = 0; m0 < 4; m0 += MB) {
            u32x4 bw[MB][2], pw[MB][2];
            if (MODE != 2) {
#pragma unroll
                for (int mm = 0; mm < MB; ++mm)
#pragma unroll
                    for (int bj = 0; bj < 2; ++bj) { const size_t o2 = (size_t)(row0 + ai * HALF + (m0 + mm) * 16) * ldc + col0 + bj * HALF;
                        if (!(MODE == 0 && basef)) bw[mm][bj] = *(const u32x4*)(baseb + o2);
                        if (MODE == 1) pw[mm][bj] = *(const u32x4*)(pe + o2); }
            }
#pragma unroll
            for (int mm = 0; mm < MB; ++mm) { const int m = m0 + mm, row = row0 + ai * HALF + m * 16; float ssq = 0.f;
#pragma unroll
                for (int bj = 0; bj < 2; ++bj) { const size_t o2 = (size_t)row * ldc + col0 + bj * HALF; const f32x4 a0 = acc[ai][bj][m][0], a1 = acc[ai][bj][m][1]; f32x4 r0, r1, b0, b1;
                    if (MODE != 2) {
                        if (MODE == 0 && basef) { b0 = *(const f32x4*)(basef + o2); b1 = *(const f32x4*)(basef + o2 + 4); }
                        else { const u32x4 w = bw[mm][bj];
                            b0 = (f32x4){__uint_as_float(w.x << 16), __uint_as_float(w.x & 0xffff0000u), __uint_as_float(w.y << 16), __uint_as_float(w.y & 0xffff0000u)};
                            b1 = (f32x4){__uint_as_float(w.z << 16), __uint_as_float(w.z & 0xffff0000u), __uint_as_float(w.w << 16), __uint_as_float(w.w & 0xffff0000u)}; } }
                    if (MODE == 0) { r0 = b0 + a0 * scale; r1 = b1 + a1 * scale; }
                    else if (MODE == 1) { const u32x4 w = pw[mm][bj]; const float rr = rs[ai][m];
                        const f32x4 p0 = (f32x4){__uint_as_float(w.x << 16), __uint_as_float(w.x & 0xffff0000u), __uint_as_float(w.y << 16), __uint_as_float(w.y & 0xffff0000u)};
                        const f32x4 p1 = (f32x4){__uint_as_float(w.z << 16), __uint_as_float(w.z & 0xffff0000u), __uint_as_float(w.w << 16), __uint_as_float(w.w & 0xffff0000u)};
#pragma unroll
                        for (int i = 0; i < 4; ++i) { r0[i] = b0[i] + p0[i] * fsigmoid(a0[i] * rr); r1[i] = b1[i] + p1[i] * fsigmoid(a1[i] * rr); } }
                    else { r0 = a0; r1 = a1; }
                    if (MODE == 1 && outf) { *(f32x4*)(outf + o2) = r0; *(f32x4*)(outf + o2 + 4) = r1; }
                    else { u32x4 w; w.x = cvt_pk_bf16(r0[0], r0[1]); w.y = cvt_pk_bf16(r0[2], r0[3]); w.z = cvt_pk_bf16(r1[0], r1[1]); w.w = cvt_pk_bf16(r1[2], r1[3]); *(u32x4*)(outb + o2) = w; }
                    if (MODE != 2) ssq += ((r0[0] * r0[0] + r0[1] * r0[1]) + (r0[2] * r0[2] + r0[3] * r0[3])) + ((r1[0] * r1[0] + r1[1] * r1[1]) + (r1[2] * r1[2] + r1[3] * r1[3])); }
                if (MODE != 2) { ssq += __shfl_xor(ssq, 16); ssq += __shfl_xor(ssq, 32); if (fq == 0) __hip_atomic_fetch_add(ssout + row, (unsigned long long)(ssq * 1048576.f + 0.5f), __ATOMIC_RELAXED, __HIP_MEMORY_SCOPE_AGENT); } }
            asm volatile("" ::: "memory"); }
    }
};
struct EpiPool {
    static constexpr bool PERM = true, AFTER_DRAIN = false, HAS_PRE = false;
    bf16_t* O; int ldc; const float* cs;
    __device__ __forceinline__ void operator()(const f32x4 (&acc)[2][2][4][2], const Unit& u, int wr, int wc, int fr_, int fq, const float (&pre)[2][4]) const {
        int fr = fr_; asm volatile("" : "+v"(fr));
        const int row0 = u.pm * BM + wr * 64 + fr, col0 = u.pn * BM + wc * 32 + 8 * fq;
#pragma unroll
        for (int bj = 0; bj < 2; ++bj) { const f32x4 s0 = *(const f32x4*)(cs + col0 + bj * HALF), s1 = *(const f32x4*)(cs + col0 + bj * HALF + 4);
#pragma unroll
            for (int ai = 0; ai < 2; ++ai)
#pragma unroll
                for (int m = 0; m < 4; ++m) { bf16_t* rowp = O + (size_t)(row0 + ai * HALF + m * 16) * ldc + col0 + bj * HALF;
                    const f32x4 v0 = acc[ai][bj][m][0] * s0, v1 = acc[ai][bj][m][1] * s1;
                    u32x4 w; w.x = cvt_pk_bf16(v0[0], v0[1]); w.y = cvt_pk_bf16(v0[2], v0[3]); w.z = cvt_pk_bf16(v1[0], v1[1]); w.w = cvt_pk_bf16(v1[2], v1[3]);
                    *(u32x4*)rowp = w; asm volatile("" ::: "memory"); } }
    }
};
struct EpiABin {
    static constexpr bool PERM = true, AFTER_DRAIN = false, HAS_PRE = true;
    __device__ __forceinline__ void prefetch(const Unit& u, float (&pre)[2][4], int wr, int fr) const {
        const unsigned long long* sp = ssin + u.pm * BM + wr * 64 + fr;
#pragma unroll
        for (int ai = 0; ai < 2; ++ai)
#pragma unroll
            for (int m = 0; m < 4; ++m) pre[ai][m] = (float)sp[ai * HALF + m * 16] * (1.f / 1048576.f);
    }

    float* U; bf16_t* Qh; const float* rope; const unsigned long long* ssin;
    __device__ __forceinline__ void operator()(const f32x4 (&acc)[2][2][4][2], const Unit& u, int wr, int wc, int fr_, int fq, const float (&pre)[2][4]) const {
        int fr = fr_; asm volatile("" : "+v"(fr));
        const int row0 = u.pm * BM + wr * 64 + fr;
        float rs[2][4];
#pragma unroll
        for (int ai = 0; ai < 2; ++ai)
#pragma unroll
            for (int m = 0; m < 4; ++m) rs[ai][m] = rsqrtf(pre[ai][m] * (1.f / 2048.f) + 1e-6f);
        if (u.pn < 4) {
            const int col0 = u.pn * BM + wc * 32 + 8 * fq;
#pragma unroll
            for (int ai = 0; ai < 2; ++ai)
#pragma unroll
                for (int m = 0; m < 4; ++m) { float* rowp = U + (size_t)(row0 + ai * HALF + m * 16) * 1024 + col0; const float r = rs[ai][m];
#pragma unroll
                    for (int bj = 0; bj < 2; ++bj) { *(f32x4*)(rowp + bj * HALF) = acc[ai][bj][m][0] * r; *(f32x4*)(rowp + bj * HALF + 4) = acc[ai][bj][m][1] * r; } }
            return;
        }
        const int kind = u.pn >> 2, h = u.pn & 3, b = u.pm >> 4;
        bf16_t* dst = Qh + (size_t)(kind - 1) * 8388608;
        const bool do_rope = (kind != 3) && (wc == 0);
#pragma unroll
        for (int ai = 0; ai < 2; ++ai)
#pragma unroll
            for (int m = 0; m < 4; ++m) { const int row = row0 + ai * HALF + m * 16, s = row & 4095;
                f32x4 c0, c1, s0, s1;
                if (do_rope) { const float* rp = rope + (size_t)row * 32 + 8 * (fq & 1); c0 = *(const f32x4*)rp; c1 = *(const f32x4*)(rp + 4); s0 = *(const f32x4*)(rp + 16); s1 = *(const f32x4*)(rp + 20); }
#pragma unroll
                for (int bj = 0; bj < 2; ++bj) { f32x4 v0 = acc[ai][bj][m][0] * rs[ai][m], v1 = acc[ai][bj][m][1] * rs[ai][m];
                    if (do_rope) {
#pragma unroll
                        for (int i = 0; i < 4; ++i) { const float p0 = __shfl_xor(v0[i], 32), p1 = __shfl_xor(v1[i], 32);
                            v0[i] = (fq < 2) ? (v0[i] * c0[i] - p0 * s0[i]) : (v0[i] * c0[i] + p0 * s0[i]);
                            v1[i] = (fq < 2) ? (v1[i] * c1[i] - p1 * s1[i]) : (v1[i] * c1[i] + p1 * s1[i]); } }
                    bf16_t* p = dst + ((size_t)(((b * 4 + h) * 2 + bj) * 4096 + s)) * 128 + wc * 32 + 8 * fq;
                    u32x4 w; w.x = cvt_pk_bf16(v0[0], v0[1]); w.y = cvt_pk_bf16(v0[2], v0[3]); w.z = cvt_pk_bf16(v1[0], v1[1]); w.w = cvt_pk_bf16(v1[2], v1[3]);
                    *(u32x4*)p = w; }
                asm volatile("" ::: "memory"); }
    }
};
struct EpiHin {
    static constexpr bool PERM = true, AFTER_DRAIN = false, HAS_PRE = true;
    __device__ __forceinline__ void prefetch(const Unit& u, float (&pre)[2][4], int wr, int fr) const {
        const unsigned long long* sp = ssin + u.pm * BM + wr * 64 + fr;
#pragma unroll
        for (int ai = 0; ai < 2; ++ai)
#pragma unroll
            for (int m = 0; m < 4; ++m) pre[ai][m] = (float)sp[ai * HALF + m * 16] * (1.f / 1048576.f);
    }

    bf16_t* Qs; float* LF; const float* lbs; const unsigned long long* ssin;
    __device__ __forceinline__ void operator()(const f32x4 (&acc)[2][2][4][2], const Unit& u, int wr, int wc, int fr_, int fq, const float (&pre)[2][4]) const {
        int fr = fr_; asm volatile("" : "+v"(fr));
        const int row0 = u.pm * BM + wr * 64 + fr, split = u.pn >> 3, col0 = (u.pn & 7) * BM + wc * 32 + 8 * fq;
        bf16_t* dst = Qs + (size_t)split * 16777216;
        float rs[2][4];
#pragma unroll
        for (int ai = 0; ai < 2; ++ai)
#pragma unroll
            for (int m = 0; m < 4; ++m) rs[ai][m] = rsqrtf(pre[ai][m] * (1.f / 2048.f) + 1e-6f);
#pragma unroll
        for (int bj = 0; bj < 2; ++bj) {
            f32x4 l0 = {0.f, 0.f, 0.f, 0.f}, l1 = l0;
            if (split == 1) { l0 = *(const f32x4*)(lbs + col0 + bj * HALF); l1 = *(const f32x4*)(lbs + col0 + bj * HALF + 4); }
#pragma unroll
            for (int ai = 0; ai < 2; ++ai)
#pragma unroll
                for (int m = 0; m < 4; ++m) { const size_t off = (size_t)(row0 + ai * HALF + m * 16) * 2048 + col0 + bj * HALF;
                    f32x4 v0 = acc[ai][bj][m][0] * rs[ai][m], v1 = acc[ai][bj][m][1] * rs[ai][m];
                    if (split == 0 || split == 3) {
#pragma unroll
                        for (int i = 0; i < 4; ++i) { v0[i] = fsilu(v0[i]); v1[i] = fsilu(v1[i]); }
                    } else if (split == 1) { f32x4 f0, f1;
#pragma unroll
                        for (int i = 0; i < 4; ++i) { const float sg0 = fsigmoid(v0[i]), sg1 = fsigmoid(v1[i]);
                            f0[i] = __logf(l0[i] + (1.f - l0[i]) * sg0); f1[i] = __logf(l1[i] + (1.f - l1[i]) * sg1);
                            v0[i] = (1.f - l0[i]) * fsigmoid(-v0[i]); v1[i] = (1.f - l1[i]) * fsigmoid(-v1[i]); }
                        *(f32x4*)(LF + off) = f0; *(f32x4*)(LF + off + 4) = f1; }
                    u32x4 w; w.x = cvt_pk_bf16(v0[0], v0[1]); w.y = cvt_pk_bf16(v0[2], v0[3]); w.z = cvt_pk_bf16(v1[0], v1[1]); w.w = cvt_pk_bf16(v1[2], v1[3]);
                    *(u32x4*)(dst + off) = w; asm volatile("" ::: "memory"); } }
    }
};

template <class Epi, class Sched, bool ALIGN_EPI = false, bool SP2 = false>
__device__ __forceinline__ void gemm_phase(PG8_LAS unsigned char* lds, const Gemm g, const Sched& S, const Epi& E) {
    const int tid = otid(), wid = __builtin_amdgcn_readfirstlane(tid >> 6), lane = tid & 63, wr = wid >> 2, wc = wid & 3, fr = lane & 15, fq = lane >> 4;
    const int K = g.K, nt = K / BK;
    unsigned voffA[2], voffB[2];
#pragma unroll
    for (int i = 0; i < 2; ++i) { int R, C; stage_rc(tid * 16 + i * 8192, R, C); const int Rb = Epi::PERM ? ((R & ~31) + perm32(R & 31)) : R;
        voffA[i] = (unsigned)(R * g.lda + C) * 2u; voffB[i] = (unsigned)(Rb * g.ldb + C) * 2u; }
    const size_t kstep = (size_t)(BK * 2);
    const size_t hstepA = (size_t)HALF * g.lda * 2, hstepB = (size_t)HALF * g.ldb * 2;
    const size_t tstepA = 2 * hstepA, tstepB = 2 * hstepB;
    const unsigned ldsw = (unsigned)wid * 1024u;
    const int aoff = lds_byte(wr * 64 + fr, fq * 8), boff = lds_byte(wc * 32 + fr, fq * 8);
#define PG8_SA(b, h) (((b) * 2 + (h)) * HTB)
#define PG8_SB(b, h) ((4 + (b) * 2 + (h)) * HTB)
#define PG8_STAGE(bufoff, gbase, voff) do { _Pragma("unroll") for (int _i = 0; _i < 2; ++_i) \
        __builtin_amdgcn_global_load_lds((const unsigned*)((const char*)(gbase) + (voff)[_i]), (PG8_LAS unsigned*)(lds + (bufoff) + ldsw + _i * 8192), 16, 0, 0); } while (0)
#define PG8_LDA(dst, b, h) do { _Pragma("unroll") for (int m = 0; m < 4; ++m) _Pragma("unroll") for (int k = 0; k < 2; ++k) dst[m][k] = *(const PG8_LAS bf16x8*)(lds + PG8_SA(b, h) + aoff + m * 2048 + k * 1024); } while (0)
#define PG8_LDB(dst, b, h) do { _Pragma("unroll") for (int n = 0; n < 2; ++n) _Pragma("unroll") for (int k = 0; k < 2; ++k) dst[n][k] = *(const PG8_LAS bf16x8*)(lds + PG8_SB(b, h) + boff + n * 2048 + k * 1024); } while (0)
#define PG8_MMA(ai, bj, At, Bt) do { __builtin_amdgcn_s_setprio(1); _Pragma("unroll") for (int m = 0; m < 4; ++m) _Pragma("unroll") for (int n = 0; n < 2; ++n) _Pragma("unroll") for (int k = 0; k < 2; ++k) \
        acc[ai][bj][m][n] = __builtin_amdgcn_mfma_f32_16x16x32_bf16(Bt[n][k], At[m][k], acc[ai][bj][m][n], 0, 0, 0); __builtin_amdgcn_s_setprio(0); } while (0)
#define PG8_WAIT_V(n) asm volatile("s_waitcnt vmcnt(" #n ")" ::: "memory")
#define PG8_WAIT_L(n) asm volatile("s_waitcnt lgkmcnt(" #n ")" ::: "memory")
#define PG8_BAR __builtin_amdgcn_s_barrier()
#define PG8_SCHED __builtin_amdgcn_sched_barrier(0)
    Unit cur, nxt; int ui = 0;
    if (!S.next(0, cur)) return;
    float pre[2][4] = {{0.f, 0.f, 0.f, 0.f}, {0.f, 0.f, 0.f, 0.f}};
    f32x4 acc[2][2][4][2];
#pragma unroll
    for (int a = 0; a < 2; ++a)
#pragma unroll
        for (int b = 0; b < 2; ++b)
#pragma unroll
            for (int m = 0; m < 4; ++m)
#pragma unroll
                for (int n = 0; n < 2; ++n) acc[a][b][m][n] = (f32x4){0.f, 0.f, 0.f, 0.f};
    bf16x8 At[4][2], B0[2][2], B1[2][2];
    const char* cA = (const char*)g.A + (size_t)cur.pm * tstepA + (size_t)cur.pn * g.apn; const char* cB = (const char*)g.Bt + (size_t)cur.pn * tstepB;
    S.a_ready(cur);
    if constexpr (SP2) {
        PG8_STAGE(PG8_SB(0, 0), cB, voffB); PG8_STAGE(PG8_SB(0, 1), cB + hstepB, voffB); PG8_STAGE(PG8_SA(0, 0), cA, voffA); PG8_STAGE(PG8_SA(0, 1), cA + hstepA, voffA);
        if (wr == 1) PG8_BAR;
        PG8_WAIT_V(2); PG8_BAR;
        PG8_STAGE(PG8_SB(1, 0), cB + kstep, voffB); PG8_STAGE(PG8_SA(1, 0), cA + kstep, voffA); PG8_STAGE(PG8_SB(1, 1), cB + hstepB + kstep, voffB);
        PG8_WAIT_V(6); PG8_BAR;
    } else {
        PG8_STAGE(PG8_SB(0, 0), cB, voffB); PG8_STAGE(PG8_SA(0, 0), cA, voffA); PG8_STAGE(PG8_SB(0, 1), cB + hstepB, voffB); PG8_STAGE(PG8_SA(0, 1), cA + hstepA, voffA);
        if (wr == 1) PG8_BAR;
        PG8_WAIT_V(4); PG8_BAR;
        PG8_STAGE(PG8_SB(1, 0), cB + kstep, voffB); PG8_STAGE(PG8_SA(1, 0), cA + kstep, voffA); PG8_STAGE(PG8_SB(1, 1), cB + hstepB + kstep, voffB);
        PG8_WAIT_V(6); PG8_BAR;
    }
    for (;;) {
        const bool has_next = S.next(ui + 1, nxt);
        const char* nA = has_next ? (const char*)g.A + (size_t)nxt.pm * tstepA + (size_t)nxt.pn * g.apn : cA; const char* nB = has_next ? (const char*)g.Bt + (size_t)nxt.pn * tstepB : cB;
        for (int t = 0; t < nt; t += 2) {
            const bool last = (t == nt - 2);
            const char* a1 = cA + (size_t)(t + 1) * kstep;
            const char* a2 = last ? nA : cA + (size_t)(t + 2) * kstep; const char* b2 = last ? nB : cB + (size_t)(t + 2) * kstep;
            const char* a3 = a2 + kstep; const char* b3 = b2 + kstep;
            if (last && has_next) S.a_ready(nxt);
            if constexpr (Epi::HAS_PRE) { if (last) E.prefetch(cur, pre, wr, fr); }
            if constexpr (SP2) {
            PG8_LDB(B0, 0, 0); PG8_LDB(B1, 0, 1); PG8_SCHED; PG8_LDA(At, 0, 0); PG8_STAGE(PG8_SA(1, 1), a1 + hstepA, voffA);
            PG8_WAIT_V(8); PG8_WAIT_L(0); PG8_BAR; PG8_MMA(0, 0, At, B0); PG8_MMA(0, 1, At, B1); PG8_BAR; PG8_SCHED;
            PG8_LDA(At, 0, 1); PG8_STAGE(PG8_SB(0, 0), b2, voffB); PG8_STAGE(PG8_SB(0, 1), b2 + hstepB, voffB); PG8_STAGE(PG8_SA(0, 0), a2, voffA);
            PG8_WAIT_V(8); PG8_WAIT_L(0); PG8_BAR; PG8_MMA(1, 0, At, B0); PG8_MMA(1, 1, At, B1); PG8_BAR; PG8_SCHED;
            PG8_LDB(B0, 1, 0); PG8_LDB(B1, 1, 1); PG8_SCHED; PG8_LDA(At, 1, 0); PG8_STAGE(PG8_SA(0, 1), a2 + hstepA, voffA);
            PG8_WAIT_V(8); PG8_WAIT_L(0); PG8_BAR; PG8_MMA(0, 0, At, B0); PG8_MMA(0, 1, At, B1); PG8_BAR; PG8_SCHED;
            PG8_LDA(At, 1, 1); PG8_STAGE(PG8_SB(1, 0), b3, voffB); PG8_STAGE(PG8_SB(1, 1), b3 + hstepB, voffB); PG8_STAGE(PG8_SA(1, 0), a3, voffA);
            PG8_WAIT_V(8); PG8_WAIT_L(0); PG8_BAR; PG8_MMA(1, 0, At, B0); PG8_MMA(1, 1, At, B1); PG8_BAR; PG8_SCHED;
            } else {
            PG8_LDB(B0, 0, 0); PG8_SCHED; PG8_LDA(At, 0, 0); PG8_STAGE(PG8_SA(1, 1), a1 + hstepA, voffA);
            PG8_WAIT_L(8); PG8_BAR; PG8_WAIT_L(0); PG8_MMA(0, 0, At, B0); PG8_BAR; PG8_SCHED;
            PG8_LDB(B1, 0, 1); PG8_STAGE(PG8_SB(0, 0), b2, voffB);
            PG8_BAR; PG8_WAIT_L(0); PG8_MMA(0, 1, At, B1); PG8_BAR;
            PG8_LDA(At, 0, 1); PG8_STAGE(PG8_SA(0, 0), a2, voffA);
            PG8_BAR; PG8_WAIT_L(0); PG8_MMA(1, 0, At, B0); PG8_BAR; PG8_SCHED;
            PG8_STAGE(PG8_SB(0, 1), b2 + hstepB, voffB);
            PG8_WAIT_V(6); PG8_BAR; PG8_MMA(1, 1, At, B1); PG8_BAR;
            PG8_LDB(B0, 1, 0); PG8_SCHED; PG8_LDA(At, 1, 0); PG8_STAGE(PG8_SA(0, 1), a2 + hstepA, voffA);
            PG8_WAIT_L(8); PG8_BAR; PG8_WAIT_L(0); PG8_MMA(0, 0, At, B0); PG8_BAR; PG8_SCHED;
            PG8_LDB(B1, 1, 1); PG8_STAGE(PG8_SB(1, 0), b3, voffB);
            PG8_BAR; PG8_WAIT_L(0); PG8_MMA(0, 1, At, B1); PG8_BAR;
            PG8_LDA(At, 1, 1); PG8_STAGE(PG8_SA(1, 0), a3, voffA);
            PG8_BAR; PG8_WAIT_L(0); PG8_MMA(1, 0, At, B0); PG8_BAR; PG8_SCHED;
            PG8_STAGE(PG8_SB(1, 1), b3 + hstepB, voffB);
            PG8_WAIT_V(6); PG8_BAR; PG8_MMA(1, 1, At, B1); PG8_BAR;
            }
        }
        if constexpr (ALIGN_EPI) { if (wr == 0) PG8_BAR; }
        if constexpr (!Epi::AFTER_DRAIN) { E(acc, cur, wr, wc, fr, fq, pre); S.done(cur); }
        if (!has_next) break;
#pragma unroll
        for (int a = 0; a < 2; ++a)
#pragma unroll
            for (int b = 0; b < 2; ++b)
#pragma unroll
                for (int m = 0; m < 4; ++m)
#pragma unroll
                    for (int n = 0; n < 2; ++n) acc[a][b][m][n] = (f32x4){0.f, 0.f, 0.f, 0.f};
        cur = nxt; cA = nA; cB = nB; ++ui;
        if constexpr (ALIGN_EPI) { if (wr == 1) PG8_BAR; }
    }
    PG8_WAIT_V(0);
    if constexpr (!ALIGN_EPI) { if (wr == 0) PG8_BAR; }
    PG8_BAR;
    if constexpr (Epi::AFTER_DRAIN) { E.fused(acc, cur, wr, wc, fr, fq, lds, wid, lane); S.done(cur); }
#undef PG8_SA
#undef PG8_SB
#undef PG8_STAGE
#undef PG8_LDA
#undef PG8_LDB
#undef PG8_MMA
#undef PG8_WAIT_V
#undef PG8_WAIT_L
#undef PG8_BAR
#undef PG8_SCHED
}
}

namespace attn {
constexpr int D = 128;
constexpr float THR = 8.f;
constexpr bool WSKIP = false;
constexpr float SCALE = 0.08838834764831845f;
constexpr int NW = 8, QBLK = 32, KVBLK = 64, QB = NW * QBLK;
constexpr int SHM_V = KVBLK * D * 2, SHM_K = KVBLK * D * 2;
constexpr int LDS_BYTES = 2 * SHM_V + 2 * SHM_K + NW * 64 * 4;
using bf16 = __hip_bfloat16;
typedef short bf16x8 __attribute__((ext_vector_type(8)));
typedef short s16x4 __attribute__((ext_vector_type(4)));
typedef float f32x16 __attribute__((ext_vector_type(16)));
typedef float f32x4 __attribute__((ext_vector_type(4)));
typedef unsigned u32x4 __attribute__((ext_vector_type(4)));
template <class A, class Bt> struct same_t { static constexpr bool v = false; };
template <class A> struct same_t<A, A> { static constexpr bool v = true; };

#define KSWZ(row, colB) ((row) * 256 + ((colB) ^ (((row) & 7) << 4)))
#define SBAR() __builtin_amdgcn_sched_barrier(0)
__device__ __forceinline__ int v_st(int k, int c) { const int kk = (k & ~0xC) | ((k & 4) << 1) | ((k & 8) >> 1); return ((kk >> 3) * 4 + (c >> 5)) * 512 + ((kk & 7) * 32 + (c & 31)) * 2; }
__device__ __forceinline__ int v_rd_base(int lane) { return ((lane & 3) << 3) | (((lane >> 2) & 3) << 6) | (((lane >> 4) & 1) << 5) | (((lane >> 5) & 1) << 8); }
constexpr int v_rd_off(int d0, int ks, int half) { return d0 * 512 + ks * 4096 + half * 2048; }
__device__ __forceinline__ int crow(int r, int hi) { return (r & 3) + 8 * (r >> 2) + 4 * hi; }
__device__ __forceinline__ unsigned cvtpk(float lo, float hi) {
    unsigned r; asm volatile("v_cvt_pk_bf16_f32 %0, %1, %2" : "=v"(r) : "v"(lo), "v"(hi)); return r;
}
__device__ __forceinline__ bf16x8 pack8(f32x4 a, f32x4 b) {
    u32x4 w = {cvtpk(a[0], a[1]), cvtpk(a[2], a[3]), cvtpk(b[0], b[1]), cvtpk(b[2], b[3])};
    return *reinterpret_cast<bf16x8*>(&w);
}
template <class T> __device__ __forceinline__ bf16x8 load8(const T* p) {
    if constexpr (same_t<T, float>::v) { return pack8(*(const f32x4*)p, *(const f32x4*)(p + 4)); }
    else { return *reinterpret_cast<const bf16x8*>(p); }
}
__device__ __forceinline__ void mask_tile(f32x16& p0, f32x16& p1, int dq, unsigned W) {
    const float NEG = -__builtin_inff();
#pragma unroll
    for (int r = 0; r < 16; ++r) {
        const int c = (r & 3) + 8 * (r >> 2);
        if ((unsigned)(dq - c) >= W) p0[r] = NEG;
        if ((unsigned)(dq - c - 32) >= W) p1[r] = NEG;
    }
}
__device__ __forceinline__ void partialSM(f32x16& p0, f32x16& p1, float& m_reg, float& mn, float& alpha) {
    float pmax = p0[0]; for (int r = 1; r < 16; ++r) pmax = fmaxf(pmax, p0[r]); for (int r = 0; r < 16; ++r) pmax = fmaxf(pmax, p1[r]);
    { auto rr = __builtin_amdgcn_permlane32_swap(__float_as_uint(pmax), __float_as_uint(pmax), false, false);
      pmax = fmaxf(__uint_as_float(rr[0]), __uint_as_float(rr[1])); }
    constexpr float C2 = 1.4426950408889634f * SCALE;
    if (__builtin_expect(__all((pmax - m_reg) * SCALE <= THR), 1)) { mn = m_reg; alpha = 1.f; }
    else { mn = fmaxf(m_reg, pmax); alpha = __builtin_amdgcn_exp2f((m_reg - mn) * C2); m_reg = mn; }
    const float mnL = -mn * C2;
    for (int r = 0; r < 16; ++r) p0[r] = fmaf(p0[r], C2, mnL); for (int r = 0; r < 16; ++r) p1[r] = fmaf(p1[r], C2, mnL);
    for (int r = 0; r < 16; ++r) p0[r] = __builtin_amdgcn_exp2f(p0[r]);
}
__device__ __forceinline__ void finishSM(f32x16& p0, f32x16& p1, float alpha, float& l_reg, bf16x8& pa0, bf16x8& pa1, bf16x8& pa2, bf16x8& pa3) {
    for (int r = 0; r < 16; ++r) p1[r] = __builtin_amdgcn_exp2f(p1[r]);
    float ps = 0; for (int r = 0; r < 16; ++r) ps += p0[r]; for (int r = 0; r < 16; ++r) ps += p1[r];
    { auto rr = __builtin_amdgcn_permlane32_swap(__float_as_uint(ps), __float_as_uint(ps), false, false);
      ps = __uint_as_float(rr[0]) + __uint_as_float(rr[1]); }
    l_reg = l_reg * alpha + ps;
#define PK4(P, B_, OUT) do { unsigned a0 = cvtpk(P[B_+0], P[B_+1]), a1 = cvtpk(P[B_+2], P[B_+3]);                          \
        unsigned b0 = cvtpk(P[B_+4], P[B_+5]), b1 = cvtpk(P[B_+6], P[B_+7]);                                             \
        auto r0 = __builtin_amdgcn_permlane32_swap(a0, b0, false, false); auto r1 = __builtin_amdgcn_permlane32_swap(a1, b1, false, false); \
        u32x4 w = {r0[0], r1[0], r0[1], r1[1]}; OUT = *reinterpret_cast<bf16x8*>(&w); } while (0)
    PK4(p0, 0, pa0); PK4(p0, 8, pa1); PK4(p1, 0, pa2); PK4(p1, 8, pa3);
#undef PK4
}
template <int KB, bool SK>
__device__ __forceinline__ void qkt(f32x16& p0, f32x16& p1, const char* K_lds, int r32, int hi, const bf16x8* qr, bool act) {
    if (SK && !act) { const float NEG = -__builtin_inff();
#pragma unroll
        for (int r = 0; r < 16; ++r) { p0[r] = NEG; p1[r] = NEG; } return; }
    p0 = f32x16{}; p1 = f32x16{};
    const char* kb[4];
#pragma unroll
    for (int dd = 0; dd < 4; ++dd) kb[dd] = K_lds + KB * SHM_K + KSWZ(r32, (dd * 16 + hi * 8) * 2);
#pragma unroll
    for (int d0 = 0; d0 < 8; ++d0) { const char* a = kb[d0 & 3] + (d0 >> 2) * 128;
        bf16x8 b0 = *reinterpret_cast<const bf16x8*>(a);
        bf16x8 b1 = *reinterpret_cast<const bf16x8*>(a + 32 * 256);
        p0 = __builtin_amdgcn_mfma_f32_32x32x16_bf16(b0, qr[d0], p0, 0, 0, 0);
        p1 = __builtin_amdgcn_mfma_f32_32x32x16_bf16(b1, qr[d0], p1, 0, 0, 0); }
}
template <int VB, bool SK>
__device__ __forceinline__ void pv_tile(f32x16* o, int vb0, bf16x8 pa0, bf16x8 pa1, bf16x8 pa2, bf16x8 pa3, bool act) {
    if (SK && !act) return;
#define TRRD(dst, off) asm volatile("ds_read_b64_tr_b16 %0, %1 offset:%2" : "=&v"(dst) : "v"(vb0), "i"(off) : "memory")
#define PV_D0(d0) do { s16x4 l0, l1, l2, l3, h0, h1, h2, h3; constexpr int b_ = VB * SHM_V + v_rd_off(d0, 0, 0);     \
        TRRD(l0, b_); TRRD(h0, b_ + 2048); TRRD(l1, b_ + 4096); TRRD(h1, b_ + 6144); TRRD(l2, b_ + 8192); TRRD(h2, b_ + 10240); TRRD(l3, b_ + 12288); TRRD(h3, b_ + 14336); \
        asm volatile("s_waitcnt lgkmcnt(0)" ::: "memory"); SBAR();                 \
        o[d0] = __builtin_amdgcn_mfma_f32_32x32x16_bf16(pa0, (bf16x8){l0[0], l0[1], l0[2], l0[3], h0[0], h0[1], h0[2], h0[3]}, o[d0], 0, 0, 0);   \
        o[d0] = __builtin_amdgcn_mfma_f32_32x32x16_bf16(pa1, (bf16x8){l1[0], l1[1], l1[2], l1[3], h1[0], h1[1], h1[2], h1[3]}, o[d0], 0, 0, 0);   \
        o[d0] = __builtin_amdgcn_mfma_f32_32x32x16_bf16(pa2, (bf16x8){l2[0], l2[1], l2[2], l2[3], h2[0], h2[1], h2[2], h2[3]}, o[d0], 0, 0, 0);   \
        o[d0] = __builtin_amdgcn_mfma_f32_32x32x16_bf16(pa3, (bf16x8){l3[0], l3[1], l3[2], l3[3], h3[0], h3[1], h3[2], h3[3]}, o[d0], 0, 0, 0); } while (0)
    PV_D0(0); PV_D0(1); PV_D0(2); PV_D0(3);
#undef PV_D0
#undef TRRD
}

template <class TIn, class TOut> struct BlockRef { const TIn* Q; const TIn* K; const TIn* V; TOut* O; int P0; };
template <class TIn> struct Seam {
    bf16x8 qr[8];
    bf16x8 st_v0, st_v1, st_k0, st_k1; f32x4 sf0, sf1, sf2, sf3;
    f32x4 tq[16];
};
__device__ __forceinline__ int swa_jlo(int P0, int W) { const int lowk = P0 - W + 1; return lowk > 0 ? lowk / KVBLK : 0; }
#define ROW(p, k0, rr) ((p) + (size_t)((k0) + (rr)) * D + sc)
#define VMW() asm volatile("s_waitcnt vmcnt(0)" ::: "memory")
#define VMWN(n) asm volatile("s_waitcnt vmcnt(%0)" :: "i"(n) : "memory")
#define SLOAD_H(Kp, Vp, k0) do { S.st_v0 = load8<TIn>(ROW(Vp, k0, sr)); S.st_v1 = load8<TIn>(ROW(Vp, k0, 32 + sr));              \
                         S.st_k0 = load8<TIn>(ROW(Kp, k0, sr)); S.st_k1 = load8<TIn>(ROW(Kp, k0, 32 + sr)); } while (0)
#define SWRITE_HK(bf) do { *(bf16x8*)(K_lds + (bf) * SHM_K + kws) = S.st_k0; *(bf16x8*)(K_lds + (bf) * SHM_K + kws + 32 * 256) = S.st_k1; } while (0)
#define SWRITE_HV(bf) do { *(bf16x8*)(V_lds + (bf) * SHM_V + vst0) = S.st_v0; *(bf16x8*)(V_lds + (bf) * SHM_V + vst1) = S.st_v1; } while (0)
#define SWRITE_H(bf) do { SWRITE_HV(bf); SWRITE_HK(bf); } while (0)
#define SLOAD_F(p, k0) do { S.sf0 = *(const f32x4*)ROW(p, k0, sr); S.sf1 = *(const f32x4*)(ROW(p, k0, sr) + 4);                \
                            S.sf2 = *(const f32x4*)ROW(p, k0, 32 + sr); S.sf3 = *(const f32x4*)(ROW(p, k0, 32 + sr) + 4); } while (0)
#define SWRITE_KF(bf) do { *(bf16x8*)(K_lds + (bf) * SHM_K + kws) = pack8(S.sf0, S.sf1); *(bf16x8*)(K_lds + (bf) * SHM_K + kws + 32 * 256) = pack8(S.sf2, S.sf3); } while (0)
#define SWRITE_VF(bf) do { *(bf16x8*)(V_lds + (bf) * SHM_V + vst0) = pack8(S.sf0, S.sf1); *(bf16x8*)(V_lds + (bf) * SHM_V + vst1) = pack8(S.sf2, S.sf3); } while (0)
template <class TIn, class TOut>
__device__ __forceinline__ void causal_swa_prime(const BlockRef<TIn, TOut>& cur, int W, char* lds, Seam<TIn>& S) {
    constexpr bool F32 = same_t<TIn, float>::v;
    const int tid = otid(), wid = __builtin_amdgcn_readfirstlane(tid >> 6), lane = tid & 63, r32 = lane & 31, hi = lane >> 5;
    const int sr = tid >> 4, sc = (tid & 15) * 8, kws = KSWZ(sr, sc * 2); char* K_lds = lds + 2 * SHM_V;
    const int kb0 = swa_jlo(cur.P0, W) * KVBLK;
    for (int d0 = 0; d0 < 8; ++d0) S.qr[d0] = load8<TIn>(cur.Q + (size_t)(wid * QBLK + r32) * D + d0 * 16 + hi * 8);
    if constexpr (F32) { SLOAD_F((const float*)cur.K, kb0); VMW(); SWRITE_KF(0); SBAR(); SLOAD_F((const float*)cur.V, kb0); }
    else { SLOAD_H(cur.K, cur.V, kb0); VMW(); SWRITE_HK(0); }
    __syncthreads();
}
template <class TIn, class TOut>
__device__ __forceinline__ void causal_swa_block(const BlockRef<TIn, TOut>& cur, const BlockRef<TIn, TOut>& nxt, int skv, int W, char* lds, Seam<TIn>& S) {
    constexpr bool F32 = same_t<TIn, float>::v;
    const int tid = otid(), wid = __builtin_amdgcn_readfirstlane(tid >> 6), lane = tid & 63, r32 = lane & 31, hi = lane >> 5;
    const int j_lo = swa_jlo(cur.P0, W);
    int j_hi = (cur.P0 + QB - 1) / KVBLK + 1; if (j_hi > skv / KVBLK) j_hi = skv / KVBLK;
    const int NT = j_hi - j_lo;
    const int kbn = swa_jlo(nxt.P0, W) * KVBLK;
    const int qlo = cur.P0 + wid * QBLK, qm = qlo + r32 - 4 * hi;
    char* V_lds = lds; char* K_lds = lds + 2 * SHM_V;
    float* ws = (float*)(lds + 2 * SHM_V + 2 * SHM_K) + wid * 64; float* li_l = ws, * al_l = ws + 32;
    float m_reg = -1e30f, l_reg = 0; f32x16 o[4] = {};
    const int sr = tid >> 4, sc = (tid & 15) * 8, vst0 = v_st(sr, sc), vst1 = v_st(32 + sr, sc), kws = KSWZ(sr, sc * 2);
    const int vb0 = (int)(uintptr_t)V_lds + v_rd_base(lane);
    const TIn* Kh = cur.K; const TIn* Vh = cur.V;
#define RESC(a) do { if (__any((a) < 1.f)) { if (hi == 0) al_l[r32] = (a); asm volatile("s_waitcnt lgkmcnt(0)" ::: "memory");              \
                     for (int d_ = 0; d_ < 4; ++d_) for (int r = 0; r < 16; ++r) o[d_][r] *= al_l[crow(r, hi)]; } } while (0)
#define KBASE(t) ((j_lo + (t)) * KVBLK)
#define ACT(t) (KBASE(t) <= qlo + QBLK - 1 && KBASE(t) + KVBLK - 1 >= qlo - W + 1)
#define MASKT(P0_, P1_, t) do { const int kb_ = KBASE(t); if ((!SK || ACT(t)) && (kb_ + KVBLK - 1 > qlo || kb_ <= qlo + QBLK - 1 - W)) mask_tile(P0_, P1_, qm - kb_, (unsigned)W); } while (0)
    constexpr int NQL = F32 ? 16 : 8;
    constexpr bool SK = WSKIP && !F32;
#define SEAM_K0() do { VMWN(NQL); if constexpr (F32) { SWRITE_KF(0); SBAR(); SLOAD_F((const float*)nxt.V, kbn); } else { SWRITE_HK(0); } SBAR(); } while (0)
    f32x16 pA0, pA1, pB0, pB1; float mnA, mnB, alA, alB; bf16x8 pa0, pa1, pa2, pa3;
    if constexpr (F32) { VMW(); SWRITE_VF(0); SBAR(); } else { SWRITE_HV(0); SBAR(); }
    if (NT > 1) { if constexpr (F32) SLOAD_F((const float*)Kh, KBASE(1)); else SLOAD_H(Kh, Vh, KBASE(1)); }
    SBAR(); qkt<0, SK>(pA0, pA1, K_lds, r32, hi, S.qr, ACT(0));
    if constexpr (F32) { if (NT > 1) { VMW(); SWRITE_KF(1); SBAR(); SLOAD_F((const float*)Vh, KBASE(1)); } }
    MASKT(pA0, pA1, 0); partialSM(pA0, pA1, m_reg, mnA, alA);
    if (NT > 1) { VMW(); if constexpr (F32) { SWRITE_VF(1); SBAR(); if (NT > 2) SLOAD_F((const float*)Kh, KBASE(2)); } else SWRITE_H(1); }
    __syncthreads();
#define HALF_STEP(PX0, PX1, mnX, alX, PY0, PY1, alY, t, KB, VB, SB) do {                                                      \
        SBAR(); qkt<KB, SK>(PX0, PX1, K_lds, r32, hi, S.qr, ACT(t));                                             \
        finishSM(PY0, PY1, alY, l_reg, pa0, pa1, pa2, pa3); SBAR();                                                           \
        if ((t) + 1 < NT) { if constexpr (F32) { VMW(); SWRITE_KF(SB); SBAR(); SLOAD_F((const float*)Vh, KBASE((t) + 1)); }  \
                            else { SLOAD_H(Kh, Vh, KBASE((t) + 1)); } SBAR(); }                                               \
        pv_tile<VB, SK>(o, vb0, pa0, pa1, pa2, pa3, ACT((t) - 1)); MASKT(PX0, PX1, (t)); partialSM(PX0, PX1, m_reg, mnX, alX);                                        \
        __syncthreads();                                                                                                      \
        if ((t) + 1 < NT) { VMW(); if constexpr (F32) { SWRITE_VF(SB); SBAR(); if ((t) + 2 < NT) SLOAD_F((const float*)Kh, KBASE((t) + 2)); } \
                            else { SWRITE_H(SB); } }                                                                          \
        RESC(alX); __syncthreads(); } while (0)
    for (int t = 1; t + 1 < NT; t += 2) {
        HALF_STEP(pB0, pB1, mnB, alB, pA0, pA1, alA, t, 1, 0, 0);
        HALF_STEP(pA0, pA1, mnA, alA, pB0, pB1, alB, t + 1, 0, 1, 1);
    }
    const bool even = (NT & 1) == 0;
    if (even) { SBAR(); qkt<1, SK>(pB0, pB1, K_lds, r32, hi, S.qr, ACT(NT - 1)); SBAR(); }
#define QROW(e) (nxt.Q + (size_t)(wid * QBLK + r32) * D + ((e) >> 1) * 16 + hi * 8 + ((e) & 1) * 4)
    if constexpr (F32) { SLOAD_F((const float*)nxt.K, kbn); SBAR();
#pragma unroll
        for (int e = 0; e < 8; ++e) S.tq[e] = *(const f32x4*)QROW(e); }
    else { SLOAD_H(nxt.K, nxt.V, kbn); SBAR();
#pragma unroll
        for (int d0 = 0; d0 < 8; ++d0) S.qr[d0] = load8<TIn>(nxt.Q + (size_t)(wid * QBLK + r32) * D + d0 * 16 + hi * 8); }
    SBAR();
    finishSM(pA0, pA1, alA, l_reg, pa0, pa1, pa2, pa3); SBAR();
    if constexpr (F32) {
#pragma unroll
        for (int e = 8; e < 16; ++e) S.tq[e] = *(const f32x4*)QROW(e); SBAR(); }
#undef QROW
    pv_tile<0, SK>(o, vb0, pa0, pa1, pa2, pa3, ACT(even ? NT - 2 : NT - 1));
    if (even) { MASKT(pB0, pB1, NT - 1); partialSM(pB0, pB1, m_reg, mnB, alB); __syncthreads(); RESC(alB);
        finishSM(pB0, pB1, alB, l_reg, pa0, pa1, pa2, pa3); SBAR(); pv_tile<1, SK>(o, vb0, pa0, pa1, pa2, pa3, ACT(NT - 1)); }
    SBAR(); SEAM_K0();
    if (hi == 0) li_l[r32] = l_reg; asm volatile("s_waitcnt lgkmcnt(0)" ::: "memory");
    float rli[16];
#pragma unroll
    for (int r = 0; r < 16; ++r) rli[r] = __builtin_amdgcn_rcpf(li_l[crow(r, hi)]);
    TOut* Ow = cur.O + (size_t)(wid * QBLK) * D;
#pragma unroll
    for (int r = 0; r < 16; ++r) { const int orow = crow(r, hi);
#pragma unroll
        for (int d0 = 0; d0 < 4; ++d0) { const float v = o[d0][r] * rli[r];
            if constexpr (same_t<TOut, float>::v) { Ow[(size_t)orow * D + d0 * 32 + r32] = v; }
            else { const float vn = __shfl_xor(v, 1);
                   if ((r32 & 1) == 0) *(unsigned*)(Ow + (size_t)orow * D + d0 * 32 + r32) = cvtpk(v, vn); } } }
    if constexpr (F32) {
#pragma unroll
        for (int d0 = 0; d0 < 8; ++d0) S.qr[d0] = pack8(S.tq[2 * d0], S.tq[2 * d0 + 1]); }
    __syncthreads();
#undef RESC
#undef KBASE
#undef ACT
#undef MASKT
#undef SEAM_K0
#undef HALF_STEP
}
#undef ROW
#undef VMW
#undef VMWN
#undef SLOAD_H
#undef SWRITE_HK
#undef SWRITE_HV
#undef SWRITE_H
#undef SLOAD_F
#undef SWRITE_KF
#undef SWRITE_VF

}

typedef unsigned short bf16_t;
typedef float f32x4 __attribute__((ext_vector_type(4)));
typedef float f32x16 __attribute__((ext_vector_type(16)));
typedef short bf16x8 __attribute__((ext_vector_type(8)));
typedef unsigned u32x4 __attribute__((ext_vector_type(4)));
typedef unsigned u32x2 __attribute__((ext_vector_type(2)));

constexpr int SEQ = 4096, MTOK = 8192, DM = 2048, DFF = 5632, PLED = 256;
constexpr size_t MiB = 1u << 20;
constexpr size_t WS_CTL = 0, WS_ROPE = 1, WS_WGU1 = 2, WS_WD1 = 46, WS_WGU2 = 68, WS_WD2 = 112, WS_WPG = 134, WS_WPE = 142, WS_WPOOL = 143,
                 WS_WMIXIN = 144, WS_WMIXOUT = 176, WS_PB = 184, WS_H = 192, WS_PE = 224, WS_GU = 288,
                 WS_U = 376, WS_QH = 408, WS_KH = 424, WS_VH = 440, WS_OH = 456, WS_DP = 488, WS_CC = 504,
                 WS_OHG = 288, WS_DEC = 320, WS_LF = 376, WS_QS = 440, WS_KB = 472, WS_VB = 504, WS_GS = 536, WS_LT = 568, WS_END = 696;
constexpr int CTL_LAM = 0, CTL_LBS = 1024;
constexpr int LDS_BYTES = 131072 + 64;
constexpr size_t CTL_BAR_BYTE = 65536, CTL_BAR_BYTES = 16384, CTL_ZERO_BYTES = 65536 + 9 * 65536;
constexpr int NPH = 22;
constexpr size_t CTL_SS_BYTE = 131072;

__device__ __forceinline__ float wave_sum(float v) {
#pragma unroll
    for (int o = 1; o < 64; o <<= 1) v += __shfl_xor(v, o);
    return v;
}
__device__ __forceinline__ unsigned pk2(float lo, float hi) { return pg8::cvt_pk_bf16(lo, hi); }
__device__ __forceinline__ bf16_t f2bf(float v) { return (bf16_t)(pg8::cvt_pk_bf16(v, 0.f) & 0xffffu); }
__device__ __forceinline__ float bflo(unsigned w) { return __uint_as_float(w << 16); }
__device__ __forceinline__ float bfhi(unsigned w) { return __uint_as_float(w & 0xffff0000u); }
#define LDS_WAIT() asm volatile("s_waitcnt lgkmcnt(0)" ::: "memory")

struct ConvJob { const float* W; const float* ksc; bf16_t* dst; int K, N, ldd, mode, start, pad; };
__device__ __forceinline__ int conv_find(const ConvJob* tab, int g) { int j = 0;
#pragma nounroll
    while (j < 13 && g >= tab[j + 1].start) ++j;
    return j; }
__device__ __forceinline__ void conv_load(const ConvJob* tab, int g, f32x4 (&v)[8], int lane) {
    const ConvJob jb = tab[conv_find(tab, g)];
    const int it = g - jb.start, nq4 = jb.N >> 8, q = it >> 3, w = it & 7, kq = q / nq4, nq = q - kq * nq4, kb = 2 * kq + (w >> 2), nb = 4 * nq + (w & 3);
    const float* wp = jb.W + (size_t)((kb << 5) + (lane >> 4)) * jb.N + (nb << 6) + (lane & 15) * 4;
#pragma unroll
    for (int r = 0; r < 8; ++r) v[r] = *(const f32x4*)(wp + (size_t)(4 * r) * jb.N);
}
__device__ __forceinline__ void conv_proc(const ConvJob* tab, int g, const f32x4 (&v)[8], float* scr, int lane) {
    const ConvJob jb = tab[conv_find(tab, g)];
    const int it = g - jb.start, nq4 = jb.N >> 8, q = it >> 3, w = it & 7, kq = q / nq4, nq = q - kq * nq4, kb = 2 * kq + (w >> 2), nb = 4 * nq + (w & 3), k0 = kb << 5, n0 = nb << 6;
    const int drow0 = jb.mode == 0 ? n0 : (((n0 >> 7) << 8) + (n0 & 127) + (jb.mode == 2 ? 128 : 0));
#pragma unroll
    for (int r = 0; r < 8; ++r) *(f32x4*)(scr + (4 * r + (lane >> 4)) * 68 + (lane & 15) * 4) = v[r];
    LDS_WAIT();
    bf16_t* dp = jb.dst + (size_t)(drow0 + lane) * jb.ldd + k0;
#pragma unroll
    for (int c = 0; c < 4; ++c) { const float* s = scr + (8 * c) * 68 + lane;
        f32x4 ka = {1.f, 1.f, 1.f, 1.f}, kb2 = ka; if (jb.ksc) { ka = *(const f32x4*)(jb.ksc + k0 + 8 * c); kb2 = *(const f32x4*)(jb.ksc + k0 + 8 * c + 4); }
        u32x4 o; o.x = pk2(s[0 * 68] * ka[0], s[1 * 68] * ka[1]); o.y = pk2(s[2 * 68] * ka[2], s[3 * 68] * ka[3]); o.z = pk2(s[4 * 68] * kb2[0], s[5 * 68] * kb2[1]); o.w = pk2(s[6 * 68] * kb2[2], s[7 * 68] * kb2[3]);
        *(u32x4*)(dp + 8 * c) = o; }
    LDS_WAIT();
}

__device__ __forceinline__ void prep_rows(const float* __restrict__ src, bf16_t* __restrict__ xb, unsigned long long* __restrict__ ss0, int gw, int NGW, int lane) {
    for (int m = gw; m < MTOK; m += NGW) {
        const f32x4* xr = (const f32x4*)(src + (size_t)m * DM) + lane;
        f32x4 v[8]; float s = 0.f;
#pragma unroll
        for (int j = 0; j < 8; ++j) { v[j] = xr[64 * j]; s += (v[j].x * v[j].x + v[j].y * v[j].y) + (v[j].z * v[j].z + v[j].w * v[j].w); }
        s = wave_sum(s);
        if (lane == 0) ss0[m] = (unsigned long long)(s * 1048576.f + 0.5f);
#pragma unroll
        for (int j = 0; j < 8; ++j) { u32x2 w; w.x = pk2(v[j].x, v[j].y); w.y = pk2(v[j].z, v[j].w); ((u32x2*)(xb + (size_t)m * DM))[lane + 64 * j] = w; }
    }
}
__device__ __forceinline__ void final_rows(float* x, const float* __restrict__ gain, const unsigned long long* ss, int gw, int NGW, int lane) {
    for (int m = gw; m < MTOK; m += NGW) {
        const float rstd = rsqrtf((float)ss[m] * (1.f / 1048576.f) * (1.f / DM) + 1e-6f);
        f32x4* xr = (f32x4*)(x + (size_t)m * DM) + lane;
#pragma unroll
        for (int j = 0; j < 8; ++j) { const f32x4 g = ((const f32x4*)gain)[lane + 64 * j]; xr[64 * j] = xr[64 * j] * rstd * g; }
    }
}

template <int W> __device__ __forceinline__ void pool_unit(const float* __restrict__ up, bf16_t* __restrict__ dp, int s0) {
    f32x4 v[16 + W];
#pragma unroll
    for (int j = 0; j < 16 + W; ++j) { const int s = s0 - W + j; v[j] = (s >= 0) ? *(const f32x4*)(up + (ptrdiff_t)(j - W) * 1024) : (f32x4){0.f, 0.f, 0.f, 0.f}; }
    f32x4 sum = {0.f, 0.f, 0.f, 0.f};
#pragma unroll
    for (int j = 0; j < W; ++j) sum += v[j];
#pragma unroll
    for (int i = 0; i < 16; ++i) {
        const int s = s0 + i; const f32x4 cur = v[W + i];
        sum += cur; sum -= v[i];
        const float inv = 1.f / (float)((s + 1) < W ? (s + 1) : W);
        const f32x4 d = sum * inv - cur;
        u32x2 o; o.x = pk2(d.x, d.y); o.y = pk2(d.z, d.w);
        *(u32x2*)(dp + (size_t)i * 1024) = o;
    }
}
__device__ __forceinline__ void pool_diff(const float* __restrict__ U, bf16_t* __restrict__ Dp, int blk, int nblk, int tid) {
    const int half = tid >> 8, c4 = tid & 255, g = __builtin_amdgcn_readfirstlane(c4 >> 6);
    for (int un = blk * 2 + half; un < MTOK / 16; un += nblk * 2) {
        const int row0 = un * 16, s0 = row0 & (SEQ - 1);
        const float* up = U + (size_t)row0 * 1024 + c4 * 4; bf16_t* dp = Dp + (size_t)row0 * 1024 + c4 * 4;
        if (g == 0) pool_unit<2>(up, dp, s0); else if (g == 1) pool_unit<4>(up, dp, s0); else if (g == 2) pool_unit<8>(up, dp, s0); else pool_unit<16>(up, dp, s0);
    }
}

__device__ __forceinline__ void attn_combine(const bf16_t* __restrict__ Oh, const float* __restrict__ subln, const float* lamp, bf16_t* __restrict__ CC, int gw, int NGW, int lane) {
    const float lam = *lamp;
    const int vh = lane >> 5, e = (lane & 31) * 4;
    const f32x4 g = *(const f32x4*)(subln + vh * 128 + e);
#pragma unroll 4
    for (int it = gw; it < MTOK * 4; it += NGW) {
        const int row = it >> 2, h = it & 3, b = row >> 12, s = row & (SEQ - 1);
        const size_t base0 = ((size_t)((((b * 4 + h) * 2 + 0) * 2 + vh) * SEQ + s)) * 128 + e;
        const size_t base1 = ((size_t)((((b * 4 + h) * 2 + 1) * 2 + vh) * SEQ + s)) * 128 + e;
        const u32x2 a = *(const u32x2*)(Oh + base0), c = *(const u32x2*)(Oh + base1);
        f32x4 o; o.x = bflo(a.x) - lam * bflo(c.x); o.y = bfhi(a.x) - lam * bfhi(c.x); o.z = bflo(a.y) - lam * bflo(c.y); o.w = bfhi(a.y) - lam * bfhi(c.y);
        const float ss = wave_sum((o.x * o.x + o.y * o.y) + (o.z * o.z + o.w * o.w));
        const float rstd = rsqrtf(ss * (1.f / 256.f) + 1e-5f) * 0.8f;
        o = o * rstd * g;
        u32x2 w; w.x = pk2(o.x, o.y); w.y = pk2(o.z, o.w);
        *(u32x2*)(CC + (size_t)row * DM + 1024 + h * 256 + vh * 128 + e) = w;
    }
}

__device__ __forceinline__ int tsw_wr(int d, int t) { return d * 72 + (t ^ (((d >> 3) & 7) << 3)); }
__device__ __forceinline__ int tsw_rd(int row, int c8) { return row * 72 + ((c8 ^ ((row >> 3) & 7)) << 3); }
__device__ __forceinline__ void lds_barrier() { asm volatile("s_waitcnt lgkmcnt(0)\n\ts_barrier" ::: "memory"); }
struct HgrnIn { f32x4 lf[4]; u32x4 a[2], b[2], c[2]; };
template <bool THREE> __device__ __forceinline__ void hgrn_load(HgrnIn& in, const float* __restrict__ LF, const bf16_t* __restrict__ A, const bf16_t* __restrict__ B, const bf16_t* __restrict__ C, int item, int tid) {
    const int bh = item >> 6, c = item & 63, b = bh >> 4, h = bh & 15, r0 = b * SEQ + c * 64, cb = h * 128;
#pragma unroll
    for (int r = 0; r < 4; ++r) { const int i = tid + 512 * r, t = i >> 5, c4 = i & 31; in.lf[r] = *(const f32x4*)(LF + (size_t)(r0 + t) * DM + cb + c4 * 4); }
#pragma unroll
    for (int r = 0; r < 2; ++r) { const int i = tid + 512 * r, t = i >> 4, d8 = (i & 15) * 8; const size_t go = (size_t)(r0 + t) * DM + cb + d8;
        in.a[r] = *(const u32x4*)(A + go); in.b[r] = *(const u32x4*)(B + go); if (THREE) in.c[r] = *(const u32x4*)(C + go); }
}
__device__ __forceinline__ void hgrn_prep(const HgrnIn& in, float* G, float* tot, int tid) {
#pragma unroll
    for (int r = 0; r < 4; ++r) { const int i = tid + 512 * r, t = i >> 5, c4 = i & 31; *(f32x4*)(G + t * 128 + c4 * 4) = in.lf[r]; }
    lds_barrier();
    const int col = tid & 127, q = tid >> 7; float* gp = G + (16 * q) * 128 + col;
    { float a = 0.f;
#pragma unroll
      for (int t = 0; t < 16; ++t) { a += gp[t * 128]; gp[t * 128] = a; }
      tot[q * 128 + col] = a; }
    lds_barrier();
    { float off = 0.f;
#pragma unroll
      for (int qq = 0; qq < 3; ++qq) off += (qq < q) ? tot[qq * 128 + col] : 0.f;
#pragma unroll
      for (int t = 0; t < 16; ++t) gp[t * 128] += off; }
    lds_barrier();
}
__device__ __forceinline__ void hgrn_passA(unsigned char* lds, const float* __restrict__ LF, const bf16_t* __restrict__ Kb, const bf16_t* __restrict__ Vb,
                                           bf16_t* __restrict__ LT, float* __restrict__ DEC, int blk, int nblk, int tid, int wave, int lane) {
    float* G = (float*)lds; bf16_t* khT = (bf16_t*)(lds + 32768); bf16_t* vT = (bf16_t*)(lds + 32768 + 18432);
    HgrnIn in;
    { int b0 = blk; asm volatile("" : "+s"(b0)); if (b0 < 2048) hgrn_load<false>(in, LF, Kb, Vb, Vb, b0, tid); }
    for (int item = blk; item < 2048; item += nblk) {
        hgrn_prep(in, G, (float*)(lds + 69632), tid);
        if (tid < 128) DEC[item * 128 + tid] = __expf(G[63 * 128 + tid]);
#pragma unroll
        for (int r = 0; r < 2; ++r) { const int i = tid + 512 * r, t = i >> 4, d8 = (i & 15) * 8;
            const u32x4 kk = in.a[r], vv = in.b[r];
#pragma unroll
            for (int j = 0; j < 4; ++j) { const unsigned kw = kk[j], vw = vv[j]; const int d = d8 + 2 * j;
                const float k0 = bflo(kw) * __expf(G[63 * 128 + d] - G[t * 128 + d]), k1 = bfhi(kw) * __expf(G[63 * 128 + d + 1] - G[t * 128 + d + 1]);
                khT[tsw_wr(d, t)] = f2bf(k0); khT[tsw_wr(d + 1, t)] = f2bf(k1);
                vT[tsw_wr(d, t)] = (bf16_t)(vw & 0xffffu); vT[tsw_wr(d + 1, t)] = (bf16_t)(vw >> 16); } }
        if (item + nblk < 2048) hgrn_load<false>(in, LF, Kb, Vb, Vb, item + nblk, tid);
        lds_barrier();
        const int r = lane & 31, hq = lane >> 5, et = wave >> 1, dt0 = (wave & 1) * 2;
        f32x16 acc0 = {}, acc1 = {};
#pragma unroll
        for (int kk = 0; kk < 4; ++kk) {
            const bf16x8 av = *(const bf16x8*)(vT + tsw_rd(et * 32 + r, kk * 2 + hq));
            const bf16x8 b0 = *(const bf16x8*)(khT + tsw_rd(dt0 * 32 + r, kk * 2 + hq));
            const bf16x8 b1 = *(const bf16x8*)(khT + tsw_rd((dt0 + 1) * 32 + r, kk * 2 + hq));
            acc0 = __builtin_amdgcn_mfma_f32_32x32x16_bf16(av, b0, acc0, 0, 0, 0);
            acc1 = __builtin_amdgcn_mfma_f32_32x32x16_bf16(av, b1, acc1, 0, 0, 0); }
        bf16_t* Lp = LT + (size_t)item * 16384;
#pragma unroll
        for (int reg = 0; reg < 16; ++reg) { const int e = et * 32 + (reg & 3) + 8 * (reg >> 2) + 4 * hq;
            const float n0 = __shfl_xor(acc0[reg], 1), n1 = __shfl_xor(acc1[reg], 1);
            if ((r & 1) == 0) { *(unsigned*)(Lp + e * 128 + dt0 * 32 + r) = pk2(acc0[reg], n0); *(unsigned*)(Lp + e * 128 + (dt0 + 1) * 32 + r) = pk2(acc1[reg], n1); } }
        lds_barrier();
    }
}
__device__ __forceinline__ void hgrn_scan(bf16_t* LT, const float* __restrict__ DEC, int gtid, int nthreads) {
    for (int base = gtid; base < 32 * 8192; base += 2 * nthreads) {
        float S[2][2] = {{0.f, 0.f}, {0.f, 0.f}}; unsigned* p[2]; const float* dp[2];
#pragma unroll
        for (int u = 0; u < 2; ++u) { int idx = base + u * nthreads; if (idx >= 32 * 8192) idx = base; const int bh = idx >> 13, ed = (idx & 8191) * 2;
            p[u] = (unsigned*)(LT + (size_t)bh * 64 * 16384 + ed); dp[u] = DEC + bh * 64 * 128 + (ed & 127); }
#pragma nounroll
        for (int cb = 0; cb < 64; cb += 16) {
            unsigned L[16][2]; float d0[16][2], d1[16][2];
#pragma unroll
            for (int j = 0; j < 16; ++j)
#pragma unroll
                for (int u = 0; u < 2; ++u) { L[j][u] = p[u][(size_t)(cb + j) * 8192]; const float* q = dp[u] + (cb + j) * 128; d0[j][u] = q[0]; d1[j][u] = q[1]; }
#pragma unroll
            for (int j = 0; j < 16; ++j) { const size_t o = (size_t)(cb + j) * 8192;
                p[0][o] = pk2(S[0][0], S[0][1]); p[1][o] = pk2(S[1][0], S[1][1]);
#pragma unroll
                for (int u = 0; u < 2; ++u) { S[u][0] = d0[j][u] * S[u][0] + bflo(L[j][u]); S[u][1] = d1[j][u] * S[u][1] + bfhi(L[j][u]); } }
        }
    }
}
__device__ __forceinline__ void hgrn_passC(unsigned char* lds, const float* __restrict__ LF, const bf16_t* __restrict__ Qs, const bf16_t* __restrict__ Kb, const bf16_t* __restrict__ Vb,
                                           const bf16_t* __restrict__ Gs, const bf16_t* __restrict__ ST, const float* __restrict__ gain, bf16_t* __restrict__ OHG,
                                           int blk, int nblk, int tid, int wave, int lane) {
    float* G = (float*)lds; bf16_t* qt = (bf16_t*)(lds + 32768); bf16_t* kt = (bf16_t*)(lds + 50176); bf16_t* vT = (bf16_t*)(lds + 67584);
    bf16_t* Ab = (bf16_t*)(lds + 86016); float* osm = (float*)(lds + 95232);
    HgrnIn in;
    { int b0 = blk; asm volatile("" : "+s"(b0)); if (b0 < 2048) hgrn_load<true>(in, LF, Qs, Kb, Vb, b0, tid); }
    for (int item = blk; item < 2048; item += nblk) {
        const int bh = item >> 6, c = item & 63, b = bh >> 4, h = bh & 15, r0 = b * SEQ + c * 64, cb = h * 128;
        u32x4 sreg[8]; { const bf16_t* Sp0 = ST + (size_t)item * 16384 + (size_t)((wave & 3) * 32 + (lane & 31)) * 128 + (lane >> 5) * 8;
#pragma unroll
            for (int kk = 0; kk < 8; ++kk) sreg[kk] = *(const u32x4*)(Sp0 + kk * 16); }
        const size_t gog = (size_t)(r0 + (tid >> 3)) * DM + cb + (tid & 7) * 16;
        const u32x4 ga = *(const u32x4*)(Gs + gog), gb = *(const u32x4*)(Gs + gog + 8);
        hgrn_prep(in, G, (float*)(lds + 129024), tid);
#pragma unroll
        for (int rr = 0; rr < 2; ++rr) { const int i = tid + 512 * rr, t = i >> 4, d8 = (i & 15) * 8;
            const u32x4 qq = in.a[rr], kk = in.b[rr], vv = in.c[rr];
            u32x4 qo, ko;
#pragma unroll
            for (int j = 0; j < 4; ++j) { const int d = d8 + 2 * j; const float g0 = G[t * 128 + d], g1 = G[t * 128 + d + 1];
                qo[j] = pk2(bflo(qq[j]) * __expf(g0), bfhi(qq[j]) * __expf(g1));
                ko[j] = pk2(bflo(kk[j]) * __expf(-g0), bfhi(kk[j]) * __expf(-g1));
                vT[tsw_wr(d, t)] = (bf16_t)(vv[j] & 0xffffu); vT[tsw_wr(d + 1, t)] = (bf16_t)(vv[j] >> 16); }
            *(u32x4*)(qt + t * 136 + d8) = qo; *(u32x4*)(kt + t * 136 + d8) = ko; }
        if (item + nblk < 2048) hgrn_load<true>(in, LF, Qs, Kb, Vb, item + nblk, tid);
        lds_barrier();
        const int r = lane & 31, hq = lane >> 5;
        if (wave < 4) { const int tt = wave >> 1, st = wave & 1; f32x16 acc = {};
#pragma unroll
            for (int kk = 0; kk < 8; ++kk) {
                const bf16x8 av = *(const bf16x8*)(qt + (tt * 32 + r) * 136 + kk * 16 + hq * 8);
                const bf16x8 bv = *(const bf16x8*)(kt + (st * 32 + r) * 136 + kk * 16 + hq * 8);
                acc = __builtin_amdgcn_mfma_f32_32x32x16_bf16(av, bv, acc, 0, 0, 0); }
#pragma unroll
            for (int reg = 0; reg < 16; ++reg) { const int t = tt * 32 + (reg & 3) + 8 * (reg >> 2) + 4 * hq, s = st * 32 + r;
                Ab[t * 72 + s] = f2bf(s <= t ? acc[reg] : 0.f); } }
        lds_barrier();
        { const int tt = wave >> 2, et = wave & 3; f32x16 acc = {};
#pragma unroll
            for (int kk = 0; kk < 8; ++kk) {
                const bf16x8 av = *(const bf16x8*)(qt + (tt * 32 + r) * 136 + kk * 16 + hq * 8);
                const u32x4 bw = sreg[kk];
                acc = __builtin_amdgcn_mfma_f32_32x32x16_bf16(av, *(const bf16x8*)&bw, acc, 0, 0, 0); }
#pragma unroll
            for (int kk = 0; kk < 4; ++kk) {
                const bf16x8 av = *(const bf16x8*)(Ab + (tt * 32 + r) * 72 + kk * 16 + hq * 8);
                const bf16x8 bv = *(const bf16x8*)(vT + tsw_rd(et * 32 + r, kk * 2 + hq));
                acc = __builtin_amdgcn_mfma_f32_32x32x16_bf16(av, bv, acc, 0, 0, 0); }
#pragma unroll
            for (int reg = 0; reg < 16; ++reg) { const int t = tt * 32 + (reg & 3) + 8 * (reg >> 2) + 4 * hq; osm[t * 132 + et * 32 + r] = acc[reg]; } }
        lds_barrier();
        { const int row = tid >> 3, j = tid & 7; f32x4 o[4]; float ss = 0.f;
#pragma unroll
            for (int q = 0; q < 4; ++q) { o[q] = *(const f32x4*)(osm + row * 132 + j * 16 + q * 4); ss += (o[q].x * o[q].x + o[q].y * o[q].y) + (o[q].z * o[q].z + o[q].w * o[q].w); }
            ss += __shfl_xor(ss, 1); ss += __shfl_xor(ss, 2); ss += __shfl_xor(ss, 4);
            const float rstd = rsqrtf(ss * (1.f / 128.f) + 1e-6f);
            const size_t go = (size_t)(r0 + row) * DM + cb + j * 16;
            u32x4 wa, wb;
#pragma unroll
            for (int q = 0; q < 4; ++q) { const f32x4 gn = *(const f32x4*)(gain + j * 16 + q * 4); const f32x4 v = o[q] * rstd * gn;
                const unsigned g01 = q < 2 ? ga[2 * q] : gb[2 * (q - 2)], g23 = q < 2 ? ga[2 * q + 1] : gb[2 * (q - 2) + 1];
                const unsigned w0 = pk2(v.x * bflo(g01), v.y * bfhi(g01)), w1 = pk2(v.z * bflo(g23), v.w * bfhi(g23));
                if (q < 2) { wa[2 * q] = w0; wa[2 * q + 1] = w1; } else { wb[2 * (q - 2)] = w0; wb[2 * (q - 2) + 1] = w1; } }
            *(u32x4*)(OHG + go) = wa; *(u32x4*)(OHG + go + 8) = wb; }
        lds_barrier();
    }
}

typedef attn::BlockRef<attn::bf16, attn::bf16> ABR;
__device__ __forceinline__ ABR attn_ref(int L, int pass, const attn::bf16* Qh, const attn::bf16* Kh, const attn::bf16* Vh, attn::bf16* Oh) {
    const int qh = L >> 3, x = L & 7, qb = pass ? 15 - x : x, bhc = qh >> 1, bh = qh >> 2, vh = qh & 1;
    ABR r;
    r.Q = Qh + ((size_t)bhc * SEQ + (size_t)qb * 256) * 128; r.K = Kh + (size_t)bhc * SEQ * 128; r.V = Vh + (size_t)(bh * 2 + vh) * SEQ * 128;
    r.O = Oh + ((size_t)qh * SEQ + (size_t)qb * 256) * 128; r.P0 = qb * 256;
    return r;
}
__device__ __forceinline__ void attn_phase(char* lds, const attn::bf16* Qh, const attn::bf16* Kh, const attn::bf16* Vh, attn::bf16* Oh, int blk, int nblk) {
    constexpr int NITEMS = 256, W = 1 << 20;
    int L = (nblk == 256) ? ((blk & 7) * 32 + (blk >> 3)) : blk; if (L >= NITEMS) return;
    int pass = 0; ABR cur = attn_ref(L, 0, Qh, Kh, Vh, Oh);
    attn::Seam<attn::bf16> S;
    attn::causal_swa_prime<attn::bf16, attn::bf16>(cur, W, lds, S);
    for (;;) {
        const bool more_pass = pass == 0, more_item = L + nblk < NITEMS, last = !more_pass && !more_item;
        int passn = pass + 1, Ln = L;
        if (!more_pass) { passn = 0; Ln = more_item ? L + nblk : L; }
        const ABR nxt = last ? cur : attn_ref(Ln, passn, Qh, Kh, Vh, Oh);
        attn::causal_swa_block<attn::bf16, attn::bf16>(cur, nxt, SEQ, W, lds, S);
        if (last) break;
        cur = nxt; pass = passn; L = Ln;
    }
}

#define XB_TMO      128
#define XB_XCNT(j)  (256  + 64 * (j))
#define XB_XSUB(j)  (1280 + 64 * (j))
#define XB_XGEN(j)  (2304 + 64 * (j))
#define XB_TOP      3328
#define XB_TOPGEN   3392
#define XCD_BAR_WORDS 3456
#define XB_SPIN_CAP (1u << 18)

__device__ __forceinline__ unsigned xb_ld(unsigned* p)              { return __hip_atomic_load(p, __ATOMIC_RELAXED, __HIP_MEMORY_SCOPE_AGENT); }
__device__ __forceinline__ unsigned xb_add(unsigned* p, unsigned v) { return __hip_atomic_fetch_add(p, v, __ATOMIC_RELAXED, __HIP_MEMORY_SCOPE_AGENT); }
__device__ __forceinline__ unsigned xb_xcc_id() { return (unsigned)__builtin_amdgcn_s_getreg((3 << 11) | 20) & 0xFu; }
#define XB_SPIN(cond, bar) do { unsigned _sp = 0; while (cond) { __builtin_amdgcn_s_sleep(1); \
    if ((++_sp & 255u) == 0u) { if (xb_ld(&(bar)[XB_TMO])) break; if (_sp > XB_SPIN_CAP) { atomicAdd(&(bar)[XB_TMO], 1u); break; } } } } while (0)

struct XcdBarrier {
    unsigned* bar; unsigned x;
    volatile unsigned* st;
};

__device__ __forceinline__ XcdBarrier xcd_barrier_post(unsigned* bar, volatile unsigned* st) {
    XcdBarrier b; b.bar = bar; b.x = xb_xcc_id(); b.st = st;
    if (otid() == 0) (void)xb_add(&bar[XB_XCNT(b.x)], 1u);
    return b;
}
__device__ __forceinline__ void xcd_barrier_complete(unsigned* bar, unsigned x, unsigned& nloc, unsigned& nx) {
    const unsigned G = gridDim.x * gridDim.y * gridDim.z;
    unsigned sum, cnt, mine, sp = 0u;
    for (;;) {
        sum = 0u; cnt = 0u; mine = 0u;
#pragma unroll
        for (unsigned j = 0; j < 16; ++j) { const unsigned c = xb_ld(&bar[XB_XCNT(j)]); sum += c; cnt += (c > 0u) ? 1u : 0u; mine = (j == x) ? c : mine; }
        if (sum == G) break;
        __builtin_amdgcn_s_sleep(1);
        if ((++sp & 255u) == 0u) { if (xb_ld(&bar[XB_TMO])) break; if (sp > XB_SPIN_CAP) { atomicAdd(&bar[XB_TMO], 1u); break; } }
    }
    nloc = mine > 0u ? mine : 1u; nx = cnt > 0u ? cnt : 1u;
}

__device__ __forceinline__ void xcd_barrier(const XcdBarrier& b) {
    asm volatile("s_waitcnt vmcnt(0)" ::: "memory");
    __syncthreads();
    if (otid() == 0) {
        unsigned* bar = b.bar;
        __builtin_amdgcn_s_waitcnt(0);
        unsigned nloc = b.st[0], nx = b.st[1];
        if (nloc == 0u) { xcd_barrier_complete(bar, b.x, nloc, nx); b.st[0] = nloc; b.st[1] = nx; }
        const unsigned old = xb_add(&bar[XB_XSUB(b.x)], 1u);
        const unsigned gen = old / nloc;
        if (old + 1u == (gen + 1u) * nloc) {
            __builtin_amdgcn_fence(__ATOMIC_RELEASE, "agent");
            asm volatile("s_waitcnt vmcnt(0)" ::: "memory");
            const unsigned og = xb_add(&bar[XB_TOP], 1u);
            const unsigned tg = og / nx;
            if (og + 1u == (tg + 1u) * nx) xb_add(&bar[XB_TOPGEN], 1u);
            else XB_SPIN(xb_ld(&bar[XB_TOPGEN]) == tg, bar);
            __builtin_amdgcn_fence(__ATOMIC_ACQUIRE, "agent");
            xb_add(&bar[XB_XGEN(b.x)], 1u);
            asm volatile("s_waitcnt vmcnt(0)" ::: "memory");
        } else {
            XB_SPIN(xb_ld(&bar[XB_XGEN(b.x)]) == gen, bar);
            __builtin_amdgcn_fence(__ATOMIC_ACQUIRE, "agent");
            asm volatile("s_waitcnt vmcnt(0)" ::: "memory");
        }
    }
    __syncthreads();
}

__device__ __forceinline__ int opq(int i) { asm volatile("" : "+s"(i)); return i; }
#define inptr(i) (a.in[opq(i)])
struct Args { const void* in[26]; float* out; unsigned char* ws; int ph_lo, ph_hi; };

__device__ __forceinline__ void convert_layer(const Args& a, unsigned char* ws, int l, unsigned jobmask, unsigned char* lds, int tid, int wave, int gw, int NGW, int lane) {
    ConvJob* tab = (ConvJob*)(lds + 8 * 8704);
    if (tid == 0) { int start = 0;
#pragma nounroll
        for (int j = 0; j < 14; ++j) {
            const float* W = nullptr; const float* ksc = nullptr; int K = 0, N = 0, ldd = 0, mode = 0; bf16_t* dst = nullptr;
            switch (j) {
                case 0: W = (const float*)inptr(4) + (size_t)l * DM * DFF; K = DM; N = DFF; dst = (bf16_t*)(ws + WS_WGU1 * MiB); ldd = DM; mode = 1; ksc = (const float*)inptr(3) + l * DM; break;
                case 1: W = (const float*)inptr(5) + (size_t)l * DM * DFF; K = DM; N = DFF; dst = (bf16_t*)(ws + WS_WGU1 * MiB); ldd = DM; mode = 2; ksc = (const float*)inptr(3) + l * DM; break;
                case 2: W = (const float*)inptr(6) + (size_t)l * DM * DFF; K = DFF; N = DM; dst = (bf16_t*)(ws + WS_WD1 * MiB); ldd = DFF; break;
                case 3: W = (const float*)inptr(9) + (size_t)l * DM * DFF; K = DM; N = DFF; dst = (bf16_t*)(ws + WS_WGU2 * MiB); ldd = DM; mode = 1; ksc = (const float*)inptr(8) + l * DM; break;
                case 4: W = (const float*)inptr(10) + (size_t)l * DM * DFF; K = DM; N = DFF; dst = (bf16_t*)(ws + WS_WGU2 * MiB); ldd = DM; mode = 2; ksc = (const float*)inptr(8) + l * DM; break;
                case 5: W = (const float*)inptr(11) + (size_t)l * DM * DFF; K = DFF; N = DM; dst = (bf16_t*)(ws + WS_WD2 * MiB); ldd = DFF; break;
                case 6: W = (const float*)inptr(13) + (size_t)l * DM * DM; K = DM; N = DM; dst = (bf16_t*)(ws + WS_WPG * MiB); ldd = DM; ksc = (const float*)inptr(12) + l * DM; break;
                case 7: W = (const float*)inptr(14) + (size_t)l * PLED * DM; K = PLED; N = DM; dst = (bf16_t*)(ws + WS_WPE * MiB); ldd = PLED; break;
                case 8: if (l == 0) { W = (const float*)inptr(15); K = DM; N = 4096; } else { W = (const float*)inptr(21); K = DM; N = 8192; } dst = (bf16_t*)(ws + WS_WMIXIN * MiB); ldd = DM; ksc = (const float*)inptr(7) + l * DM; break;
                case 9: W = (const float*)(l == 0 ? inptr(20) : inptr(24)); K = DM; N = DM; dst = (bf16_t*)(ws + WS_WMIXOUT * MiB); ldd = DM; break;
                default: if (l == 0) { const int g = j - 10; W = (const float*)inptr(16) + (size_t)g * 65536; K = 256; N = 256; dst = (bf16_t*)(ws + WS_WPOOL * MiB) + (size_t)g * 65536; ldd = 256; } else { W = (const float*)inptr(16); K = 0; N = 64; dst = (bf16_t*)(ws + WS_WPOOL * MiB); ldd = 256; } break;
            }
            if (!((jobmask >> j) & 1u)) K = 0;
            ConvJob jb; jb.W = W; jb.ksc = ksc; jb.dst = dst; jb.K = K; jb.N = N; jb.ldd = ldd; jb.mode = mode; jb.start = start; jb.pad = 0;
            tab[j] = jb; start += (K >> 5) * (N >> 6);
        }
        tab[14].start = start;
    }
    __syncthreads();
    const int total = tab[14].start; float* scr = (float*)(lds + wave * 8704);
    f32x4 va[8], vb[8];
    int g0 = gw; if (g0 < total) conv_load(tab, g0, va, lane);
#pragma nounroll
    for (;;) {
        if (g0 >= total) break;
        const int g1 = g0 + NGW; if (g1 < total) conv_load(tab, g1, vb, lane);
        conv_proc(tab, g0, va, scr, lane);
        if (g1 >= total) break;
        g0 = g1 + NGW; if (g0 < total) conv_load(tab, g0, va, lane);
        conv_proc(tab, g1, vb, scr, lane);
    }
    __syncthreads();
}
#ifndef KMASK
#define KMASK 0xFFF
#endif
#define KON(k) if constexpr (((KMASK) >> (k)) & 1)
#define LOCAL_IDS const int tid = otid(), lane = tid & 63, wave = __builtin_amdgcn_readfirstlane(tid >> 6), gw = blk * 8 + wave; (void)gw; (void)lane
__global__ void __launch_bounds__(512, 2) mega_fwd(Args a) {
    extern __shared__ __attribute__((aligned(16))) unsigned char lds[];
    cg::grid_group grid = cg::this_grid();
    const int G = gridDim.x, blk = blockIdx.x, NGW = G * 8;
    volatile unsigned* bst = (volatile unsigned*)(lds + 131072);
    if (otid() < 2) bst[otid()] = 0u;
    __syncthreads();
    XcdBarrier xbar = xcd_barrier_post((unsigned*)(a.ws + CTL_BAR_BYTE), bst);
    for (int ph = a.ph_lo; ph < a.ph_hi; ++ph) {
        size_t zoff = 0; asm volatile("" : "+s"(zoff));
        unsigned char* ws = a.ws + zoff; float* out = a.out + zoff;
        float* ctl = (float*)(ws + WS_CTL * MiB);
        float* rope = (float*)(ws + WS_ROPE * MiB);
        bf16_t* Hb = (bf16_t*)(ws + WS_H * MiB);
        bf16_t* GU = (bf16_t*)(ws + WS_GU * MiB);
        bf16_t* PE = (bf16_t*)(ws + WS_PE * MiB);
        bf16_t* PB = (bf16_t*)(ws + WS_PB * MiB);
        int kind = 0, l = 0, sub = 0;
        if (ph > 0) { l = ph >= 11 ? 1 : 0; const int r = ph - (l ? 11 : 1);
            const unsigned long long kk = l ? 0x37212BA9821ULL : 0x3721265421ULL, ss = l ? 0x40112000000ULL : 0x3011200000ULL;
            kind = (int)((kk >> (4 * r)) & 15ULL); sub = (int)((ss >> (4 * r)) & 15ULL); }
        unsigned long long* SS = (unsigned long long*)(ws + CTL_SS_BYTE);
#ifdef DUPMASK
        const int nrep = (((DUPMASK) >> kind) & 1) && kind != 2 && kind != 7 && kind != 10 && !(kind == 3 && sub == 4) ? 2 : 1;
#else
        const int nrep = 1;
#endif
        for (int rep = 0; rep < nrep; ++rep)
        switch (kind) {
        case 0: KON(0) {
            LOCAL_IDS;
            convert_layer(a, ws, 0, G == 256 ? 0x3FDBu : 0x3FFFu, lds, tid, wave, gw, NGW, lane);
            for (int i = blk * 512 + tid; i < 8 * 8192; i += G * 512) SS[8192 + i] = 0ull;
            { const f32x4* __restrict__ p4 = (const f32x4*)inptr(1); u32x2* __restrict__ o = (u32x2*)PB; const int n4 = 2 * MTOK * PLED / 4;
#pragma unroll 4
              for (int i = blk * 512 + tid; i < n4; i += G * 512) { const f32x4 v = p4[i]; u32x2 w; w.x = pk2(v.x, v.y); w.y = pk2(v.z, v.w); o[i] = w; } }
            { const int* pos = (const int*)inptr(2);
              for (int i = blk * 512 + tid; i < MTOK * 16; i += G * 512) { const int row = i >> 4, j = i & 15;
                  const float inv_freq = exp2f(-(float)j * (18.931568569324174f / 16.f));
                  const float ang = (float)pos[row] * inv_freq;
                  double rev = (double)ang * 0.15915494309189535; rev -= floor(rev);
                  const float rf = (float)rev;
                  rope[row * 32 + j] = __builtin_amdgcn_cosf(rf); rope[row * 32 + 16 + j] = __builtin_amdgcn_sinf(rf); } }
            if (blk == 0) {
                if (wave == 0) { const float* lp = (const float*)inptr(18); float s1 = 0.f, s2 = 0.f;
                    for (int i = lane; i < 128; i += 64) { s1 += lp[i] * lp[128 + i]; s2 += lp[256 + i] * lp[384 + i]; }
                    s1 = wave_sum(s1); s2 = wave_sum(s2);
                    if (lane == 0) ctl[CTL_LAM] = expf(s1) - expf(s2) + 0.2f; }
                const float* lb = (const float*)inptr(22);
                for (int i = tid; i < DM; i += 512) { const float b0 = lb[i], b1 = lb[DM + i], mx = fmaxf(b0, b1), e0 = expf(b0 - mx), e1 = expf(b1 - mx); ctl[CTL_LBS + i] = e1 / (e0 + e1); }
            }
            prep_rows((const float*)inptr(0), (bf16_t*)(ws + WS_LT * MiB), SS, gw, NGW, lane);
        } break;
        case 1: KON(1) {
            { pg8::Gemm g{sub ? Hb : (const bf16_t*)(ws + WS_LT * MiB), (const bf16_t*)(ws + (sub ? WS_WGU2 : WS_WGU1) * MiB), MTOK, 2 * DFF, DM, DM, DM, 0}; pg8::StaticOrder S; S.init(MTOK, 2 * DFF, G, blk);
              pg8::EpiSwiGLU E{GU, DFF, SS + 8192 * (4 * l + (sub ? 2 : 0))};
              pg8::gemm_phase<pg8::EpiSwiGLU, pg8::StaticOrder, true, true>((PG8_LAS unsigned char*)lds, g, S, E); }
            if (sub) { pg8::Gemm g{PB + (size_t)l * MTOK * PLED, (const bf16_t*)(ws + WS_WPE * MiB), MTOK, DM, PLED, PLED, PLED, 0}; asm volatile("" : "+s"(g.K)); pg8::StaticOrder S; S.init(MTOK, DM, G, blk);
              pg8::EpiF32<2> E{nullptr, nullptr, nullptr, PE, nullptr, ws, 1, 0, 0};
              pg8::gemm_phase<pg8::EpiF32<2>, pg8::StaticOrder, true, true>((PG8_LAS unsigned char*)lds, g, S, E); }
            if (G == 256 && blk >= 128) { LOCAL_IDS; convert_layer(a, ws, l, sub ? 0x20u : 0x4u, lds, tid, wave, (blk - 128) * 8 + wave, 128 * 8, lane); }
        } break;
        case 2: KON(2) {
            pg8::Gemm g; const float* basef = (l == 0 && sub == 0) ? (const float*)inptr(0) : nullptr;
            const bf16_t* baseb = (l == 1 && sub == 0) ? (const bf16_t*)(ws + WS_LT * MiB) : Hb;
            if (sub == 2) { g = pg8::Gemm{(const bf16_t*)(ws + (l ? WS_OHG : WS_CC) * MiB), (const bf16_t*)(ws + WS_WMIXOUT * MiB), MTOK, DM, DM, DM, DM, 0}; }
            else { g = pg8::Gemm{GU, (const bf16_t*)(ws + (sub ? WS_WD2 : WS_WD1) * MiB), MTOK, DM, DFF, DFF, DFF, 0}; }
            pg8::StaticOrder S; S.init(MTOK, DM, G, blk);
            pg8::EpiF32<0> E{basef, baseb, nullptr, Hb, nullptr, ws, sub == 2 ? 1 : 0, 4 * l + (sub == 0 ? 1 : sub == 2 ? 2 : 3), 0};
            pg8::gemm_phase<pg8::EpiF32<0>, pg8::StaticOrder, true, true>((PG8_LAS unsigned char*)lds, g, S, E);
        } break;
        case 3: KON(3) {
            LOCAL_IDS;
            if (sub == 3) convert_layer(a, ws, 1, G == 256 ? 0x3FDBu : 0x3FFFu, lds, tid, wave, gw, NGW, lane);
            else final_rows(out, (const float*)inptr(25), SS + 8192 * 8, gw, NGW, lane);
        } break;
        case 4: KON(4) {
            pg8::Gemm g{Hb, (const bf16_t*)(ws + WS_WMIXIN * MiB), MTOK, 4096, DM, DM, DM, 0}; pg8::StaticOrder S; S.init(MTOK, 4096, G, blk);
            pg8::EpiABin E{(float*)(ws + WS_U * MiB), (bf16_t*)(ws + WS_QH * MiB), rope, SS + 8192 * 1};
            pg8::gemm_phase<pg8::EpiABin, pg8::StaticOrder, true, true>((PG8_LAS unsigned char*)lds, g, S, E);
        } break;
        case 5: KON(5) {
            { LOCAL_IDS; pool_diff((const float*)(ws + WS_U * MiB), (bf16_t*)(ws + WS_DP * MiB), blk, G, tid); }
            attn_phase((char*)lds, (const attn::bf16*)(ws + WS_QH * MiB), (const attn::bf16*)(ws + WS_KH * MiB), (const attn::bf16*)(ws + WS_VH * MiB), (attn::bf16*)(ws + WS_OH * MiB), blk, G);
        } break;
        case 6: KON(6) {
            { pg8::Gemm g{(const bf16_t*)(ws + WS_DP * MiB), (const bf16_t*)(ws + WS_WPOOL * MiB), MTOK, 1024, 256, 1024, 256, 512}; asm volatile("" : "+s"(g.K)); pg8::StaticOrder S; S.init(MTOK, 1024, G, blk);
              pg8::EpiPool E{(bf16_t*)(ws + WS_CC * MiB), DM, (const float*)inptr(17)};
              pg8::gemm_phase<pg8::EpiPool, pg8::StaticOrder, true, true>((PG8_LAS unsigned char*)lds, g, S, E); }
            LOCAL_IDS;
            attn_combine((const bf16_t*)(ws + WS_OH * MiB), (const float*)inptr(19), ctl + CTL_LAM, (bf16_t*)(ws + WS_CC * MiB), gw, NGW, lane);
        } break;
        case 7: KON(7) {
            pg8::Gemm g{Hb, (const bf16_t*)(ws + WS_WPG * MiB), MTOK, DM, DM, DM, DM, 0}; pg8::StaticOrder S; S.init(MTOK, DM, G, blk);
            pg8::EpiF32<1> E{nullptr, Hb, l ? out : nullptr, (bf16_t*)(ws + WS_LT * MiB), PE, ws, 1, 4 * l + 4, 4 * l + 3};
            pg8::gemm_phase<pg8::EpiF32<1>, pg8::StaticOrder, true, true>((PG8_LAS unsigned char*)lds, g, S, E);
        } break;
        case 8: KON(8) {
            pg8::Gemm g{Hb, (const bf16_t*)(ws + WS_WMIXIN * MiB), MTOK, 8192, DM, DM, DM, 0}; pg8::StaticOrder S; S.init(MTOK, 8192, G, blk);
            pg8::EpiHin E{(bf16_t*)(ws + WS_QS * MiB), (float*)(ws + WS_LF * MiB), ctl + CTL_LBS, SS + 8192 * 5};
            pg8::gemm_phase<pg8::EpiHin, pg8::StaticOrder, true, true>((PG8_LAS unsigned char*)lds, g, S, E);
        } break;
        case 9: KON(9) { LOCAL_IDS; hgrn_passA(lds, (const float*)(ws + WS_LF * MiB), (const bf16_t*)(ws + WS_KB * MiB), (const bf16_t*)(ws + WS_VB * MiB), (bf16_t*)(ws + WS_LT * MiB), (float*)(ws + WS_DEC * MiB), blk, G, tid, wave, lane); } break;
        case 10: KON(10) { LOCAL_IDS; hgrn_scan((bf16_t*)(ws + WS_LT * MiB), (const float*)(ws + WS_DEC * MiB), blk * 512 + tid, G * 512); } break;
        case 11: KON(11) { LOCAL_IDS; hgrn_passC(lds, (const float*)(ws + WS_LF * MiB), (const bf16_t*)(ws + WS_QS * MiB), (const bf16_t*)(ws + WS_KB * MiB), (const bf16_t*)(ws + WS_VB * MiB), (const bf16_t*)(ws + WS_GS * MiB),
                            (const bf16_t*)(ws + WS_LT * MiB), (const float*)inptr(23), (bf16_t*)(ws + WS_OHG * MiB), blk, G, tid, wave, lane); } break;
        default: break;
        }
#ifdef DUPSYNC
        for (int srep = 0; srep < 2; ++srep)
#endif
        if (ph + 1 < a.ph_hi) {
            { int phh = a.ph_hi; asm volatile("" : "+s"(phh)); if (phh > 1000) grid.sync(); }
            xcd_barrier(xbar);
        }
    }
}

#ifndef MK_MULTI
#define MK_MULTI 0
#endif
extern "C" void kernel_launch(void* const* d_in, const int* in_sizes, int n_in, void* d_out, int out_size, void* d_ws, size_t ws_size, hipStream_t stream) {
    static int grid = 0;
    if (grid == 0) {
        if (n_in != 26 || out_size != MTOK * DM || ws_size < WS_END * MiB) { fprintf(stderr, "kernel_launch: unexpected shapes (n_in %d, out %d, ws %zu)\n", n_in, out_size, ws_size); grid = -1; return; }
        int dev = 0, cus = 0, per_cu = 0;
        (void)hipGetDevice(&dev); (void)hipDeviceGetAttribute(&cus, hipDeviceAttributeMultiprocessorCount, dev);
        (void)hipFuncSetAttribute((const void*)mega_fwd, hipFuncAttributeMaxDynamicSharedMemorySize, LDS_BYTES);
        (void)hipOccupancyMaxActiveBlocksPerMultiprocessor(&per_cu, (const void*)mega_fwd, 512, LDS_BYTES);
        if (per_cu < 1) { fprintf(stderr, "kernel_launch: occupancy query says %d blocks per CU\n", per_cu); per_cu = 1; }
        (void)hipGetLastError();
        grid = cus > 0 ? cus : 256;
    }
    if (grid < 0) return;
    (void)hipMemsetAsync((char*)d_ws + CTL_BAR_BYTE, 0, CTL_BAR_BYTES, stream);
    Args a{};
    for (int i = 0; i < 26; ++i) a.in[i] = d_in[i];
    a.out = (float*)d_out; a.ws = (unsigned char*)d_ws;
#if MK_MULTI
    for (int ph = 0; ph < NPH; ++ph) { a.ph_lo = ph; a.ph_hi = ph + 1; hipLaunchKernelGGL(mega_fwd, dim3(grid), dim3(512), LDS_BYTES, stream, a); }
#else
    a.ph_lo = 0; a.ph_hi = NPH;
    void* args[] = {&a};
    hipError_t e = hipLaunchCooperativeKernel((const void*)mega_fwd, dim3(grid), dim3(512), args, LDS_BYTES, stream);
    if (e != hipSuccess) fprintf(stderr, "cooperative launch failed: %s (grid %d)\n", hipGetErrorString(e), grid);
#ifdef PROBE_LIST
    { const int plist[] = PROBE_LIST;
      for (int p : plist) { Args a2 = a; a2.out = (float*)((char*)d_ws + WS_LT * MiB); a2.ph_lo = p; a2.ph_hi = p + 1; void* args2[] = {&a2};
          (void)hipLaunchCooperativeKernel((const void*)mega_fwd, dim3(grid), dim3(512), args2, LDS_BYTES, stream); } }
#endif
#endif
}
```

```cpp
#include <hip/hip_runtime.h>
#include <hip/hip_bf16.h>
#include <hip/hip_cooperative_groups.h>
#include <cstdio>
#include <cstdint>
namespace cg = cooperative_groups;
__device__ __forceinline__ int otid() { int t = threadIdx.x; asm volatile("" : "+v"(t)); return t; }

namespace pg8 {
#define PG8_LAS __attribute__((address_space(3)))
typedef unsigned short bf16_t;
typedef short bf16x8 __attribute__((ext_vector_type(8)));
typedef float f32x4 __attribute__((ext_vector_type(4)));
typedef unsigned u32x4 __attribute__((ext_vector_type(4)));
typedef unsigned u32x2 __attribute__((ext_vector_type(2)));
constexpr int BM = 256, BK = 64, HALF = 128, HTB = HALF * BK * 2, STAGE_BYTES = 8 * HTB, NXCD = 8, WGM = 8;

__host__ __device__ __forceinline__ int lds_byte(int r, int c) { const int st = (r >> 4) * 2 + (c >> 5), rr = r & 15, cc = c & 31, ob = rr * 64 + cc * 2; return st * 1024 + (ob ^ (((ob >> 9) & 1) << 5)); }
__host__ __device__ __forceinline__ void stage_rc(int b, int& R, int& C) { const int st = b / 1024, sb = b % 1024, swz = sb ^ (((sb >> 9) & 1) << 5); R = (st >> 1) * 16 + swz / 64; C = (st & 1) * 32 + (swz % 64) / 2; }
__host__ __device__ __forceinline__ int perm32(int rho) { const int n = rho >> 4, i = rho & 15; return 8 * (i >> 2) + 4 * n + (i & 3); }

struct Unit { int pm, pn; };
struct Gemm { const bf16_t* A; const bf16_t* Bt; int M, N, K, lda, ldb; size_t apn; };

struct StaticOrder {
    int nM, nN, nwg, G, c;
    __host__ __device__ void init(int M, int N, int G_, int c_) { nM = M / BM; nN = N / BM; nwg = nM * nN; G = G_; c = c_; }
    __host__ __device__ bool next(int i, Unit& u) const {
        const long L = (long)i * G + c; if (L >= nwg) return false;
        int wgid = (int)L; { const int q = nwg / NXCD, r = nwg % NXCD, xcd = wgid % NXCD, off = wgid / NXCD; wgid = (xcd < r ? xcd * (q + 1) : r * (q + 1) + (xcd - r) * q) + off; }
        const int nig = WGM * nN, gid = wgid / nig, fm = gid * WGM, gsz = (nM - fm) < WGM ? (nM - fm) : WGM;
        u.pm = fm + ((wgid % nig) % gsz); u.pn = (wgid % nig) / gsz; return true;
    }
    __device__ __forceinline__ void a_ready(const Unit&) const {}
    __device__ __forceinline__ void done(const Unit&) const {}
};

__device__ __forceinline__ unsigned cvt_pk_bf16(float lo, float hi) { unsigned r; asm volatile("v_cvt_pk_bf16_f32 %0, %1, %2" : "=v"(r) : "v"(lo), "v"(hi)); return r; }
__device__ __forceinline__ float fsigmoid(float v) { return __builtin_amdgcn_rcpf(1.0f + __builtin_amdgcn_exp2f(-1.4426950408889634f * v)); }
__device__ __forceinline__ float fsilu(float v) { return v * fsigmoid(v); }


struct EpiSwiGLU {
    static constexpr bool PERM = true, AFTER_DRAIN = false, HAS_PRE = true;
    __device__ __forceinline__ void prefetch(const Unit& u, float (&pre)[2][4], int wr, int fr) const {
        const unsigned long long* sp = ssin + u.pm * BM + wr * 64 + fr;
#pragma unroll
        for (int ai = 0; ai < 2; ++ai)
#pragma unroll
            for (int m = 0; m < 4; ++m) pre[ai][m] = (float)sp[ai * HALF + m * 16] * (1.f / 1048576.f);
    }

    bf16_t* O; int ldc; const unsigned long long* ssin;
    __device__ __forceinline__ void operator()(const f32x4 (&acc)[2][2][4][2], const Unit& u, int wr, int wc, int fr_, int fq, const float (&pre)[2][4]) const {
        int fr = fr_; asm volatile("" : "+v"(fr));
        const int row0 = u.pm * BM + wr * 64 + fr, col0 = u.pn * HALF + wc * 32 + 8 * fq;
        float rs[2][4];
#pragma unroll
        for (int ai = 0; ai < 2; ++ai)
#pragma unroll
            for (int m = 0; m < 4; ++m) rs[ai][m] = rsqrtf(pre[ai][m] * (1.f / 2048.f) + 1e-6f);
#pragma unroll
        for (int ai = 0; ai < 2; ++ai)
#pragma unroll
            for (int m = 0; m < 4; ++m) { bf16_t* rowp = O + (size_t)(row0 + ai * HALF + m * 16) * ldc + col0; const float r = rs[ai][m];
                f32x4 g0 = acc[ai][0][m][0] * r, g1 = acc[ai][0][m][1] * r, u0 = acc[ai][1][m][0] * r, u1 = acc[ai][1][m][1] * r;
                f32x4 v0, v1;
#pragma unroll
                for (int i = 0; i < 4; ++i) { v0[i] = fsilu(g0[i]) * u0[i]; v1[i] = fsilu(g1[i]) * u1[i]; }
                u32x4 w; w.x = cvt_pk_bf16(v0[0], v0[1]); w.y = cvt_pk_bf16(v0[2], v0[3]); w.z = cvt_pk_bf16(v1[0], v1[1]); w.w = cvt_pk_bf16(v1[2], v1[3]);
                __builtin_nontemporal_store(w, (u32x4*)rowp); asm volatile("" ::: "memory"); }
    }
};
template <int MODE> struct EpiF32 {
    static constexpr bool PERM = true, AFTER_DRAIN = false, HAS_PRE = (MODE == 1);
    __device__ __forceinline__ void prefetch(const Unit& u, float (&pre)[2][4], int wr, int fr) const {
        const unsigned long long* sp = ((const unsigned long long*)(wsb + 131072) + 8192 * slot_in) + u.pm * BM + wr * 64 + fr;
#pragma unroll
        for (int ai = 0; ai < 2; ++ai)
#pragma unroll
            for (int m = 0; m < 4; ++m) pre[ai][m] = (float)sp[ai * HALF + m * 16] * (1.f / 1048576.f);
    }
    const float* basef; const bf16_t* baseb; float* outf; bf16_t* outb; const bf16_t* pe; unsigned char* wsb; int full, slot_out, slot_in;
    static constexpr int ldc = 2048;
    __device__ __forceinline__ void operator()(const f32x4 (&acc)[2][2][4][2], const Unit& u, int wr, int wc, int fr_, int fq, const float (&pre)[2][4]) const {
        int fr = fr_; asm volatile("" : "+v"(fr));
        const int row0 = u.pm * BM + wr * 64 + fr, col0 = u.pn * BM + wc * 32 + 8 * fq;
        const float scale = full ? 1.f : 0.5f;
        unsigned long long* ssout = (unsigned long long*)(wsb + 131072) + 8192 * slot_out;
        float rs[2][4];
        if (MODE == 1) {
#pragma unroll
            for (int ai = 0; ai < 2; ++ai)
#pragma unroll
                for (int m = 0; m < 4; ++m) rs[ai][m] = rsqrtf(pre[ai][m] * (1.f / 2048.f) + 1e-6f);
        }
        constexpr int MB = (MODE == 1) ? 2 : 4;
#pragma unroll
        for (int ai = 0; ai < 2; ++ai)
#pragma unroll
        for (int m0 = 0; m0 < 4; m0 += MB) {
            u32x4 bw[MB][2], pw[MB][2];
            if (MODE != 2) {
#pragma unroll
                for (int mm = 0; mm < MB; ++mm)
#pragma unroll
                    for (int bj = 0; bj < 2; ++bj) { const size_t o2 = (size_t)(row0 + ai * HALF + (m0 + mm) * 16) * ldc + col0 + bj * HALF;
                        if (!(MODE == 0 && basef)) bw[mm][bj] = *(const u32x4*)(baseb + o2);
                        if (MODE == 1) pw[mm][bj] = *(const u32x4*)(pe + o2); }
            }
#pragma unroll
            for (int mm = 0; mm < MB; ++mm) { const int m = m0 + mm, row = row0 + ai * HALF + m * 16; float ssq = 0.f;
#pragma unroll
                for (int bj = 0; bj < 2; ++bj) { const size_t o2 = (size_t)row * ldc + col0 + bj * HALF; const f32x4 a0 = acc[ai][bj][m][0], a1 = acc[ai][bj][m][1]; f32x4 r0, r1, b0, b1;
                    if (MODE != 2) {
                        if (MODE == 0 && basef) { b0 = *(const f32x4*)(basef + o2); b1 = *(const f32x4*)(basef + o2 + 4); }
                        else { const u32x4 w = bw[mm][bj];
                            b0 = (f32x4){__uint_as_float(w.x << 16), __uint_as_float(w.x & 0xffff0000u), __uint_as_float(w.y << 16), __uint_as_float(w.y & 0xffff0000u)};
                            b1 = (f32x4){__uint_as_float(w.z << 16), __uint_as_float(w.z & 0xffff0000u), __uint_as_float(w.w << 16), __uint_as_float(w.w & 0xffff0000u)}; } }
                    if (MODE == 0) { r0 = b0 + a0 * scale; r1 = b1 + a1 * scale; }
                    else if (MODE == 1) { const u32x4 w = pw[mm][bj]; const float rr = rs[ai][m];
                        const f32x4 p0 = (f32x4){__uint_as_float(w.x << 16), __uint_as_float(w.x & 0xffff0000u), __uint_as_float(w.y << 16), __uint_as_float(w.y & 0xffff0000u)};
                        const f32x4 p1 = (f32x4){__uint_as_float(w.z << 16), __uint_as_float(w.z & 0xffff0000u), __uint_as_float(w.w << 16), __uint_as_float(w.w & 0xffff0000u)};
#pragma unroll
                        for (int i = 0; i < 4; ++i) { r0[i] = b0[i] + p0[i] * fsigmoid(a0[i] * rr); r1[i] = b1[i] + p1[i] * fsigmoid(a1[i] * rr); } }
                    else { r0 = a0; r1 = a1; }
                    if (MODE == 1 && outf) { *(f32x4*)(outf + o2) = r0; *(f32x4*)(outf + o2 + 4) = r1; }
                    else { u32x4 w; w.x = cvt_pk_bf16(r0[0], r0[1]); w.y = cvt_pk_bf16(r0[2], r0[3]); w.z = cvt_pk_bf16(r1[0], r1[1]); w.w = cvt_pk_bf16(r1[2], r1[3]); *(u32x4*)(outb + o2) = w; }
                    if (MODE != 2) ssq += ((r0[0] * r0[0] + r0[1] * r0[1]) + (r0[2] * r0[2] + r0[3] * r0[3])) + ((r1[0] * r1[0] + r1[1] * r1[1]) + (r1[2] * r1[2] + r1[3] * r1[3])); }
                if (MODE != 2) { ssq += __shfl_xor(ssq, 16); ssq += __shfl_xor(ssq, 32); if (fq == 0) __hip_atomic_fetch_add(ssout + row, (unsigned long long)(ssq * 1048576.f + 0.5f), __ATOMIC_RELAXED, __HIP_MEMORY_SCOPE_AGENT); } }
            asm volatile("" ::: "memory"); }
    }
};
struct EpiPool {
    static constexpr bool PERM = true, AFTER_DRAIN = false, HAS_PRE = false;
    bf16_t* O; int ldc; const float* cs;
    __device__ __forceinline__ void operator()(const f32x4 (&acc)[2][2][4][2], const Unit& u, int wr, int wc, int fr_, int fq, const float (&pre)[2][4]) const {
        int fr = fr_; asm volatile("" : "+v"(fr));
        const int row0 = u.pm * BM + wr * 64 + fr, col0 = u.pn * BM + wc * 32 + 8 * fq;
#pragma unroll
        for (int bj = 0; bj < 2; ++bj) { const f32x4 s0 = *(const f32x4*)(cs + col0 + bj * HALF), s1 = *(const f32x4*)(cs + col0 + bj * HALF + 4);
#pragma unroll
            for (int ai = 0; ai < 2; ++ai)
#pragma unroll
                for (int m = 0; m < 4; ++m) { bf16_t* rowp = O + (size_t)(row0 + ai * HALF + m * 16) * ldc + col0 + bj * HALF;
                    const f32x4 v0 = acc[ai][bj][m][0] * s0, v1 = acc[ai][bj][m][1] * s1;
                    u32x4 w; w.x = cvt_pk_bf16(v0[0], v0[1]); w.y = cvt_pk_bf16(v0[2], v0[3]); w.z = cvt_pk_bf16(v1[0], v1[1]); w.w = cvt_pk_bf16(v1[2], v1[3]);
                    *(u32x4*)rowp = w; asm volatile("" ::: "memory"); } }
    }
};
struct EpiABin {
    static constexpr bool PERM = true, AFTER_DRAIN = false, HAS_PRE = true;
    __device__ __forceinline__ void prefetch(const Unit& u, float (&pre)[2][4], int wr, int fr) const {
        const unsigned long long* sp = ssin + u.pm * BM + wr * 64 + fr;
#pragma unroll
        for (int ai = 0; ai < 2; ++ai)
#pragma unroll
            for (int m = 0; m < 4; ++m) pre[ai][m] = (float)sp[ai * HALF + m * 16] * (1.f / 1048576.f);
    }

    float* U; bf16_t* Qh; const float* rope; const unsigned long long* ssin;
    __device__ __forceinline__ void operator()(const f32x4 (&acc)[2][2][4][2], const Unit& u, int wr, int wc, int fr_, int fq, const float (&pre)[2][4]) const {
        int fr = fr_; asm volatile("" : "+v"(fr));
        const int row0 = u.pm * BM + wr * 64 + fr;
        float rs[2][4];
#pragma unroll
        for (int ai = 0; ai < 2; ++ai)
#pragma unroll
            for (int m = 0; m < 4; ++m) rs[ai][m] = rsqrtf(pre[ai][m] * (1.f / 2048.f) + 1e-6f);
        if (u.pn < 4) {
            const int col0 = u.pn * BM + wc * 32 + 8 * fq;
#pragma unroll
            for (int ai = 0; ai < 2; ++ai)
#pragma unroll
                for (int m = 0; m < 4; ++m) { float* rowp = U + (size_t)(row0 + ai * HALF + m * 16) * 1024 + col0; const float r = rs[ai][m];
#pragma unroll
                    for (int bj = 0; bj < 2; ++bj) { *(f32x4*)(rowp + bj * HALF) = acc[ai][bj][m][0] * r; *(f32x4*)(rowp + bj * HALF + 4) = acc[ai][bj][m][1] * r; } }
            return;
        }
        const int kind = u.pn >> 2, h = u.pn & 3, b = u.pm >> 4;
        bf16_t* dst = Qh + (size_t)(kind - 1) * 8388608;
        const bool do_rope = (kind != 3) && (wc == 0);
#pragma unroll
        for (int ai = 0; ai < 2; ++ai)
#pragma unroll
            for (int m = 0; m < 4; ++m) { const int row = row0 + ai * HALF + m * 16, s = row & 4095;
                f32x4 c0, c1, s0, s1;
                if (do_rope) { const float* rp = rope + (size_t)row * 32 + 8 * (fq & 1); c0 = *(const f32x4*)rp; c1 = *(const f32x4*)(rp + 4); s0 = *(const f32x4*)(rp + 16); s1 = *(const f32x4*)(rp + 20); }
#pragma unroll
                for (int bj = 0; bj < 2; ++bj) { f32x4 v0 = acc[ai][bj][m][0] * rs[ai][m], v1 = acc[ai][bj][m][1] * rs[ai][m];
                    if (do_rope) {
#pragma unroll
                        for (int i = 0; i < 4; ++i) { const float p0 = __shfl_xor(v0[i], 32), p1 = __shfl_xor(v1[i], 32);
                            v0[i] = (fq < 2) ? (v0[i] * c0[i] - p0 * s0[i]) : (v0[i] * c0[i] + p0 * s0[i]);
                            v1[i] = (fq < 2) ? (v1[i] * c1[i] - p1 * s1[i]) : (v1[i] * c1[i] + p1 * s1[i]); } }
                    bf16_t* p = dst + ((size_t)(((b * 4 + h) * 2 + bj) * 4096 + s)) * 128 + wc * 32 + 8 * fq;
                    u32x4 w; w.x = cvt_pk_bf16(v0[0], v0[1]); w.y = cvt_pk_bf16(v0[2], v0[3]); w.z = cvt_pk_bf16(v1[0], v1[1]); w.w = cvt_pk_bf16(v1[2], v1[3]);
                    *(u32x4*)p = w; }
                asm volatile("" ::: "memory"); }
    }
};
struct EpiHin {
    static constexpr bool PERM = true, AFTER_DRAIN = false, HAS_PRE = true;
    __device__ __forceinline__ void prefetch(const Unit& u, float (&pre)[2][4], int wr, int fr) const {
        const unsigned long long* sp = ssin + u.pm * BM + wr * 64 + fr;
#pragma unroll
        for (int ai = 0; ai < 2; ++ai)
#pragma unroll
            for (int m = 0; m < 4; ++m) pre[ai][m] = (float)sp[ai * HALF + m * 16] * (1.f / 1048576.f);
    }

    bf16_t* Qs; float* LF; const float* lbs; const unsigned long long* ssin;
    __device__ __forceinline__ void operator()(const f32x4 (&acc)[2][2][4][2], const Unit& u, int wr, int wc, int fr_, int fq, const float (&pre)[2][4]) const {
        int fr = fr_; asm volatile("" : "+v"(fr));
        const int row0 = u.pm * BM + wr * 64 + fr, split = u.pn >> 3, col0 = (u.pn & 7) * BM + wc * 32 + 8 * fq;
        bf16_t* dst = Qs + (size_t)split * 16777216;
        float rs[2][4];
#pragma unroll
        for (int ai = 0; ai < 2; ++ai)
#pragma unroll
            for (int m = 0; m < 4; ++m) rs[ai][m] = rsqrtf(pre[ai][m] * (1.f / 2048.f) + 1e-6f);
#pragma unroll
        for (int bj = 0; bj < 2; ++bj) {
            f32x4 l0 = {0.f, 0.f, 0.f, 0.f}, l1 = l0;
            if (split == 1) { l0 = *(const f32x4*)(lbs + col0 + bj * HALF); l1 = *(const f32x4*)(lbs + col0 + bj * HALF + 4); }
#pragma unroll
            for (int ai = 0; ai < 2; ++ai)
#pragma unroll
                for (int m = 0; m < 4; ++m) { const size_t off = (size_t)(row0 + ai * HALF + m * 16) * 2048 + col0 + bj * HALF;
                    f32x4 v0 = acc[ai][bj][m][0] * rs[ai][m], v1 = acc[ai][bj][m][1] * rs[ai][m];
                    if (split == 0 || split == 3) {
#pragma unroll
                        for (int i = 0; i < 4; ++i) { v0[i] = fsilu(v0[i]); v1[i] = fsilu(v1[i]); }
                    } else if (split == 1) { f32x4 f0, f1;
#pragma unroll
                        for (int i = 0; i < 4; ++i) { const float sg0 = fsigmoid(v0[i]), sg1 = fsigmoid(v1[i]);
                            f0[i] = __logf(l0[i] + (1.f - l0[i]) * sg0); f1[i] = __logf(l1[i] + (1.f - l1[i]) * sg1);
                            v0[i] = (1.f - l0[i]) * fsigmoid(-v0[i]); v1[i] = (1.f - l1[i]) * fsigmoid(-v1[i]); }
                        *(f32x4*)(LF + off) = f0; *(f32x4*)(LF + off + 4) = f1; }
                    u32x4 w; w.x = cvt_pk_bf16(v0[0], v0[1]); w.y = cvt_pk_bf16(v0[2], v0[3]); w.z = cvt_pk_bf16(v1[0], v1[1]); w.w = cvt_pk_bf16(v1[2], v1[3]);
                    *(u32x4*)(dst + off) = w; asm volatile("" ::: "memory"); } }
    }
};

template <class Epi, class Sched, bool ALIGN_EPI = false, bool SP2 = false>
__device__ __forceinline__ void gemm_phase(PG8_LAS unsigned char* lds, const Gemm g, const Sched& S, const Epi& E) {
    const int tid = otid(), wid = __builtin_amdgcn_readfirstlane(tid >> 6), lane = tid & 63, wr = wid >> 2, wc = wid & 3, fr = lane & 15, fq = lane >> 4;
    const int K = g.K, nt = K / BK;
    unsigned voffA[2], voffB[2];
#pragma unroll
    for (int i = 0; i < 2; ++i) { int R, C; stage_rc(tid * 16 + i * 8192, R, C); const int Rb = Epi::PERM ? ((R & ~31) + perm32(R & 31)) : R;
        voffA[i] = (unsigned)(R * g.lda + C) * 2u; voffB[i] = (unsigned)(Rb * g.ldb + C) * 2u; }
    const size_t kstep = (size_t)(BK * 2);
    const size_t hstepA = (size_t)HALF * g.lda * 2, hstepB = (size_t)HALF * g.ldb * 2;
    const size_t tstepA = 2 * hstepA, tstepB = 2 * hstepB;
    const unsigned ldsw = (unsigned)wid * 1024u;
    const int aoff = lds_byte(wr * 64 + fr, fq * 8), boff = lds_byte(wc * 32 + fr, fq * 8);
#define PG8_SA(b, h) (((b) * 2 + (h)) * HTB)
#define PG8_SB(b, h) ((4 + (b) * 2 + (h)) * HTB)
#define PG8_STAGE(bufoff, gbase, voff) do { _Pragma("unroll") for (int _i = 0; _i < 2; ++_i) \
        __builtin_amdgcn_global_load_lds((const unsigned*)((const char*)(gbase) + (voff)[_i]), (PG8_LAS unsigned*)(lds + (bufoff) + ldsw + _i * 8192), 16, 0, 0); } while (0)
#define PG8_LDA(dst, b, h) do { _Pragma("unroll") for (int m = 0; m < 4; ++m) _Pragma("unroll") for (int k = 0; k < 2; ++k) dst[m][k] = *(const PG8_LAS bf16x8*)(lds + PG8_SA(b, h) + aoff + m * 2048 + k * 1024); } while (0)
#define PG8_LDB(dst, b, h) do { _Pragma("unroll") for (int n = 0; n < 2; ++n) _Pragma("unroll") for (int k = 0; k < 2; ++k) dst[n][k] = *(const PG8_LAS bf16x8*)(lds + PG8_SB(b, h) + boff + n * 2048 + k * 1024); } while (0)
#define PG8_MMA(ai, bj, At, Bt) do { __builtin_amdgcn_s_setprio(1); _Pragma("unroll") for (int m = 0; m < 4; ++m) _Pragma("unroll") for (int n = 0; n < 2; ++n) _Pragma("unroll") for (int k = 0; k < 2; ++k) \
        acc[ai][bj][m][n] = __builtin_amdgcn_mfma_f32_16x16x32_bf16(Bt[n][k], At[m][k], acc[ai][bj][m][n], 0, 0, 0); __builtin_amdgcn_s_setprio(0); } while (0)
#define PG8_WAIT_V(n) asm volatile("s_waitcnt vmcnt(" #n ")" ::: "memory")
#define PG8_WAIT_L(n) asm volatile("s_waitcnt lgkmcnt(" #n ")" ::: "memory")
#define PG8_BAR __builtin_amdgcn_s_barrier()
#define PG8_SCHED __builtin_amdgcn_sched_barrier(0)
    Unit cur, nxt; int ui = 0;
    if (!S.next(0, cur)) return;
    float pre[2][4] = {{0.f, 0.f, 0.f, 0.f}, {0.f, 0.f, 0.f, 0.f}};
    f32x4 acc[2][2][4][2];
#pragma unroll
    for (int a = 0; a < 2; ++a)
#pragma unroll
        for (int b = 0; b < 2; ++b)
#pragma unroll
            for (int m = 0; m < 4; ++m)
#pragma unroll
                for (int n = 0; n < 2; ++n) acc[a][b][m][n] = (f32x4){0.f, 0.f, 0.f, 0.f};
    bf16x8 At[4][2], B0[2][2], B1[2][2];
    const char* cA = (const char*)g.A + (size_t)cur.pm * tstepA + (size_t)cur.pn * g.apn; const char* cB = (const char*)g.Bt + (size_t)cur.pn * tstepB;
    S.a_ready(cur);
    if constexpr (SP2) {
        PG8_STAGE(PG8_SB(0, 0), cB, voffB); PG8_STAGE(PG8_SB(0, 1), cB + hstepB, voffB); PG8_STAGE(PG8_SA(0, 0), cA, voffA); PG8_STAGE(PG8_SA(0, 1), cA + hstepA, voffA);
        if (wr == 1) PG8_BAR;
        PG8_WAIT_V(2); PG8_BAR;
        PG8_STAGE(PG8_SB(1, 0), cB + kstep, voffB); PG8_STAGE(PG8_SA(1, 0), cA + kstep, voffA); PG8_STAGE(PG8_SB(1, 1), cB + hstepB + kstep, voffB);
        PG8_WAIT_V(6); PG8_BAR;
    } else {
        PG8_STAGE(PG8_SB(0, 0), cB, voffB); PG8_STAGE(PG8_SA(0, 0), cA, voffA); PG8_STAGE(PG8_SB(0, 1), cB + hstepB, voffB); PG8_STAGE(PG8_SA(0, 1), cA + hstepA, voffA);
        if (wr == 1) PG8_BAR;
        PG8_WAIT_V(4); PG8_BAR;
        PG8_STAGE(PG8_SB(1, 0), cB + kstep, voffB); PG8_STAGE(PG8_SA(1, 0), cA + kstep, voffA); PG8_STAGE(PG8_SB(1, 1), cB + hstepB + kstep, voffB);
        PG8_WAIT_V(6); PG8_BAR;
    }
    for (;;) {
        const bool has_next = S.next(ui + 1, nxt);
        const char* nA = has_next ? (const char*)g.A + (size_t)nxt.pm * tstepA + (size_t)nxt.pn * g.apn : cA; const char* nB = has_next ? (const char*)g.Bt + (size_t)nxt.pn * tstepB : cB;
        for (int t = 0; t < nt; t += 2) {
            const bool last = (t == nt - 2);
            const char* a1 = cA + (size_t)(t + 1) * kstep;
            const char* a2 = last ? nA : cA + (size_t)(t + 2) * kstep; const char* b2 = last ? nB : cB + (size_t)(t + 2) * kstep;
            const char* a3 = a2 + kstep; const char* b3 = b2 + kstep;
            if (last && has_next) S.a_ready(nxt);
            if constexpr (Epi::HAS_PRE) { if (last) E.prefetch(cur, pre, wr, fr); }
            if constexpr (SP2) {
            PG8_LDB(B0, 0, 0); PG8_LDB(B1, 0, 1); PG8_SCHED; PG8_LDA(At, 0, 0); PG8_STAGE(PG8_SA(1, 1), a1 + hstepA, voffA);
            PG8_WAIT_V(8); PG8_WAIT_L(0); PG8_BAR; PG8_MMA(0, 0, At, B0); PG8_MMA(0, 1, At, B1); PG8_BAR; PG8_SCHED;
            PG8_LDA(At, 0, 1); PG8_STAGE(PG8_SB(0, 0), b2, voffB); PG8_STAGE(PG8_SB(0, 1), b2 + hstepB, voffB); PG8_STAGE(PG8_SA(0, 0), a2, voffA);
            PG8_WAIT_V(8); PG8_WAIT_L(0); PG8_BAR; PG8_MMA(1, 0, At, B0); PG8_MMA(1, 1, At, B1); PG8_BAR; PG8_SCHED;
            PG8_LDB(B0, 1, 0); PG8_LDB(B1, 1, 1); PG8_SCHED; PG8_LDA(At, 1, 0); PG8_STAGE(PG8_SA(0, 1), a2 + hstepA, voffA);
            PG8_WAIT_V(8); PG8_WAIT_L(0); PG8_BAR; PG8_MMA(0, 0, At, B0); PG8_MMA(0, 1, At, B1); PG8_BAR; PG8_SCHED;
            PG8_LDA(At, 1, 1); PG8_STAGE(PG8_SB(1, 0), b3, voffB); PG8_STAGE(PG8_SB(1, 1), b3 + hstepB, voffB); PG8_STAGE(PG8_SA(1, 0), a3, voffA);
            PG8_WAIT_V(8); PG8_WAIT_L(0); PG8_BAR; PG8_MMA(1, 0, At, B0); PG8_MMA(1, 1, At, B1); PG8_BAR; PG8_SCHED;
            } else {
            PG8_LDB(B0, 0, 0); PG8_SCHED; PG8_LDA(At, 0, 0); PG8_STAGE(PG8_SA(1, 1), a1 + hstepA, voffA);
            PG8_WAIT_L(8); PG8_BAR; PG8_WAIT_L(0); PG8_MMA(0, 0, At, B0); PG8_BAR; PG8_SCHED;
            PG8_LDB(B1, 0, 1); PG8_STAGE(PG8_SB(0, 0), b2, voffB);
            PG8_BAR; PG8_WAIT_L(0); PG8_MMA(0, 1, At, B1); PG8_BAR;
            PG8_LDA(At, 0, 1); PG8_STAGE(PG8_SA(0, 0), a2, voffA);
            PG8_BAR; PG8_WAIT_L(0); PG8_MMA(1, 0, At, B0); PG8_BAR; PG8_SCHED;
            PG8_STAGE(PG8_SB(0, 1), b2 + hstepB, voffB);
            PG8_WAIT_V(6); PG8_BAR; PG8_MMA(1, 1, At, B1); PG8_BAR;
            PG8_LDB(B0, 1, 0); PG8_SCHED; PG8_LDA(At, 1, 0); PG8_STAGE(PG8_SA(0, 1), a2 + hstepA, voffA);
            PG8_WAIT_L(8); PG8_BAR; PG8_WAIT_L(0); PG8_MMA(0, 0, At, B0); PG8_BAR; PG8_SCHED;
            PG8_LDB(B1, 1, 1); PG8_STAGE(PG8_SB(1, 0), b3, voffB);
            PG8_BAR; PG8_WAIT_L(0); PG8_MMA(0, 1, At, B1); PG8_BAR;
            PG8_LDA(At, 1, 1); PG8_STAGE(PG8_SA(1, 0), a3, voffA);
            PG8_BAR; PG8_WAIT_L(0); PG8_MMA(1, 0, At, B0); PG8_BAR; PG8_SCHED;
            PG8_STAGE(PG8_SB(1, 1), b3 + hstepB, voffB);
            PG8_WAIT_V(6); PG8_BAR; PG8_MMA(1, 1, At, B1); PG8_BAR;
            }
        }
        if constexpr (ALIGN_EPI) { if (wr == 0) PG8_BAR; }
        if constexpr (!Epi::AFTER_DRAIN) { E(acc, cur, wr, wc, fr, fq, pre); S.done(cur); }
        if (!has_next) break;
#pragma unroll
        for (int a = 0; a < 2; ++a)
#pragma unroll
            for (int b = 0; b < 2; ++b)
#pragma unroll
                for (int m = 0; m < 4; ++m)
#pragma unroll
                    for (int n = 0; n < 2; ++n) acc[a][b][m][n] = (f32x4){0.f, 0.f, 0.f, 0.f};
        cur = nxt; cA = nA; cB = nB; ++ui;
        if constexpr (ALIGN_EPI) { if (wr == 1) PG8_BAR; }
    }
    PG8_WAIT_V(0);
    if constexpr (!ALIGN_EPI) { if (wr == 0) PG8_BAR; }
    PG8_BAR;
    if constexpr (Epi::AFTER_DRAIN) { E.fused(acc, cur, wr, wc, fr, fq, lds, wid, lane); S.done(cur); }
#undef PG8_SA
#undef PG8_SB
#undef PG8_STAGE
#undef PG8_LDA
#undef PG8_LDB
#undef PG8_MMA
#undef PG8_WAIT_V
#undef PG8_WAIT_L
#undef PG8_BAR
#undef PG8_SCHED
}
}

namespace attn {
constexpr int D = 128;
constexpr float THR = 8.f;
constexpr bool WSKIP = false;
constexpr float SCALE = 0.08838834764831845f;
constexpr int NW = 8, QBLK = 32, KVBLK = 64, QB = NW * QBLK;
constexpr int SHM_V = KVBLK * D * 2, SHM_K = KVBLK * D * 2;
constexpr int LDS_BYTES = 2 * SHM_V + 2 * SHM_K + NW * 64 * 4;
using bf16 = __hip_bfloat16;
typedef short bf16x8 __attribute__((ext_vector_type(8)));
typedef short s16x4 __attribute__((ext_vector_type(4)));
typedef float f32x16 __attribute__((ext_vector_type(16)));
typedef float f32x4 __attribute__((ext_vector_type(4)));
typedef unsigned u32x4 __attribute__((ext_vector_type(4)));
template <class A, class Bt> struct same_t { static constexpr bool v = false; };
template <class A> struct same_t<A, A> { static constexpr bool v = true; };

#define KSWZ(row, colB) ((row) * 256 + ((colB) ^ (((row) & 7) << 4)))
#define SBAR() __builtin_amdgcn_sched_barrier(0)
__device__ __forceinline__ int v_st(int k, int c) { const int kk = (k & ~0xC) | ((k & 4) << 1) | ((k & 8) >> 1); return ((kk >> 3) * 4 + (c >> 5)) * 512 + ((kk & 7) * 32 + (c & 31)) * 2; }
__device__ __forceinline__ int v_rd_base(int lane) { return ((lane & 3) << 3) | (((lane >> 2) & 3) << 6) | (((lane >> 4) & 1) << 5) | (((lane >> 5) & 1) << 8); }
constexpr int v_rd_off(int d0, int ks, int half) { return d0 * 512 + ks * 4096 + half * 2048; }
__device__ __forceinline__ int crow(int r, int hi) { return (r & 3) + 8 * (r >> 2) + 4 * hi; }
__device__ __forceinline__ unsigned cvtpk(float lo, float hi) {
    unsigned r; asm volatile("v_cvt_pk_bf16_f32 %0, %1, %2" : "=v"(r) : "v"(lo), "v"(hi)); return r;
}
__device__ __forceinline__ bf16x8 pack8(f32x4 a, f32x4 b) {
    u32x4 w = {cvtpk(a[0], a[1]), cvtpk(a[2], a[3]), cvtpk(b[0], b[1]), cvtpk(b[2], b[3])};
    return *reinterpret_cast<bf16x8*>(&w);
}
template <class T> __device__ __forceinline__ bf16x8 load8(const T* p) {
    if constexpr (same_t<T, float>::v) { return pack8(*(const f32x4*)p, *(const f32x4*)(p + 4)); }
    else { return *reinterpret_cast<const bf16x8*>(p); }
}
__device__ __forceinline__ void mask_tile(f32x16& p0, f32x16& p1, int dq, unsigned W) {
    const float NEG = -__builtin_inff();
#pragma unroll
    for (int r = 0; r < 16; ++r) {
        const int c = (r & 3) + 8 * (r >> 2);
        if ((unsigned)(dq - c) >= W) p0[r] = NEG;
        if ((unsigned)(dq - c - 32) >= W) p1[r] = NEG;
    }
}
__device__ __forceinline__ void partialSM(f32x16& p0, f32x16& p1, float& m_reg, float& mn, float& alpha) {
    float pmax = p0[0]; for (int r = 1; r < 16; ++r) pmax = fmaxf(pmax, p0[r]); for (int r = 0; r < 16; ++r) pmax = fmaxf(pmax, p1[r]);
    { auto rr = __builtin_amdgcn_permlane32_swap(__float_as_uint(pmax), __float_as_uint(pmax), false, false);
      pmax = fmaxf(__uint_as_float(rr[0]), __uint_as_float(rr[1])); }
    constexpr float C2 = 1.4426950408889634f * SCALE;
    if (__builtin_expect(__all((pmax - m_reg) * SCALE <= THR), 1)) { mn = m_reg; alpha = 1.f; }
    else { mn = fmaxf(m_reg, pmax); alpha = __builtin_amdgcn_exp2f((m_reg - mn) * C2); m_reg = mn; }
    const float mnL = -mn * C2;
    for (int r = 0; r < 16; ++r) p0[r] = fmaf(p0[r], C2, mnL); for (int r = 0; r < 16; ++r) p1[r] = fmaf(p1[r], C2, mnL);
    for (int r = 0; r < 16; ++r) p0[r] = __builtin_amdgcn_exp2f(p0[r]);
}
__device__ __forceinline__ void finishSM(f32x16& p0, f32x16& p1, float alpha, float& l_reg, bf16x8& pa0, bf16x8& pa1, bf16x8& pa2, bf16x8& pa3) {
    for (int r = 0; r < 16; ++r) p1[r] = __builtin_amdgcn_exp2f(p1[r]);
    float ps = 0; for (int r = 0; r < 16; ++r) ps += p0[r]; for (int r = 0; r < 16; ++r) ps += p1[r];
    { auto rr = __builtin_amdgcn_permlane32_swap(__float_as_uint(ps), __float_as_uint(ps), false, false);
      ps = __uint_as_float(rr[0]) + __uint_as_float(rr[1]); }
    l_reg = l_reg * alpha + ps;
#define PK4(P, B_, OUT) do { unsigned a0 = cvtpk(P[B_+0], P[B_+1]), a1 = cvtpk(P[B_+2], P[B_+3]);                          \
        unsigned b0 = cvtpk(P[B_+4], P[B_+5]), b1 = cvtpk(P[B_+6], P[B_+7]);                                             \
        auto r0 = __builtin_amdgcn_permlane32_swap(a0, b0, false, false); auto r1 = __builtin_amdgcn_permlane32_swap(a1, b1, false, false); \
        u32x4 w = {r0[0], r1[0], r0[1], r1[1]}; OUT = *reinterpret_cast<bf16x8*>(&w); } while (0)
    PK4(p0, 0, pa0); PK4(p0, 8, pa1); PK4(p1, 0, pa2); PK4(p1, 8, pa3);
#undef PK4
}
template <int KB, bool SK>
__device__ __forceinline__ void qkt(f32x16& p0, f32x16& p1, const char* K_lds, int r32, int hi, const bf16x8* qr, bool act) {
    if (SK && !act) { const float NEG = -__builtin_inff();
#pragma unroll
        for (int r = 0; r < 16; ++r) { p0[r] = NEG; p1[r] = NEG; } return; }
    p0 = f32x16{}; p1 = f32x16{};
    const char* kb[4];
#pragma unroll
    for (int dd = 0; dd < 4; ++dd) kb[dd] = K_lds + KB * SHM_K + KSWZ(r32, (dd * 16 + hi * 8) * 2);
#pragma unroll
    for (int d0 = 0; d0 < 8; ++d0) { const char* a = kb[d0 & 3] + (d0 >> 2) * 128;
        bf16x8 b0 = *reinterpret_cast<const bf16x8*>(a);
        bf16x8 b1 = *reinterpret_cast<const bf16x8*>(a + 32 * 256);
        p0 = __builtin_amdgcn_mfma_f32_32x32x16_bf16(b0, qr[d0], p0, 0, 0, 0);
        p1 = __builtin_amdgcn_mfma_f32_32x32x16_bf16(b1, qr[d0], p1, 0, 0, 0); }
}
template <int VB, bool SK>
__device__ __forceinline__ void pv_tile(f32x16* o, int vb0, bf16x8 pa0, bf16x8 pa1, bf16x8 pa2, bf16x8 pa3, bool act) {
    if (SK && !act) return;
#define TRRD(dst, off) asm volatile("ds_read_b64_tr_b16 %0, %1 offset:%2" : "=&v"(dst) : "v"(vb0), "i"(off) : "memory")
#define PV_D0(d0) do { s16x4 l0, l1, l2, l3, h0, h1, h2, h3; constexpr int b_ = VB * SHM_V + v_rd_off(d0, 0, 0);     \
        TRRD(l0, b_); TRRD(h0, b_ + 2048); TRRD(l1, b_ + 4096); TRRD(h1, b_ + 6144); TRRD(l2, b_ + 8192); TRRD(h2, b_ + 10240); TRRD(l3, b_ + 12288); TRRD(h3, b_ + 14336); \
        asm volatile("s_waitcnt lgkmcnt(0)" ::: "memory"); SBAR();                 \
        o[d0] = __builtin_amdgcn_mfma_f32_32x32x16_bf16(pa0, (bf16x8){l0[0], l0[1], l0[2], l0[3], h0[0], h0[1], h0[2], h0[3]}, o[d0], 0, 0, 0);   \
        o[d0] = __builtin_amdgcn_mfma_f32_32x32x16_bf16(pa1, (bf16x8){l1[0], l1[1], l1[2], l1[3], h1[0], h1[1], h1[2], h1[3]}, o[d0], 0, 0, 0);   \
        o[d0] = __builtin_amdgcn_mfma_f32_32x32x16_bf16(pa2, (bf16x8){l2[0], l2[1], l2[2], l2[3], h2[0], h2[1], h2[2], h2[3]}, o[d0], 0, 0, 0);   \
        o[d0] = __builtin_amdgcn_mfma_f32_32x32x16_bf16(pa3, (bf16x8){l3[0], l3[1], l3[2], l3[3], h3[0], h3[1], h3[2], h3[3]}, o[d0], 0, 0, 0); } while (0)
    PV_D0(0); PV_D0(1); PV_D0(2); PV_D0(3);
#undef PV_D0
#undef TRRD
}

template <class TIn, class TOut> struct BlockRef { const TIn* Q; const TIn* K; const TIn* V; TOut* O; int P0; };
template <class TIn> struct Seam {
    bf16x8 qr[8];
    bf16x8 st_v0, st_v1, st_k0, st_k1; f32x4 sf0, sf1, sf2, sf3;
    f32x4 tq[16];
};
__device__ __forceinline__ int swa_jlo(int P0, int W) { const int lowk = P0 - W + 1; return lowk > 0 ? lowk / KVBLK : 0; }
#define ROW(p, k0, rr) ((p) + (size_t)((k0) + (rr)) * D + sc)
#define VMW() asm volatile("s_waitcnt vmcnt(0)" ::: "memory")
#define VMWN(n) asm volatile("s_waitcnt vmcnt(%0)" :: "i"(n) : "memory")
#define SLOAD_H(Kp, Vp, k0) do { S.st_v0 = load8<TIn>(ROW(Vp, k0, sr)); S.st_v1 = load8<TIn>(ROW(Vp, k0, 32 + sr));              \
                         S.st_k0 = load8<TIn>(ROW(Kp, k0, sr)); S.st_k1 = load8<TIn>(ROW(Kp, k0, 32 + sr)); } while (0)
#define SWRITE_HK(bf) do { *(bf16x8*)(K_lds + (bf) * SHM_K + kws) = S.st_k0; *(bf16x8*)(K_lds + (bf) * SHM_K + kws + 32 * 256) = S.st_k1; } while (0)
#define SWRITE_HV(bf) do { *(bf16x8*)(V_lds + (bf) * SHM_V + vst0) = S.st_v0; *(bf16x8*)(V_lds + (bf) * SHM_V + vst1) = S.st_v1; } while (0)
#define SWRITE_H(bf) do { SWRITE_HV(bf); SWRITE_HK(bf); } while (0)
#define SLOAD_F(p, k0) do { S.sf0 = *(const f32x4*)ROW(p, k0, sr); S.sf1 = *(const f32x4*)(ROW(p, k0, sr) + 4);                \
                            S.sf2 = *(const f32x4*)ROW(p, k0, 32 + sr); S.sf3 = *(const f32x4*)(ROW(p, k0, 32 + sr) + 4); } while (0)
#define SWRITE_KF(bf) do { *(bf16x8*)(K_lds + (bf) * SHM_K + kws) = pack8(S.sf0, S.sf1); *(bf16x8*)(K_lds + (bf) * SHM_K + kws + 32 * 256) = pack8(S.sf2, S.sf3); } while (0)
#define SWRITE_VF(bf) do { *(bf16x8*)(V_lds + (bf) * SHM_V + vst0) = pack8(S.sf0, S.sf1); *(bf16x8*)(V_lds + (bf) * SHM_V + vst1) = pack8(S.sf2, S.sf3); } while (0)
template <class TIn, class TOut>
__device__ __forceinline__ void causal_swa_prime(const BlockRef<TIn, TOut>& cur, int W, char* lds, Seam<TIn>& S) {
    constexpr bool F32 = same_t<TIn, float>::v;
    const int tid = otid(), wid = __builtin_amdgcn_readfirstlane(tid >> 6), lane = tid & 63, r32 = lane & 31, hi = lane >> 5;
    const int sr = tid >> 4, sc = (tid & 15) * 8, kws = KSWZ(sr, sc * 2); char* K_lds = lds + 2 * SHM_V;
    const int kb0 = swa_jlo(cur.P0, W) * KVBLK;
    for (int d0 = 0; d0 < 8; ++d0) S.qr[d0] = load8<TIn>(cur.Q + (size_t)(wid * QBLK + r32) * D + d0 * 16 + hi * 8);
    if constexpr (F32) { SLOAD_F((const float*)cur.K, kb0); VMW(); SWRITE_KF(0); SBAR(); SLOAD_F((const float*)cur.V, kb0); }
    else { SLOAD_H(cur.K, cur.V, kb0); VMW(); SWRITE_HK(0); }
    __syncthreads();
}
template <class TIn, class TOut>
__device__ __forceinline__ void causal_swa_block(const BlockRef<TIn, TOut>& cur, const BlockRef<TIn, TOut>& nxt, int skv, int W, char* lds, Seam<TIn>& S) {
    constexpr bool F32 = same_t<TIn, float>::v;
    const int tid = otid(), wid = __builtin_amdgcn_readfirstlane(tid >> 6), lane = tid & 63, r32 = lane & 31, hi = lane >> 5;
    const int j_lo = swa_jlo(cur.P0, W);
    int j_hi = (cur.P0 + QB - 1) / KVBLK + 1; if (j_hi > skv / KVBLK) j_hi = skv / KVBLK;
    const int NT = j_hi - j_lo;
    const int kbn = swa_jlo(nxt.P0, W) * KVBLK;
    const int qlo = cur.P0 + wid * QBLK, qm = qlo + r32 - 4 * hi;
    char* V_lds = lds; char* K_lds = lds + 2 * SHM_V;
    float* ws = (float*)(lds + 2 * SHM_V + 2 * SHM_K) + wid * 64; float* li_l = ws, * al_l = ws + 32;
    float m_reg = -1e30f, l_reg = 0; f32x16 o[4] = {};
    const int sr = tid >> 4, sc = (tid & 15) * 8, vst0 = v_st(sr, sc), vst1 = v_st(32 + sr, sc), kws = KSWZ(sr, sc * 2);
    const int vb0 = (int)(uintptr_t)V_lds + v_rd_base(lane);
    const TIn* Kh = cur.K; const TIn* Vh = cur.V;
#define RESC(a) do { if (__any((a) < 1.f)) { if (hi == 0) al_l[r32] = (a); asm volatile("s_waitcnt lgkmcnt(0)" ::: "memory");              \
                     for (int d_ = 0; d_ < 4; ++d_) for (int r = 0; r < 16; ++r) o[d_][r] *= al_l[crow(r, hi)]; } } while (0)
#define KBASE(t) ((j_lo + (t)) * KVBLK)
#define ACT(t) (KBASE(t) <= qlo + QBLK - 1 && KBASE(t) + KVBLK - 1 >= qlo - W + 1)
#define MASKT(P0_, P1_, t) do { const int kb_ = KBASE(t); if ((!SK || ACT(t)) && (kb_ + KVBLK - 1 > qlo || kb_ <= qlo + QBLK - 1 - W)) mask_tile(P0_, P1_, qm - kb_, (unsigned)W); } while (0)
    constexpr int NQL = F32 ? 16 : 8;
    constexpr bool SK = WSKIP && !F32;
#define SEAM_K0() do { VMWN(NQL); if constexpr (F32) { SWRITE_KF(0); SBAR(); SLOAD_F((const float*)nxt.V, kbn); } else { SWRITE_HK(0); } SBAR(); } while (0)
    f32x16 pA0, pA1, pB0, pB1; float mnA, mnB, alA, alB; bf16x8 pa0, pa1, pa2, pa3;
    if constexpr (F32) { VMW(); SWRITE_VF(0); SBAR(); } else { SWRITE_HV(0); SBAR(); }
    if (NT > 1) { if constexpr (F32) SLOAD_F((const float*)Kh, KBASE(1)); else SLOAD_H(Kh, Vh, KBASE(1)); }
    SBAR(); qkt<0, SK>(pA0, pA1, K_lds, r32, hi, S.qr, ACT(0));
    if constexpr (F32) { if (NT > 1) { VMW(); SWRITE_KF(1); SBAR(); SLOAD_F((const float*)Vh, KBASE(1)); } }
    MASKT(pA0, pA1, 0); partialSM(pA0, pA1, m_reg, mnA, alA);
    if (NT > 1) { VMW(); if constexpr (F32) { SWRITE_VF(1); SBAR(); if (NT > 2) SLOAD_F((const float*)Kh, KBASE(2)); } else SWRITE_H(1); }
    __syncthreads();
#define HALF_STEP(PX0, PX1, mnX, alX, PY0, PY1, alY, t, KB, VB, SB) do {                                                      \
        SBAR(); qkt<KB, SK>(PX0, PX1, K_lds, r32, hi, S.qr, ACT(t));                                             \
        finishSM(PY0, PY1, alY, l_reg, pa0, pa1, pa2, pa3); SBAR();                                                           \
        if ((t) + 1 < NT) { if constexpr (F32) { VMW(); SWRITE_KF(SB); SBAR(); SLOAD_F((const float*)Vh, KBASE((t) + 1)); }  \
                            else { SLOAD_H(Kh, Vh, KBASE((t) + 1)); } SBAR(); }                                               \
        pv_tile<VB, SK>(o, vb0, pa0, pa1, pa2, pa3, ACT((t) - 1)); MASKT(PX0, PX1, (t)); partialSM(PX0, PX1, m_reg, mnX, alX);                                        \
        __syncthreads();                                                                                                      \
        if ((t) + 1 < NT) { VMW(); if constexpr (F32) { SWRITE_VF(SB); SBAR(); if ((t) + 2 < NT) SLOAD_F((const float*)Kh, KBASE((t) + 2)); } \
                            else { SWRITE_H(SB); } }                                                                          \
        RESC(alX); __syncthreads(); } while (0)
    for (int t = 1; t + 1 < NT; t += 2) {
        HALF_STEP(pB0, pB1, mnB, alB, pA0, pA1, alA, t, 1, 0, 0);
        HALF_STEP(pA0, pA1, mnA, alA, pB0, pB1, alB, t + 1, 0, 1, 1);
    }
    const bool even = (NT & 1) == 0;
    if (even) { SBAR(); qkt<1, SK>(pB0, pB1, K_lds, r32, hi, S.qr, ACT(NT - 1)); SBAR(); }
#define QROW(e) (nxt.Q + (size_t)(wid * QBLK + r32) * D + ((e) >> 1) * 16 + hi * 8 + ((e) & 1) * 4)
    if constexpr (F32) { SLOAD_F((const float*)nxt.K, kbn); SBAR();
#pragma unroll
        for (int e = 0; e < 8; ++e) S.tq[e] = *(const f32x4*)QROW(e); }
    else { SLOAD_H(nxt.K, nxt.V, kbn); SBAR();
#pragma unroll
        for (int d0 = 0; d0 < 8; ++d0) S.qr[d0] = load8<TIn>(nxt.Q + (size_t)(wid * QBLK + r32) * D + d0 * 16 + hi * 8); }
    SBAR();
    finishSM(pA0, pA1, alA, l_reg, pa0, pa1, pa2, pa3); SBAR();
    if constexpr (F32) {
#pragma unroll
        for (int e = 8; e < 16; ++e) S.tq[e] = *(const f32x4*)QROW(e); SBAR(); }
#undef QROW
    pv_tile<0, SK>(o, vb0, pa0, pa1, pa2, pa3, ACT(even ? NT - 2 : NT - 1));
    if (even) { MASKT(pB0, pB1, NT - 1); partialSM(pB0, pB1, m_reg, mnB, alB); __syncthreads(); RESC(alB);
        finishSM(pB0, pB1, alB, l_reg, pa0, pa1, pa2, pa3); SBAR(); pv_tile<1, SK>(o, vb0, pa0, pa1, pa2, pa3, ACT(NT - 1)); }
    SBAR(); SEAM_K0();
    if (hi == 0) li_l[r32] = l_reg; asm volatile("s_waitcnt lgkmcnt(0)" ::: "memory");
    float rli[16];
#pragma unroll
    for (int r = 0; r < 16; ++r) rli[r] = __builtin_amdgcn_rcpf(li_l[crow(r, hi)]);
    TOut* Ow = cur.O + (size_t)(wid * QBLK) * D;
#pragma unroll
    for (int r = 0; r < 16; ++r) { const int orow = crow(r, hi);
#pragma unroll
        for (int d0 = 0; d0 < 4; ++d0) { const float v = o[d0][r] * rli[r];
            if constexpr (same_t<TOut, float>::v) { Ow[(size_t)orow * D + d0 * 32 + r32] = v; }
            else { const float vn = __shfl_xor(v, 1);
                   if ((r32 & 1) == 0) *(unsigned*)(Ow + (size_t)orow * D + d0 * 32 + r32) = cvtpk(v, vn); } } }
    if constexpr (F32) {
#pragma unroll
        for (int d0 = 0; d0 < 8; ++d0) S.qr[d0] = pack8(S.tq[2 * d0], S.tq[2 * d0 + 1]); }
    __syncthreads();
#undef RESC
#undef KBASE
#undef ACT
#undef MASKT
#undef SEAM_K0
#undef HALF_STEP
}
#undef ROW
#undef VMW
#undef VMWN
#undef SLOAD_H
#undef SWRITE_HK
#undef SWRITE_HV
#undef SWRITE_H
#undef SLOAD_F
#undef SWRITE_KF
#undef SWRITE_VF

}

typedef unsigned short bf16_t;
typedef float f32x4 __attribute__((ext_vector_type(4)));
typedef float f32x16 __attribute__((ext_vector_type(16)));
typedef short bf16x8 __attribute__((ext_vector_type(8)));
typedef unsigned u32x4 __attribute__((ext_vector_type(4)));
typedef unsigned u32x2 __attribute__((ext_vector_type(2)));

constexpr int SEQ = 4096, MTOK = 8192, DM = 2048, DFF = 5632, PLED = 256;
constexpr size_t MiB = 1u << 20;
constexpr size_t WS_CTL = 0, WS_ROPE = 1, WS_WGU1 = 2, WS_WD1 = 46, WS_WGU2 = 68, WS_WD2 = 112, WS_WPG = 134, WS_WPE = 142, WS_WPOOL = 143,
                 WS_WMIXIN = 144, WS_WMIXOUT = 176, WS_PB = 184, WS_H = 192, WS_PE = 224, WS_GU = 288,
                 WS_U = 376, WS_QH = 408, WS_KH = 424, WS_VH = 440, WS_OH = 456, WS_DP = 488, WS_CC = 504,
                 WS_OHG = 288, WS_DEC = 320, WS_LF = 376, WS_QS = 440, WS_KB = 472, WS_VB = 504, WS_GS = 536, WS_LT = 568, WS_END = 696;
constexpr int CTL_LAM = 0, CTL_LBS = 1024;
constexpr int LDS_BYTES = 131072 + 64;
constexpr size_t CTL_BAR_BYTE = 65536, CTL_BAR_BYTES = 16384, CTL_ZERO_BYTES = 65536 + 9 * 65536;
constexpr int NPH = 22;
constexpr size_t CTL_SS_BYTE = 131072;

__device__ __forceinline__ float wave_sum(float v) {
#pragma unroll
    for (int o = 1; o < 64; o <<= 1) v += __shfl_xor(v, o);
    return v;
}
__device__ __forceinline__ unsigned pk2(float lo, float hi) { return pg8::cvt_pk_bf16(lo, hi); }
__device__ __forceinline__ bf16_t f2bf(float v) { return (bf16_t)(pg8::cvt_pk_bf16(v, 0.f) & 0xffffu); }
__device__ __forceinline__ float bflo(unsigned w) { return __uint_as_float(w << 16); }
__device__ __forceinline__ float bfhi(unsigned w) { return __uint_as_float(w & 0xffff0000u); }
#define LDS_WAIT() asm volatile("s_waitcnt lgkmcnt(0)" ::: "memory")

struct ConvJob { const float* W; const float* ksc; bf16_t* dst; int K, N, ldd, mode, start, pad; };
__device__ __forceinline__ int conv_find(const ConvJob* tab, int g) { int j = 0;
#pragma nounroll
    while (j < 13 && g >= tab[j + 1].start) ++j;
    return j; }
__device__ __forceinline__ void conv_load(const ConvJob* tab, int g, f32x4 (&v)[8], int lane) {
    const ConvJob jb = tab[conv_find(tab, g)];
    const int it = g - jb.start, nq4 = jb.N >> 8, q = it >> 3, w = it & 7, kq = q / nq4, nq = q - kq * nq4, kb = 2 * kq + (w >> 2), nb = 4 * nq + (w & 3);
    const float* wp = jb.W + (size_t)((kb << 5) + (lane >> 4)) * jb.N + (nb << 6) + (lane & 15) * 4;
#pragma unroll
    for (int r = 0; r < 8; ++r) v[r] = *(const f32x4*)(wp + (size_t)(4 * r) * jb.N);
}
__device__ __forceinline__ void conv_proc(const ConvJob* tab, int g, const f32x4 (&v)[8], float* scr, int lane) {
    const ConvJob jb = tab[conv_find(tab, g)];
    const int it = g - jb.start, nq4 = jb.N >> 8, q = it >> 3, w = it & 7, kq = q / nq4, nq = q - kq * nq4, kb = 2 * kq + (w >> 2), nb = 4 * nq + (w & 3), k0 = kb << 5, n0 = nb << 6;
    const int drow0 = jb.mode == 0 ? n0 : (((n0 >> 7) << 8) + (n0 & 127) + (jb.mode == 2 ? 128 : 0));
#pragma unroll
    for (int r = 0; r < 8; ++r) *(f32x4*)(scr + (4 * r + (lane >> 4)) * 68 + (lane & 15) * 4) = v[r];
    LDS_WAIT();
    bf16_t* dp = jb.dst + (size_t)(drow0 + lane) * jb.ldd + k0;
#pragma unroll
    for (int c = 0; c < 4; ++c) { const float* s = scr + (8 * c) * 68 + lane;
        f32x4 ka = {1.f, 1.f, 1.f, 1.f}, kb2 = ka; if (jb.ksc) { ka = *(const f32x4*)(jb.ksc + k0 + 8 * c); kb2 = *(const f32x4*)(jb.ksc + k0 + 8 * c + 4); }
        u32x4 o; o.x = pk2(s[0 * 68] * ka[0], s[1 * 68] * ka[1]); o.y = pk2(s[2 * 68] * ka[2], s[3 * 68] * ka[3]); o.z = pk2(s[4 * 68] * kb2[0], s[5 * 68] * kb2[1]); o.w = pk2(s[6 * 68] * kb2[2], s[7 * 68] * kb2[3]);
        *(u32x4*)(dp + 8 * c) = o; }
    LDS_WAIT();
}

__device__ __forceinline__ void prep_rows(const float* __restrict__ src, bf16_t* __restrict__ xb, unsigned long long* __restrict__ ss0, int gw, int NGW, int lane) {
    for (int m = gw; m < MTOK; m += NGW) {
        const f32x4* xr = (const f32x4*)(src + (size_t)m * DM) + lane;
        f32x4 v[8]; float s = 0.f;
#pragma unroll
        for (int j = 0; j < 8; ++j) { v[j] = xr[64 * j]; s += (v[j].x * v[j].x + v[j].y * v[j].y) + (v[j].z * v[j].z + v[j].w * v[j].w); }
        s = wave_sum(s);
        if (lane == 0) ss0[m] = (unsigned long long)(s * 1048576.f + 0.5f);
#pragma unroll
        for (int j = 0; j < 8; ++j) { u32x2 w; w.x = pk2(v[j].x, v[j].y); w.y = pk2(v[j].z, v[j].w); ((u32x2*)(xb + (size_t)m * DM))[lane + 64 * j] = w; }
    }
}
__device__ __forceinline__ void final_rows(float* x, const float* __restrict__ gain, const unsigned long long* ss, int gw, int NGW, int lane) {
    for (int m = gw; m < MTOK; m += NGW) {
        const float rstd = rsqrtf((float)ss[m] * (1.f / 1048576.f) * (1.f / DM) + 1e-6f);
        f32x4* xr = (f32x4*)(x + (size_t)m * DM) + lane;
#pragma unroll
        for (int j = 0; j < 8; ++j) { const f32x4 g = ((const f32x4*)gain)[lane + 64 * j]; xr[64 * j] = xr[64 * j] * rstd * g; }
    }
}

template <int W> __device__ __forceinline__ void pool_unit(const float* __restrict__ up, bf16_t* __restrict__ dp, int s0) {
    f32x4 v[16 + W];
#pragma unroll
    for (int j = 0; j < 16 + W; ++j) { const int s = s0 - W + j; v[j] = (s >= 0) ? *(const f32x4*)(up + (ptrdiff_t)(j - W) * 1024) : (f32x4){0.f, 0.f, 0.f, 0.f}; }
    f32x4 sum = {0.f, 0.f, 0.f, 0.f};
#pragma unroll
    for (int j = 0; j < W; ++j) sum += v[j];
#pragma unroll
    for (int i = 0; i < 16; ++i) {
        const int s = s0 + i; const f32x4 cur = v[W + i];
        sum += cur; sum -= v[i];
        const float inv = 1.f / (float)((s + 1) < W ? (s + 1) : W);
        const f32x4 d = sum * inv - cur;
        u32x2 o; o.x = pk2(d.x, d.y); o.y = pk2(d.z, d.w);
        *(u32x2*)(dp + (size_t)i * 1024) = o;
    }
}
__device__ __forceinline__ void pool_diff(const float* __restrict__ U, bf16_t* __restrict__ Dp, int blk, int nblk, int tid) {
    const int half = tid >> 8, c4 = tid & 255, g = __builtin_amdgcn_readfirstlane(c4 >> 6);
    for (int un = blk * 2 + half; un < MTOK / 16; un += nblk * 2) {
        const int row0 = un * 16, s0 = row0 & (SEQ - 1);
        const float* up = U + (size_t)row0 * 1024 + c4 * 4; bf16_t* dp = Dp + (size_t)row0 * 1024 + c4 * 4;
        if (g == 0) pool_unit<2>(up, dp, s0); else if (g == 1) pool_unit<4>(up, dp, s0); else if (g == 2) pool_unit<8>(up, dp, s0); else pool_unit<16>(up, dp, s0);
    }
}

__device__ __forceinline__ void attn_combine(const bf16_t* __restrict__ Oh, const float* __restrict__ subln, const float* lamp, bf16_t* __restrict__ CC, int gw, int NGW, int lane) {
    const float lam = *lamp;
    const int vh = lane >> 5, e = (lane & 31) * 4;
    const f32x4 g = *(const f32x4*)(subln + vh * 128 + e);
#pragma unroll 4
    for (int it = gw; it < MTOK * 4; it += NGW) {
        const int row = it >> 2, h = it & 3, b = row >> 12, s = row & (SEQ - 1);
        const size_t base0 = ((size_t)((((b * 4 + h) * 2 + 0) * 2 + vh) * SEQ + s)) * 128 + e;
        const size_t base1 = ((size_t)((((b * 4 + h) * 2 + 1) * 2 + vh) * SEQ + s)) * 128 + e;
        const u32x2 a = *(const u32x2*)(Oh + base0), c = *(const u32x2*)(Oh + base1);
        f32x4 o; o.x = bflo(a.x) - lam * bflo(c.x); o.y = bfhi(a.x) - lam * bfhi(c.x); o.z = bflo(a.y) - lam * bflo(c.y); o.w = bfhi(a.y) - lam * bfhi(c.y);
        const float ss = wave_sum((o.x * o.x + o.y * o.y) + (o.z * o.z + o.w * o.w));
        const float rstd = rsqrtf(ss * (1.f / 256.f) + 1e-5f) * 0.8f;
        o = o * rstd * g;
        u32x2 w; w.x = pk2(o.x, o.y); w.y = pk2(o.z, o.w);
        *(u32x2*)(CC + (size_t)row * DM + 1024 + h * 256 + vh * 128 + e) = w;
    }
}

__device__ __forceinline__ int tsw_wr(int d, int t) { return d * 72 + (t ^ (((d >> 3) & 7) << 3)); }
__device__ __forceinline__ int tsw_rd(int row, int c8) { return row * 72 + ((c8 ^ ((row >> 3) & 7)) << 3); }
__device__ __forceinline__ void lds_barrier() { asm volatile("s_waitcnt lgkmcnt(0)\n\ts_barrier" ::: "memory"); }
struct HgrnIn { f32x4 lf[4]; u32x4 a[2], b[2], c[2]; };
template <bool THREE> __device__ __forceinline__ void hgrn_load(HgrnIn& in, const float* __restrict__ LF, const bf16_t* __restrict__ A, const bf16_t* __restrict__ B, const bf16_t* __restrict__ C, int item, int tid) {
    const int bh = item >> 6, c = item & 63, b = bh >> 4, h = bh & 15, r0 = b * SEQ + c * 64, cb = h * 128;
#pragma unroll
    for (int r = 0; r < 4; ++r) { const int i = tid + 512 * r, t = i >> 5, c4 = i & 31; in.lf[r] = *(const f32x4*)(LF + (size_t)(r0 + t) * DM + cb + c4 * 4); }
#pragma unroll
    for (int r = 0; r < 2; ++r) { const int i = tid + 512 * r, t = i >> 4, d8 = (i & 15) * 8; const size_t go = (size_t)(r0 + t) * DM + cb + d8;
        in.a[r] = *(const u32x4*)(A + go); in.b[r] = *(const u32x4*)(B + go); if (THREE) in.c[r] = *(const u32x4*)(C + go); }
}
__device__ __forceinline__ void hgrn_prep(const HgrnIn& in, float* G, float* tot, int tid) {
#pragma unroll
    for (int r = 0; r < 4; ++r) { const int i = tid + 512 * r, t = i >> 5, c4 = i & 31; *(f32x4*)(G + t * 128 + c4 * 4) = in.lf[r]; }
    lds_barrier();
    const int col = tid & 127, q = tid >> 7; float* gp = G + (16 * q) * 128 + col;
    { float a = 0.f;
#pragma unroll
      for (int t = 0; t < 16; ++t) { a += gp[t * 128]; gp[t * 128] = a; }
      tot[q * 128 + col] = a; }
    lds_barrier();
    { float off = 0.f;
#pragma unroll
      for (int qq = 0; qq < 3; ++qq) off += (qq < q) ? tot[qq * 128 + col] : 0.f;
#pragma unroll
      for (int t = 0; t < 16; ++t) gp[t * 128] += off; }
    lds_barrier();
}
__device__ __forceinline__ void hgrn_passA(unsigned char* lds, const float* __restrict__ LF, const bf16_t* __restrict__ Kb, const bf16_t* __restrict__ Vb,
                                           bf16_t* __restrict__ LT, float* __restrict__ DEC, int blk, int nblk, int tid, int wave, int lane) {
    float* G = (float*)lds; bf16_t* khT = (bf16_t*)(lds + 32768); bf16_t* vT = (bf16_t*)(lds + 32768 + 18432);
    HgrnIn in;
    { int b0 = blk; asm volatile("" : "+s"(b0)); if (b0 < 2048) hgrn_load<false>(in, LF, Kb, Vb, Vb, b0, tid); }
    for (int item = blk; item < 2048; item += nblk) {
        hgrn_prep(in, G, (float*)(lds + 69632), tid);
        if (tid < 128) DEC[item * 128 + tid] = __expf(G[63 * 128 + tid]);
#pragma unroll
        for (int r = 0; r < 2; ++r) { const int i = tid + 512 * r, t = i >> 4, d8 = (i & 15) * 8;
            const u32x4 kk = in.a[r], vv = in.b[r];
#pragma unroll
            for (int j = 0; j < 4; ++j) { const unsigned kw = kk[j], vw = vv[j]; const int d = d8 + 2 * j;
                const float k0 = bflo(kw) * __expf(G[63 * 128 + d] - G[t * 128 + d]), k1 = bfhi(kw) * __expf(G[63 * 128 + d + 1] - G[t * 128 + d + 1]);
                khT[tsw_wr(d, t)] = f2bf(k0); khT[tsw_wr(d + 1, t)] = f2bf(k1);
                vT[tsw_wr(d, t)] = (bf16_t)(vw & 0xffffu); vT[tsw_wr(d + 1, t)] = (bf16_t)(vw >> 16); } }
        if (item + nblk < 2048) hgrn_load<false>(in, LF, Kb, Vb, Vb, item + nblk, tid);
        lds_barrier();
        const int r = lane & 31, hq = lane >> 5, et = wave >> 1, dt0 = (wave & 1) * 2;
        f32x16 acc0 = {}, acc1 = {};
#pragma unroll
        for (int kk = 0; kk < 4; ++kk) {
            const bf16x8 av = *(const bf16x8*)(vT + tsw_rd(et * 32 + r, kk * 2 + hq));
            const bf16x8 b0 = *(const bf16x8*)(khT + tsw_rd(dt0 * 32 + r, kk * 2 + hq));
            const bf16x8 b1 = *(const bf16x8*)(khT + tsw_rd((dt0 + 1) * 32 + r, kk * 2 + hq));
            acc0 = __builtin_amdgcn_mfma_f32_32x32x16_bf16(av, b0, acc0, 0, 0, 0);
            acc1 = __builtin_amdgcn_mfma_f32_32x32x16_bf16(av, b1, acc1, 0, 0, 0); }
        bf16_t* Lp = LT + (size_t)item * 16384;
#pragma unroll
        for (int reg = 0; reg < 16; ++reg) { const int e = et * 32 + (reg & 3) + 8 * (reg >> 2) + 4 * hq;
            const float n0 = __shfl_xor(acc0[reg], 1), n1 = __shfl_xor(acc1[reg], 1);
            if ((r & 1) == 0) { *(unsigned*)(Lp + e * 128 + dt0 * 32 + r) = pk2(acc0[reg], n0); *(unsigned*)(Lp + e * 128 + (dt0 + 1) * 32 + r) = pk2(acc1[reg], n1); } }
        lds_barrier();
    }
}
__device__ __forceinline__ void hgrn_scan(bf16_t* LT, const float* __restrict__ DEC, int gtid, int nthreads) {
    for (int base = gtid; base < 32 * 8192; base += 2 * nthreads) {
        float S[2][2] = {{0.f, 0.f}, {0.f, 0.f}}; unsigned* p[2]; const float* dp[2];
#pragma unroll
        for (int u = 0; u < 2; ++u) { int idx = base + u * nthreads; if (idx >= 32 * 8192) idx = base; const int bh = idx >> 13, ed = (idx & 8191) * 2;
            p[u] = (unsigned*)(LT + (size_t)bh * 64 * 16384 + ed); dp[u] = DEC + bh * 64 * 128 + (ed & 127); }
#pragma nounroll
        for (int cb = 0; cb < 64; cb += 16) {
            unsigned L[16][2]; float d0[16][2], d1[16][2];
#pragma unroll
            for (int j = 0; j < 16; ++j)
#pragma unroll
                for (int u = 0; u < 2; ++u) { L[j][u] = p[u][(size_t)(cb + j) * 8192]; const float* q = dp[u] + (cb + j) * 128; d0[j][u] = q[0]; d1[j][u] = q[1]; }
#pragma unroll
            for (int j = 0; j < 16; ++j) { const size_t o = (size_t)(cb + j) * 8192;
                p[0][o] = pk2(S[0][0], S[0][1]); p[1][o] = pk2(S[1][0], S[1][1]);
#pragma unroll
                for (int u = 0; u < 2; ++u) { S[u][0] = d0[j][u] * S[u][0] + bflo(L[j][u]); S[u][1] = d1[j][u] * S[u][1] + bfhi(L[j][u]); } }
        }
    }
}
__device__ __forceinline__ void hgrn_passC(unsigned char* lds, const float* __restrict__ LF, const bf16_t* __restrict__ Qs, const bf16_t* __restrict__ Kb, const bf16_t* __restrict__ Vb,
                                           const bf16_t* __restrict__ Gs, const bf16_t* __restrict__ ST, const float* __restrict__ gain, bf16_t* __restrict__ OHG,
                                           int blk, int nblk, int tid, int wave, int lane) {
    float* G = (float*)lds; bf16_t* qt = (bf16_t*)(lds + 32768); bf16_t* kt = (bf16_t*)(lds + 50176); bf16_t* vT = (bf16_t*)(lds + 67584);
    bf16_t* Ab = (bf16_t*)(lds + 86016); float* osm = (float*)(lds + 95232);
    HgrnIn in;
    { int b0 = blk; asm volatile("" : "+s"(b0)); if (b0 < 2048) hgrn_load<true>(in, LF, Qs, Kb, Vb, b0, tid); }
    for (int item = blk; item < 2048; item += nblk) {
        const int bh = item >> 6, c = item & 63, b = bh >> 4, h = bh & 15, r0 = b * SEQ + c * 64, cb = h * 128;
        u32x4 sreg[8]; { const bf16_t* Sp0 = ST + (size_t)item * 16384 + (size_t)((wave & 3) * 32 + (lane & 31)) * 128 + (lane >> 5) * 8;
#pragma unroll
            for (int kk = 0; kk < 8; ++kk) sreg[kk] = *(const u32x4*)(Sp0 + kk * 16); }
        const size_t gog = (size_t)(r0 + (tid >> 3)) * DM + cb + (tid & 7) * 16;
        const u32x4 ga = *(const u32x4*)(Gs + gog), gb = *(const u32x4*)(Gs + gog + 8);
        hgrn_prep(in, G, (float*)(lds + 129024), tid);
#pragma unroll
        for (int rr = 0; rr < 2; ++rr) { const int i = tid + 512 * rr, t = i >> 4, d8 = (i & 15) * 8;
            const u32x4 qq = in.a[rr], kk = in.b[rr], vv = in.c[rr];
            u32x4 qo, ko;
#pragma unroll
            for (int j = 0; j < 4; ++j) { const int d = d8 + 2 * j; const float g0 = G[t * 128 + d], g1 = G[t * 128 + d + 1];
                qo[j] = pk2(bflo(qq[j]) * __expf(g0), bfhi(qq[j]) * __expf(g1));
                ko[j] = pk2(bflo(kk[j]) * __expf(-g0), bfhi(kk[j]) * __expf(-g1));
                vT[tsw_wr(d, t)] = (bf16_t)(vv[j] & 0xffffu); vT[tsw_wr(d + 1, t)] = (bf16_t)(vv[j] >> 16); }
            *(u32x4*)(qt + t * 136 + d8) = qo; *(u32x4*)(kt + t * 136 + d8) = ko; }
        if (item + nblk < 2048) hgrn_load<true>(in, LF, Qs, Kb, Vb, item + nblk, tid);
        lds_barrier();
        const int r = lane & 31, hq = lane >> 5;
        if (wave < 4) { const int tt = wave >> 1, st = wave & 1; f32x16 acc = {};
#pragma unroll
            for (int kk = 0; kk < 8; ++kk) {
                const bf16x8 av = *(const bf16x8*)(qt + (tt * 32 + r) * 136 + kk * 16 + hq * 8);
                const bf16x8 bv = *(const bf16x8*)(kt + (st * 32 + r) * 136 + kk * 16 + hq * 8);
                acc = __builtin_amdgcn_mfma_f32_32x32x16_bf16(av, bv, acc, 0, 0, 0); }
#pragma unroll
            for (int reg = 0; reg < 16; ++reg) { const int t = tt * 32 + (reg & 3) + 8 * (reg >> 2) + 4 * hq, s = st * 32 + r;
                Ab[t * 72 + s] = f2bf(s <= t ? acc[reg] : 0.f); } }
        lds_barrier();
        { const int tt = wave >> 2, et = wave & 3; f32x16 acc = {};
#pragma unroll
            for (int kk = 0; kk < 8; ++kk) {
                const bf16x8 av = *(const bf16x8*)(qt + (tt * 32 + r) * 136 + kk * 16 + hq * 8);
                const u32x4 bw = sreg[kk];
                acc = __builtin_amdgcn_mfma_f32_32x32x16_bf16(av, *(const bf16x8*)&bw, acc, 0, 0, 0); }
#pragma unroll
            for (int kk = 0; kk < 4; ++kk) {
                const bf16x8 av = *(const bf16x8*)(Ab + (tt * 32 + r) * 72 + kk * 16 + hq * 8);
                const bf16x8 bv = *(const bf16x8*)(vT + tsw_rd(et * 32 + r, kk * 2 + hq));
                acc = __builtin_amdgcn_mfma_f32_32x32x16_bf16(av, bv, acc, 0, 0, 0); }
#pragma unroll
            for (int reg = 0; reg < 16; ++reg) { const int t = tt * 32 + (reg & 3) + 8 * (reg >> 2) + 4 * hq; osm[t * 132 + et * 32 + r] = acc[reg]; } }
        lds_barrier();
        { const int row = tid >> 3, j = tid & 7; f32x4 o[4]; float ss = 0.f;
#pragma unroll
            for (int q = 0; q < 4; ++q) { o[q] = *(const f32x4*)(osm + row * 132 + j * 16 + q * 4); ss += (o[q].x * o[q].x + o[q].y * o[q].y) + (o[q].z * o[q].z + o[q].w * o[q].w); }
            ss += __shfl_xor(ss, 1); ss += __shfl_xor(ss, 2); ss += __shfl_xor(ss, 4);
            const float rstd = rsqrtf(ss * (1.f / 128.f) + 1e-6f);
            const size_t go = (size_t)(r0 + row) * DM + cb + j * 16;
            u32x4 wa, wb;
#pragma unroll
            for (int q = 0; q < 4; ++q) { const f32x4 gn = *(const f32x4*)(gain + j * 16 + q * 4); const f32x4 v = o[q] * rstd * gn;
                const unsigned g01 = q < 2 ? ga[2 * q] : gb[2 * (q - 2)], g23 = q < 2 ? ga[2 * q + 1] : gb[2 * (q - 2) + 1];
                const unsigned w0 = pk2(v.x * bflo(g01), v.y * bfhi(g01)), w1 = pk2(v.z * bflo(g23), v.w * bfhi(g23));
                if (q < 2) { wa[2 * q] = w0; wa[2 * q + 1] = w1; } else { wb[2 * (q - 2)] = w0; wb[2 * (q - 2) + 1] = w1; } }
            *(u32x4*)(OHG + go) = wa; *(u32x4*)(OHG + go + 8) = wb; }
        lds_barrier();
    }
}

typedef attn::BlockRef<attn::bf16, attn::bf16> ABR;
__device__ __forceinline__ ABR attn_ref(int L, int pass, const attn::bf16* Qh, const attn::bf16* Kh, const attn::bf16* Vh, attn::bf16* Oh) {
    const int qh = L >> 3, x = L & 7, qb = pass ? 15 - x : x, bhc = qh >> 1, bh = qh >> 2, vh = qh & 1;
    ABR r;
    r.Q = Qh + ((size_t)bhc * SEQ + (size_t)qb * 256) * 128; r.K = Kh + (size_t)bhc * SEQ * 128; r.V = Vh + (size_t)(bh * 2 + vh) * SEQ * 128;
    r.O = Oh + ((size_t)qh * SEQ + (size_t)qb * 256) * 128; r.P0 = qb * 256;
    return r;
}
__device__ __forceinline__ void attn_phase(char* lds, const attn::bf16* Qh, const attn::bf16* Kh, const attn::bf16* Vh, attn::bf16* Oh, int blk, int nblk) {
    constexpr int NITEMS = 256, W = 1 << 20;
    int L = (nblk == 256) ? ((blk & 7) * 32 + (blk >> 3)) : blk; if (L >= NITEMS) return;
    int pass = 0; ABR cur = attn_ref(L, 0, Qh, Kh, Vh, Oh);
    attn::Seam<attn::bf16> S;
    attn::causal_swa_prime<attn::bf16, attn::bf16>(cur, W, lds, S);
    for (;;) {
        const bool more_pass = pass == 0, more_item = L + nblk < NITEMS, last = !more_pass && !more_item;
        int passn = pass + 1, Ln = L;
        if (!more_pass) { passn = 0; Ln = more_item ? L + nblk : L; }
        const ABR nxt = last ? cur : attn_ref(Ln, passn, Qh, Kh, Vh, Oh);
        attn::causal_swa_block<attn::bf16, attn::bf16>(cur, nxt, SEQ, W, lds, S);
        if (last) break;
        cur = nxt; pass = passn; L = Ln;
    }
}

#define XB_TMO      128
#define XB_XCNT(j)  (256  + 64 * (j))
#define XB_XSUB(j)  (1280 + 64 * (j))
#define XB_XGEN(j)  (2304 + 64 * (j))
#define XB_TOP      3328
#define XB_TOPGEN   3392
#define XCD_BAR_WORDS 3456
#define XB_SPIN_CAP (1u << 18)

__device__ __forceinline__ unsigned xb_ld(unsigned* p)              { return __hip_atomic_load(p, __ATOMIC_RELAXED, __HIP_MEMORY_SCOPE_AGENT); }
__device__ __forceinline__ unsigned xb_add(unsigned* p, unsigned v) { return __hip_atomic_fetch_add(p, v, __ATOMIC_RELAXED, __HIP_MEMORY_SCOPE_AGENT); }
__device__ __forceinline__ unsigned xb_xcc_id() { return (unsigned)__builtin_amdgcn_s_getreg((3 << 11) | 20) & 0xFu; }
#define XB_SPIN(cond, bar) do { unsigned _sp = 0; while (cond) { __builtin_amdgcn_s_sleep(1); \
    if ((++_sp & 255u) == 0u) { if (xb_ld(&(bar)[XB_TMO])) break; if (_sp > XB_SPIN_CAP) { atomicAdd(&(bar)[XB_TMO], 1u); break; } } } } while (0)

struct XcdBarrier {
    unsigned* bar; unsigned x;
    volatile unsigned* st;
};

__device__ __forceinline__ XcdBarrier xcd_barrier_post(unsigned* bar, volatile unsigned* st) {
    XcdBarrier b; b.bar = bar; b.x = xb_xcc_id(); b.st = st;
    if (otid() == 0) (void)xb_add(&bar[XB_XCNT(b.x)], 1u);
    return b;
}
__device__ __forceinline__ void xcd_barrier_complete(unsigned* bar, unsigned x, unsigned& nloc, unsigned& nx) {
    const unsigned G = gridDim.x * gridDim.y * gridDim.z;
    unsigned sum, cnt, mine, sp = 0u;
    for (;;) {
        sum = 0u; cnt = 0u; mine = 0u;
#pragma unroll
        for (unsigned j = 0; j < 16; ++j) { const unsigned c = xb_ld(&bar[XB_XCNT(j)]); sum += c; cnt += (c > 0u) ? 1u : 0u; mine = (j == x) ? c : mine; }
        if (sum == G) break;
        __builtin_amdgcn_s_sleep(1);
        if ((++sp & 255u) == 0u) { if (xb_ld(&bar[XB_TMO])) break; if (sp > XB_SPIN_CAP) { atomicAdd(&bar[XB_TMO], 1u); break; } }
    }
    nloc = mine > 0u ? mine : 1u; nx = cnt > 0u ? cnt : 1u;
}

__device__ __forceinline__ void xcd_barrier(const XcdBarrier& b) {
    asm volatile("s_waitcnt vmcnt(0)" ::: "memory");
    __syncthreads();
    if (otid() == 0) {
        unsigned* bar = b.bar;
        __builtin_amdgcn_s_waitcnt(0);
        unsigned nloc = b.st[0], nx = b.st[1];
        if (nloc == 0u) { xcd_barrier_complete(bar, b.x, nloc, nx); b.st[0] = nloc; b.st[1] = nx; }
        const unsigned old = xb_add(&bar[XB_XSUB(b.x)], 1u);
        const unsigned gen = old / nloc;
        if (old + 1u == (gen + 1u) * nloc) {
            __builtin_amdgcn_fence(__ATOMIC_RELEASE, "agent");
            asm volatile("s_waitcnt vmcnt(0)" ::: "memory");
            const unsigned og = xb_add(&bar[XB_TOP], 1u);
            const unsigned tg = og / nx;
            if (og + 1u == (tg + 1u) * nx) xb_add(&bar[XB_TOPGEN], 1u);
            else XB_SPIN(xb_ld(&bar[XB_TOPGEN]) == tg, bar);
            __builtin_amdgcn_fence(__ATOMIC_ACQUIRE, "agent");
            xb_add(&bar[XB_XGEN(b.x)], 1u);
            asm volatile("s_waitcnt vmcnt(0)" ::: "memory");
        } else {
            XB_SPIN(xb_ld(&bar[XB_XGEN(b.x)]) == gen, bar);
            __builtin_amdgcn_fence(__ATOMIC_ACQUIRE, "agent");
            asm volatile("s_waitcnt vmcnt(0)" ::: "memory");
        }
    }
    __syncthreads();
}

__device__ __forceinline__ int opq(int i) { asm volatile("" : "+s"(i)); return i; }
#define inptr(i) (a.in[opq(i)])
struct Args { const void* in[26]; float* out; unsigned char* ws; int ph_lo, ph_hi; };

__device__ __forceinline__ void convert_layer(const Args& a, unsigned char* ws, int l, unsigned jobmask, unsigned char* lds, int tid, int wave, int gw, int NGW, int lane) {
    ConvJob* tab = (ConvJob*)(lds + 8 * 8704);
    if (tid == 0) { int start = 0;
#pragma nounroll
        for (int j = 0; j < 14; ++j) {
            const float* W = nullptr; const float* ksc = nullptr; int K = 0, N = 0, ldd = 0, mode = 0; bf16_t* dst = nullptr;
            switch (j) {
                case 0: W = (const float*)inptr(4) + (size_t)l * DM * DFF; K = DM; N = DFF; dst = (bf16_t*)(ws + WS_WGU1 * MiB); ldd = DM; mode = 1; ksc = (const float*)inptr(3) + l * DM; break;
                case 1: W = (const float*)inptr(5) + (size_t)l * DM * DFF; K = DM; N = DFF; dst = (bf16_t*)(ws + WS_WGU1 * MiB); ldd = DM; mode = 2; ksc = (const float*)inptr(3) + l * DM; break;
                case 2: W = (const float*)inptr(6) + (size_t)l * DM * DFF; K = DFF; N = DM; dst = (bf16_t*)(ws + WS_WD1 * MiB); ldd = DFF; break;
                case 3: W = (const float*)inptr(9) + (size_t)l * DM * DFF; K = DM; N = DFF; dst = (bf16_t*)(ws + WS_WGU2 * MiB); ldd = DM; mode = 1; ksc = (const float*)inptr(8) + l * DM; break;
                case 4: W = (const float*)inptr(10) + (size_t)l * DM * DFF; K = DM; N = DFF; dst = (bf16_t*)(ws + WS_WGU2 * MiB); ldd = DM; mode = 2; ksc = (const float*)inptr(8) + l * DM; break;
                case 5: W = (const float*)inptr(11) + (size_t)l * DM * DFF; K = DFF; N = DM; dst = (bf16_t*)(ws + WS_WD2 * MiB); ldd = DFF; break;
                case 6: W = (const float*)inptr(13) + (size_t)l * DM * DM; K = DM; N = DM; dst = (bf16_t*)(ws + WS_WPG * MiB); ldd = DM; ksc = (const float*)inptr(12) + l * DM; break;
                case 7: W = (const float*)inptr(14) + (size_t)l * PLED * DM; K = PLED; N = DM; dst = (bf16_t*)(ws + WS_WPE * MiB); ldd = PLED; break;
                case 8: if (l == 0) { W = (const float*)inptr(15); K = DM; N = 4096; } else { W = (const float*)inptr(21); K = DM; N = 8192; } dst = (bf16_t*)(ws + WS_WMIXIN * MiB); ldd = DM; ksc = (const float*)inptr(7) + l * DM; break;
                case 9: W = (const float*)(l == 0 ? inptr(20) : inptr(24)); K = DM; N = DM; dst = (bf16_t*)(ws + WS_WMIXOUT * MiB); ldd = DM; break;
                default: if (l == 0) { const int g = j - 10; W = (const float*)inptr(16) + (size_t)g * 65536; K = 256; N = 256; dst = (bf16_t*)(ws + WS_WPOOL * MiB) + (size_t)g * 65536; ldd = 256; } else { W = (const float*)inptr(16); K = 0; N = 64; dst = (bf16_t*)(ws + WS_WPOOL * MiB); ldd = 256; } break;
            }
            if (!((jobmask >> j) & 1u)) K = 0;
            ConvJob jb; jb.W = W; jb.ksc = ksc; jb.dst = dst; jb.K = K; jb.N = N; jb.ldd = ldd; jb.mode = mode; jb.start = start; jb.pad = 0;
            tab[j] = jb; start += (K >> 5) * (N >> 6);
        }
        tab[14].start = start;
    }
    __syncthreads();
    const int total = tab[14].start; float* scr = (float*)(lds + wave * 8704);
    f32x4 va[8], vb[8];
    int g0 = gw; if (g0 < total) conv_load(tab, g0, va, lane);
#pragma nounroll
    for (;;) {
        if (g0 >= total) break;
        const int g1 = g0 + NGW; if (g1 < total) conv_load(tab, g1, vb, lane);
        conv_proc(tab, g0, va, scr, lane);
        if (g1 >= total) break;
        g0 = g1 + NGW; if (g0 < total) conv_load(tab, g0, va, lane);
        conv_proc(tab, g1, vb, scr, lane);
    }
    __syncthreads();
}
#ifndef KMASK
#define KMASK 0xFFF
#endif
#define KON(k) if constexpr (((KMASK) >> (k)) & 1)
#define LOCAL_IDS const int tid = otid(), lane = tid & 63, wave = __builtin_amdgcn_readfirstlane(tid >> 6), gw = blk * 8 + wave; (void)gw; (void)lane
__global__ void __launch_bounds__(512, 2) mega_fwd(Args a) {
    extern __shared__ __attribute__((aligned(16))) unsigned char lds[];
    cg::grid_group grid = cg::this_grid();
    const int G = gridDim.x, blk = blockIdx.x, NGW = G * 8;
    volatile unsigned* bst = (volatile unsigned*)(lds + 131072);
    if (otid() < 2) bst[otid()] = 0u;
    __syncthreads();
    XcdBarrier xbar = xcd_barrier_post((unsigned*)(a.ws + CTL_BAR_BYTE), bst);
    for (int ph = a.ph_lo; ph < a.ph_hi; ++ph) {
        size_t zoff = 0; asm volatile("" : "+s"(zoff));
        unsigned char* ws = a.ws + zoff; float* out = a.out + zoff;
        float* ctl = (float*)(ws + WS_CTL * MiB);
        float* rope = (float*)(ws + WS_ROPE * MiB);
        bf16_t* Hb = (bf16_t*)(ws + WS_H * MiB);
        bf16_t* GU = (bf16_t*)(ws + WS_GU * MiB);
        bf16_t* PE = (bf16_t*)(ws + WS_PE * MiB);
        bf16_t* PB = (bf16_t*)(ws + WS_PB * MiB);
        int kind = 0, l = 0, sub = 0;
        if (ph > 0) { l = ph >= 11 ? 1 : 0; const int r = ph - (l ? 11 : 1);
            const unsigned long long kk = l ? 0x37212BA9821ULL : 0x3721265421ULL, ss = l ? 0x40112000000ULL : 0x3011200000ULL;
            kind = (int)((kk >> (4 * r)) & 15ULL); sub = (int)((ss >> (4 * r)) & 15ULL); }
        unsigned long long* SS = (unsigned long long*)(ws + CTL_SS_BYTE);
#ifdef DUPMASK
        const int nrep = (((DUPMASK) >> kind) & 1) && kind != 2 && kind != 7 && kind != 10 && !(kind == 3 && sub == 4) ? 2 : 1;
#else
        const int nrep = 1;
#endif
        for (int rep = 0; rep < nrep; ++rep)
        switch (kind) {
        case 0: KON(0) {
            LOCAL_IDS;
            convert_layer(a, ws, 0, G == 256 ? 0x3FDBu : 0x3FFFu, lds, tid, wave, gw, NGW, lane);
            for (int i = blk * 512 + tid; i < 8 * 8192; i += G * 512) SS[8192 + i] = 0ull;
            { const f32x4* __restrict__ p4 = (const f32x4*)inptr(1); u32x2* __restrict__ o = (u32x2*)PB; const int n4 = 2 * MTOK * PLED / 4;
#pragma unroll 4
              for (int i = blk * 512 + tid; i < n4; i += G * 512) { const f32x4 v = p4[i]; u32x2 w; w.x = pk2(v.x, v.y); w.y = pk2(v.z, v.w); o[i] = w; } }
            { const int* pos = (const int*)inptr(2);
              for (int i = blk * 512 + tid; i < MTOK * 16; i += G * 512) { const int row = i >> 4, j = i & 15;
                  const float inv_freq = exp2f(-(float)j * (18.931568569324174f / 16.f));
                  const float ang = (float)pos[row] * inv_freq;
                  double rev = (double)ang * 0.15915494309189535; rev -= floor(rev);
                  const float rf = (float)rev;
                  rope[row * 32 + j] = __builtin_amdgcn_cosf(rf); rope[row * 32 + 16 + j] = __builtin_amdgcn_sinf(rf); } }
            if (blk == 0) {
                if (wave == 0) { const float* lp = (const float*)inptr(18); float s1 = 0.f, s2 = 0.f;
                    for (int i = lane; i < 128; i += 64) { s1 += lp[i] * lp[128 + i]; s2 += lp[256 + i] * lp[384 + i]; }
                    s1 = wave_sum(s1); s2 = wave_sum(s2);
                    if (lane == 0) ctl[CTL_LAM] = expf(s1) - expf(s2) + 0.2f; }
                const float* lb = (const float*)inptr(22);
                for (int i = tid; i < DM; i += 512) { const float b0 = lb[i], b1 = lb[DM + i], mx = fmaxf(b0, b1), e0 = expf(b0 - mx), e1 = expf(b1 - mx); ctl[CTL_LBS + i] = e1 / (e0 + e1); }
            }
            prep_rows((const float*)inptr(0), (bf16_t*)(ws + WS_LT * MiB), SS, gw, NGW, lane);
        } break;
        case 1: KON(1) {
            { pg8::Gemm g{sub ? Hb : (const bf16_t*)(ws + WS_LT * MiB), (const bf16_t*)(ws + (sub ? WS_WGU2 : WS_WGU1) * MiB), MTOK, 2 * DFF, DM, DM, DM, 0}; pg8::StaticOrder S; S.init(MTOK, 2 * DFF, G, blk);
              pg8::EpiSwiGLU E{GU, DFF, SS + 8192 * (4 * l + (sub ? 2 : 0))};
              pg8::gemm_phase<pg8::EpiSwiGLU, pg8::StaticOrder, true, true>((PG8_LAS unsigned char*)lds, g, S, E); }
            if (sub) { pg8::Gemm g{PB + (size_t)l * MTOK * PLED, (const bf16_t*)(ws + WS_WPE * MiB), MTOK, DM, PLED, PLED, PLED, 0}; asm volatile("" : "+s"(g.K)); pg8::StaticOrder S; S.init(MTOK, DM, G, blk);
              pg8::EpiF32<2> E{nullptr, nullptr, nullptr, PE, nullptr, ws, 1, 0, 0};
              pg8::gemm_phase<pg8::EpiF32<2>, pg8::StaticOrder, true, true>((PG8_LAS unsigned char*)lds, g, S, E); }
            if (G == 256 && blk >= 128) { LOCAL_IDS; convert_layer(a, ws, l, sub ? 0x20u : 0x4u, lds, tid, wave, (blk - 128) * 8 + wave, 128 * 8, lane); }
        } break;
        case 2: KON(2) {
            pg8::Gemm g; const float* basef = (l == 0 && sub == 0) ? (const float*)inptr(0) : nullptr;
            const bf16_t* baseb = (l == 1 && sub == 0) ? (const bf16_t*)(ws + WS_LT * MiB) : Hb;
            if (sub == 2) { g = pg8::Gemm{(const bf16_t*)(ws + (l ? WS_OHG : WS_CC) * MiB), (const bf16_t*)(ws + WS_WMIXOUT * MiB), MTOK, DM, DM, DM, DM, 0}; }
            else { g = pg8::Gemm{GU, (const bf16_t*)(ws + (sub ? WS_WD2 : WS_WD1) * MiB), MTOK, DM, DFF, DFF, DFF, 0}; }
            pg8::StaticOrder S; S.init(MTOK, DM, G, blk);
            pg8::EpiF32<0> E{basef, baseb, nullptr, Hb, nullptr, ws, sub == 2 ? 1 : 0, 4 * l + (sub == 0 ? 1 : sub == 2 ? 2 : 3), 0};
            pg8::gemm_phase<pg8::EpiF32<0>, pg8::StaticOrder, true, true>((PG8_LAS unsigned char*)lds, g, S, E);
        } break;
        case 3: KON(3) {
            LOCAL_IDS;
            if (sub == 3) convert_layer(a, ws, 1, G == 256 ? 0x3FDBu : 0x3FFFu, lds, tid, wave, gw, NGW, lane);
            else final_rows(out, (const float*)inptr(25), SS + 8192 * 8, gw, NGW, lane);
        } break;
        case 4: KON(4) {
            pg8::Gemm g{Hb, (const bf16_t*)(ws + WS_WMIXIN * MiB), MTOK, 4096, DM, DM, DM, 0}; pg8::StaticOrder S; S.init(MTOK, 4096, G, blk);
            pg8::EpiABin E{(float*)(ws + WS_U * MiB), (bf16_t*)(ws + WS_QH * MiB), rope, SS + 8192 * 1};
            pg8::gemm_phase<pg8::EpiABin, pg8::StaticOrder, true, true>((PG8_LAS unsigned char*)lds, g, S, E);
        } break;
        case 5: KON(5) {
            { LOCAL_IDS; pool_diff((const float*)(ws + WS_U * MiB), (bf16_t*)(ws + WS_DP * MiB), blk, G, tid); }
            attn_phase((char*)lds, (const attn::bf16*)(ws + WS_QH * MiB), (const attn::bf16*)(ws + WS_KH * MiB), (const attn::bf16*)(ws + WS_VH * MiB), (attn::bf16*)(ws + WS_OH * MiB), blk, G);
        } break;
        case 6: KON(6) {
            { pg8::Gemm g{(const bf16_t*)(ws + WS_DP * MiB), (const bf16_t*)(ws + WS_WPOOL * MiB), MTOK, 1024, 256, 1024, 256, 512}; asm volatile("" : "+s"(g.K)); pg8::StaticOrder S; S.init(MTOK, 1024, G, blk);
              pg8::EpiPool E{(bf16_t*)(ws + WS_CC * MiB), DM, (const float*)inptr(17)};
              pg8::gemm_phase<pg8::EpiPool, pg8::StaticOrder, true, true>((PG8_LAS unsigned char*)lds, g, S, E); }
            LOCAL_IDS;
            attn_combine((const bf16_t*)(ws + WS_OH * MiB), (const float*)inptr(19), ctl + CTL_LAM, (bf16_t*)(ws + WS_CC * MiB), gw, NGW, lane);
        } break;
        case 7: KON(7) {
            pg8::Gemm g{Hb, (const bf16_t*)(ws + WS_WPG * MiB), MTOK, DM, DM, DM, DM, 0}; pg8::StaticOrder S; S.init(MTOK, DM, G, blk);
            pg8::EpiF32<1> E{nullptr, Hb, l ? out : nullptr, (bf16_t*)(ws + WS_LT * MiB), PE, ws, 1, 4 * l + 4, 4 * l + 3};
            pg8::gemm_phase<pg8::EpiF32<1>, pg8::StaticOrder, true, true>((PG8_LAS unsigned char*)lds, g, S, E);
        } break;
        case 8: KON(8) {
            pg8::Gemm g{Hb, (const bf16_t*)(ws + WS_WMIXIN * MiB), MTOK, 8192, DM, DM, DM, 0}; pg8::StaticOrder S; S.init(MTOK, 8192, G, blk);
            pg8::EpiHin E{(bf16_t*)(ws + WS_QS * MiB), (float*)(ws + WS_LF * MiB), ctl + CTL_LBS, SS + 8192 * 5};
            pg8::gemm_phase<pg8::EpiHin, pg8::StaticOrder, true, true>((PG8_LAS unsigned char*)lds, g, S, E);
        } break;
        case 9: KON(9) { LOCAL_IDS; hgrn_passA(lds, (const float*)(ws + WS_LF * MiB), (const bf16_t*)(ws + WS_KB * MiB), (const bf16_t*)(ws + WS_VB * MiB), (bf16_t*)(ws + WS_LT * MiB), (float*)(ws + WS_DEC * MiB), blk, G, tid, wave, lane); } break;
        case 10: KON(10) { LOCAL_IDS; hgrn_scan((bf16_t*)(ws + WS_LT * MiB), (const float*)(ws + WS_DEC * MiB), blk * 512 + tid, G * 512); } break;
        case 11: KON(11) { LOCAL_IDS; hgrn_passC(lds, (const float*)(ws + WS_LF * MiB), (const bf16_t*)(ws + WS_QS * MiB), (const bf16_t*)(ws + WS_KB * MiB), (const bf16_t*)(ws + WS_VB * MiB), (const bf16_t*)(ws + WS_GS * MiB),
                            (const bf16_t*)(ws + WS_LT * MiB), (const float*)inptr(23), (bf16_t*)(ws + WS_OHG * MiB), blk, G, tid, wave, lane); } break;
        default: break;
        }
#ifdef DUPSYNC
        for (int srep = 0; srep < 2; ++srep)
#endif
        if (ph + 1 < a.ph_hi) {
            { int phh = a.ph_hi; asm volatile("" : "+s"(phh)); if (phh > 1000) grid.sync(); }
            xcd_barrier(xbar);
        }
    }
}

#ifndef MK_MULTI
#define MK_MULTI 0
#endif
extern "C" void kernel_launch(void* const* d_in, const int* in_sizes, int n_in, void* d_out, int out_size, void* d_ws, size_t ws_size, hipStream_t stream) {
    static int grid = 0;
    if (grid == 0) {
        if (n_in != 26 || out_size != MTOK * DM || ws_size < WS_END * MiB) { fprintf(stderr, "kernel_launch: unexpected shapes (n_in %d, out %d, ws %zu)\n", n_in, out_size, ws_size); grid = -1; return; }
        int dev = 0, cus = 0, per_cu = 0;
        (void)hipGetDevice(&dev); (void)hipDeviceGetAttribute(&cus, hipDeviceAttributeMultiprocessorCount, dev);
        (void)hipFuncSetAttribute((const void*)mega_fwd, hipFuncAttributeMaxDynamicSharedMemorySize, LDS_BYTES);
        (void)hipOccupancyMaxActiveBlocksPerMultiprocessor(&per_cu, (const void*)mega_fwd, 512, LDS_BYTES);
        if (per_cu < 1) { fprintf(stderr, "kernel_launch: occupancy query says %d blocks per CU\n", per_cu); per_cu = 1; }
        (void)hipGetLastError();
        grid = cus > 0 ? cus : 256;
    }
    if (grid < 0) return;
    (void)hipMemsetAsync((char*)d_ws + CTL_BAR_BYTE, 0, CTL_BAR_BYTES, stream);
    Args a{};
    for (int i = 0; i < 26; ++i) a.in[i] = d_in[i];
    a.out = (float*)d_out; a.ws = (unsigned char*)d_ws;
#if MK_MULTI
    for (int ph = 0; ph < NPH; ++ph) { a.ph_lo = ph; a.ph_hi = ph + 1; hipLaunchKernelGGL(mega_fwd, dim3(grid), dim3(512), LDS_BYTES, stream, a); }
#else
    a.ph_lo = 0; a.ph_hi = NPH;
    void* args[] = {&a};
    hipError_t e = hipLaunchCooperativeKernel((const void*)mega_fwd, dim3(grid), dim3(512), args, LDS_BYTES, stream);
    if (e != hipSuccess) fprintf(stderr, "cooperative launch failed: %s (grid %d)\n", hipGetErrorString(e), grid);
#ifdef PROBE_LIST
    { const int plist[] = PROBE_LIST;
      for (int p : plist) { Args a2 = a; a2.out = (float*)((char*)d_ws + WS_LT * MiB); a2.ph_lo = p; a2.ph_hi = p + 1; void* args2[] = {&a2};
          (void)hipLaunchCooperativeKernel((const void*)mega_fwd, dim3(grid), dim3(512), args2, LDS_BYTES, stream); } }
#endif
#endif
}
```

```cpp
#include <hip/hip_runtime.h>
#include <hip/hip_bf16.h>
#include <hip/hip_cooperative_groups.h>
#include <cstdio>
#include <cstdint>
namespace cg = cooperative_groups;
__device__ __forceinline__ int otid() { int t = threadIdx.x; asm volatile("" : "+v"(t)); return t; }

namespace pg8 {
#define PG8_LAS __attribute__((address_space(3)))
typedef unsigned short bf16_t;
typedef short bf16x8 __attribute__((ext_vector_type(8)));
typedef float f32x4 __attribute__((ext_vector_type(4)));
typedef unsigned u32x4 __attribute__((ext_vector_type(4)));
typedef unsigned u32x2 __attribute__((ext_vector_type(2)));
constexpr int BM = 256, BK = 64, HALF = 128, HTB = HALF * BK * 2, STAGE_BYTES = 8 * HTB, NXCD = 8, WGM = 8;

__host__ __device__ __forceinline__ int lds_byte(int r, int c) { const int st = (r >> 4) * 2 + (c >> 5), rr = r & 15, cc = c & 31, ob = rr * 64 + cc * 2; return st * 1024 + (ob ^ (((ob >> 9) & 1) << 5)); }
__host__ __device__ __forceinline__ void stage_rc(int b, int& R, int& C) { const int st = b / 1024, sb = b % 1024, swz = sb ^ (((sb >> 9) & 1) << 5); R = (st >> 1) * 16 + swz / 64; C = (st & 1) * 32 + (swz % 64) / 2; }
__host__ __device__ __forceinline__ int perm32(int rho) { const int n = rho >> 4, i = rho & 15; return 8 * (i >> 2) + 4 * n + (i & 3); }

struct Unit { int pm, pn; };
struct Gemm { const bf16_t* A; const bf16_t* Bt; int M, N, K, lda, ldb; size_t apn; };

struct StaticOrder {
    int nM, nN, nwg, G, c;
    __host__ __device__ void init(int M, int N, int G_, int c_) { nM = M / BM; nN = N / BM; nwg = nM * nN; G = G_; c = c_; }
    __host__ __device__ bool next(int i, Unit& u) const {
        const long L = (long)i * G + c; if (L >= nwg) return false;
        int wgid = (int)L; { const int q = nwg / NXCD, r = nwg % NXCD, xcd = wgid % NXCD, off = wgid / NXCD; wgid = (xcd < r ? xcd * (q + 1) : r * (q + 1) + (xcd - r) * q) + off; }
        const int nig = WGM * nN, gid = wgid / nig, fm = gid * WGM, gsz = (nM - fm) < WGM ? (nM - fm) : WGM;
        u.pm = fm + ((wgid % nig) % gsz); u.pn = (wgid % nig) / gsz; return true;
    }
    __device__ __forceinline__ void a_ready(const Unit&) const {}
    __device__ __forceinline__ void done(const Unit&) const {}
};

__device__ __forceinline__ unsigned cvt_pk_bf16(float lo, float hi) { unsigned r; asm volatile("v_cvt_pk_bf16_f32 %0, %1, %2" : "=v"(r) : "v"(lo), "v"(hi)); return r; }
__device__ __forceinline__ float fsigmoid(float v) { return __builtin_amdgcn_rcpf(1.0f + __builtin_amdgcn_exp2f(-1.4426950408889634f * v)); }
__device__ __forceinline__ float fsilu(float v) { return v * fsigmoid(v); }


struct EpiSwiGLU {
    static constexpr bool PERM = true, AFTER_DRAIN = false, HAS_PRE = true;
    __device__ __forceinline__ void prefetch(const Unit& u, float (&pre)[2][4], int wr, int fr) const {
        const unsigned long long* sp = ssin + u.pm * BM + wr * 64 + fr;
#pragma unroll
        for (int ai = 0; ai < 2; ++ai)
#pragma unroll
            for (int m = 0; m < 4; ++m) pre[ai][m] = (float)sp[ai * HALF + m * 16] * (1.f / 1048576.f);
    }

    bf16_t* O; int ldc; const unsigned long long* ssin;
    __device__ __forceinline__ void operator()(const f32x4 (&acc)[2][2][4][2], const Unit& u, int wr, int wc, int fr_, int fq, const float (&pre)[2][4]) const {
        int fr = fr_; asm volatile("" : "+v"(fr));
        const int row0 = u.pm * BM + wr * 64 + fr, col0 = u.pn * HALF + wc * 32 + 8 * fq;
        float rs[2][4];
#pragma unroll
        for (int ai = 0; ai < 2; ++ai)
#pragma unroll
            for (int m = 0; m < 4; ++m) rs[ai][m] = rsqrtf(pre[ai][m] * (1.f / 2048.f) + 1e-6f);
#pragma unroll
        for (int ai = 0; ai < 2; ++ai)
#pragma unroll
            for (int m = 0; m < 4; ++m) { bf16_t* rowp = O + (size_t)(row0 + ai * HALF + m * 16) * ldc + col0; const float r = rs[ai][m];
                f32x4 g0 = acc[ai][0][m][0] * r, g1 = acc[ai][0][m][1] * r, u0 = acc[ai][1][m][0] * r, u1 = acc[ai][1][m][1] * r;
                f32x4 v0, v1;
#pragma unroll
                for (int i = 0; i < 4; ++i) { v0[i] = fsilu(g0[i]) * u0[i]; v1[i] = fsilu(g1[i]) * u1[i]; }
                u32x4 w; w.x = cvt_pk_bf16(v0[0], v0[1]); w.y = cvt_pk_bf16(v0[2], v0[3]); w.z = cvt_pk_bf16(v1[0], v1[1]); w.w = cvt_pk_bf16(v1[2], v1[3]);
                __builtin_nontemporal_store(w, (u32x4*)rowp); asm volatile("" ::: "memory"); }
    }
};
template <int MODE> struct EpiF32 {
    static constexpr bool PERM = true, AFTER_DRAIN = false, HAS_PRE = (MODE == 1);
    __device__ __forceinline__ void prefetch(const Unit& u, float (&pre)[2][4], int wr, int fr) const {
        const unsigned long long* sp = ((const unsigned long long*)(wsb + 131072) + 8192 * slot_in) + u.pm * BM + wr * 64 + fr;
#pragma unroll
        for (int ai = 0; ai < 2; ++ai)
#pragma unroll
            for (int m = 0; m < 4; ++m) pre[ai][m] = (float)sp[ai * HALF + m * 16] * (1.f / 1048576.f);
    }
    const float* basef; const bf16_t* baseb; float* outf; bf16_t* outb; const bf16_t* pe; unsigned char* wsb; int full, slot_out, slot_in;
    static constexpr int ldc = 2048;
    __device__ __forceinline__ void operator()(const f32x4 (&acc)[2][2][4][2], const Unit& u, int wr, int wc, int fr_, int fq, const float (&pre)[2][4]) const {
        int fr = fr_; asm volatile("" : "+v"(fr));
        const int row0 = u.pm * BM + wr * 64 + fr, col0 = u.pn * BM + wc * 32 + 8 * fq;
        const float scale = full ? 1.f : 0.5f;
        unsigned long long* ssout = (unsigned long long*)(wsb + 131072) + 8192 * slot_out;
        float rs[2][4];
        if (MODE == 1) {
#pragma unroll
            for (int ai = 0; ai < 2; ++ai)
#pragma unroll
                for (int m = 0; m < 4; ++m) rs[ai][m] = rsqrtf(pre[ai][m] * (1.f / 2048.f) + 1e-6f);
        }
        constexpr int MB = (MODE == 1) ? 2 : 4;
#pragma unroll
        for (int ai = 0; ai < 2; ++ai)
#pragma unroll
        for (int m0 = 0; m0 < 4; m0 += MB) {
            u32x4 bw[MB][2], pw[MB][2];
            if (MODE != 2) {
#pragma unroll
                for (int mm = 0; mm < MB; ++mm)
#pragma unroll
                    for (int bj = 0; bj < 2; ++bj) { const size_t o2 = (size_t)(row0 + ai * HALF + (m0 + mm) * 16) * ldc + col0 + bj * HALF;
                        if (!(MODE == 0 && basef)) bw[mm][bj] = *(const u32x4*)(baseb + o2);
                        if (MODE == 1) pw[mm][bj] = *(const u32x4*)(pe + o2); }
            }
#pragma unroll
            for (int mm = 0; mm < MB; ++mm) { const int m = m0 + mm, row = row0 + ai * HALF + m * 16; float ssq = 0.f;
#pragma unroll
                for (int bj = 0; bj < 2; ++bj) { const size_t o2 = (size_t)row * ldc + col0 + bj * HALF; const f32x4 a0 = acc[ai][bj][m][0], a1 = acc[ai][bj][m][1]; f32x4 r0, r1, b0, b1;
                    if (MODE != 2) {
                        if (MODE == 0 && basef) { b0 = *(const f32x4*)(basef + o2); b1 = *(const f32x4*)(basef + o2 + 4); }
                        else { const u32x4 w = bw[mm][bj];
                            b0 = (f32x4){__uint_as_float(w.x << 16), __uint_as_float(w.x & 0xffff0000u), __uint_as_float(w.y << 16), __uint_as_float(w.y & 0xffff0000u)};
                            b1 = (f32x4){__uint_as_float(w.z << 16), __uint_as_float(w.z & 0xffff0000u), __uint_as_float(w.w << 16), __uint_as_float(w.w & 0xffff0000u)}; } }
                    if (MODE == 0) { r0 = b0 + a0 * scale; r1 = b1 + a1 * scale; }
                    else if (MODE == 1) { const u32x4 w = pw[mm][bj]; const float rr = rs[ai][m];
                        const f32x4 p0 = (f32x4){__uint_as_float(w.x << 16), __uint_as_float(w.x & 0xffff0000u), __uint_as_float(w.y << 16), __uint_as_float(w.y & 0xffff0000u)};
                        const f32x4 p1 = (f32x4){__uint_as_float(w.z << 16), __uint_as_float(w.z & 0xffff0000u), __uint_as_float(w.w << 16), __uint_as_float(w.w & 0xffff0000u)};
#pragma unroll
                        for (int i = 0; i < 4; ++i) { r0[i] = b0[i] + p0[i] * fsigmoid(a0[i] * rr); r1[i] = b1[i] + p1[i] * fsigmoid(a1[i] * rr); } }
                    else { r0 = a0; r1 = a1; }
                    if (MODE == 1 && outf) { *(f32x4*)(outf + o2) = r0; *(f32x4*)(outf + o2 + 4) = r1; }
                    else { u32x4 w; w.x = cvt_pk_bf16(r0[0], r0[1]); w.y = cvt_pk_bf16(r0[2], r0[3]); w.z = cvt_pk_bf16(r1[0], r1[1]); w.w = cvt_pk_bf16(r1[2], r1[3]); *(u32x4*)(outb + o2) = w; }
                    if (MODE != 2) ssq += ((r0[0] * r0[0] + r0[1] * r0[1]) + (r0[2] * r0[2] + r0[3] * r0[3])) + ((r1[0] * r1[0] + r1[1] * r1[1]) + (r1[2] * r1[2] + r1[3] * r1[3])); }
                if (MODE != 2) { ssq += __shfl_xor(ssq, 16); ssq += __shfl_xor(ssq, 32); if (fq == 0) __hip_atomic_fetch_add(ssout + row, (unsigned long long)(ssq * 1048576.f + 0.5f), __ATOMIC_RELAXED, __HIP_MEMORY_SCOPE_AGENT); } }
            asm volatile("" ::: "memory"); }
    }
};
struct EpiPool {
    static constexpr bool PERM = true, AFTER_DRAIN = false, HAS_PRE = false;
    bf16_t* O; int ldc; const float* cs;
    __device__ __forceinline__ void operator()(const f32x4 (&acc)[2][2][4][2], const Unit& u, int wr, int wc, int fr_, int fq, const float (&pre)[2][4]) const {
        int fr = fr_; asm volatile("" : "+v"(fr));
        const int row0 = u.pm * BM + wr * 64 + fr, col0 = u.pn * BM + wc * 32 + 8 * fq;
#pragma unroll
        for (int bj = 0; bj < 2; ++bj) { const f32x4 s0 = *(const f32x4*)(cs + col0 + bj * HALF), s1 = *(const f32x4*)(cs + col0 + bj * HALF + 4);
#pragma unroll
            for (int ai = 0; ai < 2; ++ai)
#pragma unroll
                for (int m = 0; m < 4; ++m) { bf16_t* rowp = O + (size_t)(row0 + ai * HALF + m * 16) * ldc + col0 + bj * HALF;
                    const f32x4 v0 = acc[ai][bj][m][0] * s0, v1 = acc[ai][bj][m][1] * s1;
                    u32x4 w; w.x = cvt_pk_bf16(v0[0], v0[1]); w.y = cvt_pk_bf16(v0[2], v0[3]); w.z = cvt_pk_bf16(v1[0], v1[1]); w.w = cvt_pk_bf16(v1[2], v1[3]);
                    *(u32x4*)rowp = w; asm volatile("" ::: "memory"); } }
    }
};
struct EpiABin {
    static constexpr bool PERM = true, AFTER_DRAIN = false, HAS_PRE = true;
    __device__ __forceinline__ void prefetch(const Unit& u, float (&pre)[2][4], int wr, int fr) const {
        const unsigned long long* sp = ssin + u.pm * BM + wr * 64 + fr;
#pragma unroll
        for (int ai = 0; ai < 2; ++ai)
#pragma unroll
            for (int m = 0; m < 4; ++m) pre[ai][m] = (float)sp[ai * HALF + m * 16] * (1.f / 1048576.f);
    }

    float* U; bf16_t* Qh; const float* rope; const unsigned long long* ssin;
    __device__ __forceinline__ void operator()(const f32x4 (&acc)[2][2][4][2], const Unit& u, int wr, int wc, int fr_, int fq, const float (&pre)[2][4]) const {
        int fr = fr_; asm volatile("" : "+v"(fr));
        const int row0 = u.pm * BM + wr * 64 + fr;
        float rs[2][4];
#pragma unroll
        for (int ai = 0; ai < 2; ++ai)
#pragma unroll
            for (int m = 0; m < 4; ++m) rs[ai][m] = rsqrtf(pre[ai][m] * (1.f / 2048.f) + 1e-6f);
        if (u.pn < 4) {
            const int col0 = u.pn * BM + wc * 32 + 8 * fq;
#pragma unroll
            for (int ai = 0; ai < 2; ++ai)
#pragma unroll
                for (int m = 0; m < 4; ++m) { float* rowp = U + (size_t)(row0 + ai * HALF + m * 16) * 1024 + col0; const float r = rs[ai][m];
#pragma unroll
                    for (int bj = 0; bj < 2; ++bj) { *(f32x4*)(rowp + bj * HALF) = acc[ai][bj][m][0] * r; *(f32x4*)(rowp + bj * HALF + 4) = acc[ai][bj][m][1] * r; } }
            return;
        }
        const int kind = u.pn >> 2, h = u.pn & 3, b = u.pm >> 4;
        bf16_t* dst = Qh + (size_t)(kind - 1) * 8388608;
        const bool do_rope = (kind != 3) && (wc == 0);
#pragma unroll
        for (int ai = 0; ai < 2; ++ai)
#pragma unroll
            for (int m = 0; m < 4; ++m) { const int row = row0 + ai * HALF + m * 16, s = row & 4095;
                f32x4 c0, c1, s0, s1;
                if (do_rope) { const float* rp = rope + (size_t)row * 32 + 8 * (fq & 1); c0 = *(const f32x4*)rp; c1 = *(const f32x4*)(rp + 4); s0 = *(const f32x4*)(rp + 16); s1 = *(const f32x4*)(rp + 20); }
#pragma unroll
                for (int bj = 0; bj < 2; ++bj) { f32x4 v0 = acc[ai][bj][m][0] * rs[ai][m], v1 = acc[ai][bj][m][1] * rs[ai][m];
                    if (do_rope) {
#pragma unroll
                        for (int i = 0; i < 4; ++i) { const float p0 = __shfl_xor(v0[i], 32), p1 = __shfl_xor(v1[i], 32);
                            v0[i] = (fq < 2) ? (v0[i] * c0[i] - p0 * s0[i]) : (v0[i] * c0[i] + p0 * s0[i]);
                            v1[i] = (fq < 2) ? (v1[i] * c1[i] - p1 * s1[i]) : (v1[i] * c1[i] + p1 * s1[i]); } }
                    bf16_t* p = dst + ((size_t)(((b * 4 + h) * 2 + bj) * 4096 + s)) * 128 + wc * 32 + 8 * fq;
                    u32x4 w; w.x = cvt_pk_bf16(v0[0], v0[1]); w.y = cvt_pk_bf16(v0[2], v0[3]); w.z = cvt_pk_bf16(v1[0], v1[1]); w.w = cvt_pk_bf16(v1[2], v1[3]);
                    *(u32x4*)p = w; }
                asm volatile("" ::: "memory"); }
    }
};
struct EpiHin {
    static constexpr bool PERM = true, AFTER_DRAIN = false, HAS_PRE = true;
    __device__ __forceinline__ void prefetch(const Unit& u, float (&pre)[2][4], int wr, int fr) const {
        const unsigned long long* sp = ssin + u.pm * BM + wr * 64 + fr;
#pragma unroll
        for (int ai = 0; ai < 2; ++ai)
#pragma unroll
            for (int m = 0; m < 4; ++m) pre[ai][m] = (float)sp[ai * HALF + m * 16] * (1.f / 1048576.f);
    }

    bf16_t* Qs; float* LF; const float* lbs; const unsigned long long* ssin;
    __device__ __forceinline__ void operator()(const f32x4 (&acc)[2][2][4][2], const Unit& u, int wr, int wc, int fr_, int fq, const float (&pre)[2][4]) const {
        int fr = fr_; asm volatile("" : "+v"(fr));
        const int row0 = u.pm * BM + wr * 64 + fr, split = u.pn >> 3, col0 = (u.pn & 7) * BM + wc * 32 + 8 * fq;
        bf16_t* dst = Qs + (size_t)split * 16777216;
        float rs[2][4];
#pragma unroll
        for (int ai = 0; ai < 2; ++ai)
#pragma unroll
            for (int m = 0; m < 4; ++m) rs[ai][m] = rsqrtf(pre[ai][m] * (1.f / 2048.f) + 1e-6f);
#pragma unroll
        for (int bj = 0; bj < 2; ++bj) {
            f32x4 l0 = {0.f, 0.f, 0.f, 0.f}, l1 = l0;
            if (split == 1) { l0 = *(const f32x4*)(lbs + col0 + bj * HALF); l1 = *(const f32x4*)(lbs + col0 + bj * HALF + 4); }
#pragma unroll
            for (int ai = 0; ai < 2; ++ai)
#pragma unroll
                for (int m = 0; m < 4; ++m) { const size_t off = (size_t)(row0 + ai * HALF + m * 16) * 2048 + col0 + bj * HALF;
                    f32x4 v0 = acc[ai][bj][m][0] * rs[ai][m], v1 = acc[ai][bj][m][1] * rs[ai][m];
                    if (split == 0 || split == 3) {
#pragma unroll
                        for (int i = 0; i < 4; ++i) { v0[i] = fsilu(v0[i]); v1[i] = fsilu(v1[i]); }
                    } else if (split == 1) { f32x4 f0, f1;
#pragma unroll
                        for (int i = 0; i < 4; ++i) { const float sg0 = fsigmoid(v0[i]), sg1 = fsigmoid(v1[i]);
                            f0[i] = __logf(l0[i] + (1.f - l0[i]) * sg0); f1[i] = __logf(l1[i] + (1.f - l1[i]) * sg1);
                            v0[i] = (1.f - l0[i]) * fsigmoid(-v0[i]); v1[i] = (1.f - l1[i]) * fsigmoid(-v1[i]); }
                        *(f32x4*)(LF + off) = f0; *(f32x4*)(LF + off + 4) = f1; }
                    u32x4 w; w.x = cvt_pk_bf16(v0[0], v0[1]); w.y = cvt_pk_bf16(v0[2], v0[3]); w.z = cvt_pk_bf16(v1[0], v1[1]); w.w = cvt_pk_bf16(v1[2], v1[3]);
                    *(u32x4*)(dst + off) = w; asm volatile("" ::: "memory"); } }
    }
};

template <class Epi, class Sched, bool ALIGN_EPI = false, bool SP2 = false>
__device__ __forceinline__ void gemm_phase(PG8_LAS unsigned char* lds, const Gemm g, const Sched& S, const Epi& E) {
    const int tid = otid(), wid = __builtin_amdgcn_readfirstlane(tid >> 6), lane = tid & 63, wr = wid >> 2, wc = wid & 3, fr = lane & 15, fq = lane >> 4;
    const int K = g.K, nt = K / BK;
    unsigned voffA[2], voffB[2];
#pragma unroll
    for (int i = 0; i < 2; ++i) { int R, C; stage_rc(tid * 16 + i * 8192, R, C); const int Rb = Epi::PERM ? ((R & ~31) + perm32(R & 31)) : R;
        voffA[i] = (unsigned)(R * g.lda + C) * 2u; voffB[i] = (unsigned)(Rb * g.ldb + C) * 2u; }
    const size_t kstep = (size_t)(BK * 2);
    const size_t hstepA = (size_t)HALF * g.lda * 2, hstepB = (size_t)HALF * g.ldb * 2;
    const size_t tstepA = 2 * hstepA, tstepB = 2 * hstepB;
    const unsigned ldsw = (unsigned)wid * 1024u;
    const int aoff = lds_byte(wr * 64 + fr, fq * 8), boff = lds_byte(wc * 32 + fr, fq * 8);
#define PG8_SA(b, h) (((b) * 2 + (h)) * HTB)
#define PG8_SB(b, h) ((4 + (b) * 2 + (h)) * HTB)
#define PG8_STAGE(bufoff, gbase, voff) do { _Pragma("unroll") for (int _i = 0; _i < 2; ++_i) \
        __builtin_amdgcn_global_load_lds((const unsigned*)((const char*)(gbase) + (voff)[_i]), (PG8_LAS unsigned*)(lds + (bufoff) + ldsw + _i * 8192), 16, 0, 0); } while (0)
#define PG8_LDA(dst, b, h) do { _Pragma("unroll") for (int m = 0; m < 4; ++m) _Pragma("unroll") for (int k = 0; k < 2; ++k) dst[m][k] = *(const PG8_LAS bf16x8*)(lds + PG8_SA(b, h) + aoff + m * 2048 + k * 1024); } while (0)
#define PG8_LDB(dst, b, h) do { _Pragma("unroll") for (int n = 0; n < 2; ++n) _Pragma("unroll") for (int k = 0; k < 2; ++k) dst[n][k] = *(const PG8_LAS bf16x8*)(lds + PG8_SB(b, h) + boff + n * 2048 + k * 1024); } while (0)
#define PG8_MMA(ai, bj, At, Bt) do { __builtin_amdgcn_s_setprio(1); _Pragma("unroll") for (int m = 0; m < 4; ++m) _Pragma("unroll") for (int n = 0; n < 2; ++n) _Pragma("unroll") for (int k = 0; k < 2; ++k) \
        acc[ai][bj][m][n] = __builtin_amdgcn_mfma_f32_16x16x32_bf16(Bt[n][k], At[m][k], acc[ai][bj][m][n], 0, 0, 0); __builtin_amdgcn_s_setprio(0); } while (0)
#define PG8_WAIT_V(n) asm volatile("s_waitcnt vmcnt(" #n ")" ::: "memory")
#define PG8_WAIT_L(n) asm volatile("s_waitcnt lgkmcnt(" #n ")" ::: "memory")
#define PG8_BAR __builtin_amdgcn_s_barrier()
#define PG8_SCHED __builtin_amdgcn_sched_barrier(0)
    Unit cur, nxt; int ui = 0;
    if (!S.next(0, cur)) return;
    float pre[2][4] = {{0.f, 0.f, 0.f, 0.f}, {0.f, 0.f, 0.f, 0.f}};
    f32x4 acc[2][2][4][2];
#pragma unroll
    for (int a = 0; a < 2; ++a)
#pragma unroll
        for (int b = 0; b < 2; ++b)
#pragma unroll
            for (int m = 0; m < 4; ++m)
#pragma unroll
                for (int n = 0; n < 2; ++n) acc[a][b][m][n] = (f32x4){0.f, 0.f, 0.f, 0.f};
    bf16x8 At[4][2], B0[2][2], B1[2][2];
    const char* cA = (const char*)g.A + (size_t)cur.pm * tstepA + (size_t)cur.pn * g.apn; const char* cB = (const char*)g.Bt + (size_t)cur.pn * tstepB;
    S.a_ready(cur);
    if constexpr (SP2) {
        PG8_STAGE(PG8_SB(0, 0), cB, voffB); PG8_STAGE(PG8_SB(0, 1), cB + hstepB, voffB); PG8_STAGE(PG8_SA(0, 0), cA, voffA); PG8_STAGE(PG8_SA(0, 1), cA + hstepA, voffA);
        if (wr == 1) PG8_BAR;
        PG8_WAIT_V(2); PG8_BAR;
        PG8_STAGE(PG8_SB(1, 0), cB + kstep, voffB); PG8_STAGE(PG8_SA(1, 0), cA + kstep, voffA); PG8_STAGE(PG8_SB(1, 1), cB + hstepB + kstep, voffB);
        PG8_WAIT_V(6); PG8_BAR;
    } else {
        PG8_STAGE(PG8_SB(0, 0), cB, voffB); PG8_STAGE(PG8_SA(0, 0), cA, voffA); PG8_STAGE(PG8_SB(0, 1), cB + hstepB, voffB); PG8_STAGE(PG8_SA(0, 1), cA + hstepA, voffA);
        if (wr == 1) PG8_BAR;
        PG8_WAIT_V(4); PG8_BAR;
        PG8_STAGE(PG8_SB(1, 0), cB + kstep, voffB); PG8_STAGE(PG8_SA(1, 0), cA + kstep, voffA); PG8_STAGE(PG8_SB(1, 1), cB + hstepB + kstep, voffB);
        PG8_WAIT_V(6); PG8_BAR;
    }
    for (;;) {
        const bool has_next = S.next(ui + 1, nxt);
        const char* nA = has_next ? (const char*)g.A + (size_t)nxt.pm * tstepA + (size_t)nxt.pn * g.apn : cA; const char* nB = has_next ? (const char*)g.Bt + (size_t)nxt.pn * tstepB : cB;
        for (int t = 0; t < nt; t += 2) {
            const bool last = (t == nt - 2);
            const char* a1 = cA + (size_t)(t + 1) * kstep;
            const char* a2 = last ? nA : cA + (size_t)(t + 2) * kstep; const char* b2 = last ? nB : cB + (size_t)(t + 2) * kstep;
            const char* a3 = a2 + kstep; const char* b3 = b2 + kstep;
            if (last && has_next) S.a_ready(nxt);
            if constexpr (Epi::HAS_PRE) { if (last) E.prefetch(cur, pre, wr, fr); }
            if constexpr (SP2) {
            PG8_LDB(B0, 0, 0); PG8_LDB(B1, 0, 1); PG8_SCHED; PG8_LDA(At, 0, 0); PG8_STAGE(PG8_SA(1, 1), a1 + hstepA, voffA);
            PG8_WAIT_V(8); PG8_WAIT_L(0); PG8_BAR; PG8_MMA(0, 0, At, B0); PG8_MMA(0, 1, At, B1); PG8_BAR; PG8_SCHED;
            PG8_LDA(At, 0, 1); PG8_STAGE(PG8_SB(0, 0), b2, voffB); PG8_STAGE(PG8_SB(0, 1), b2 + hstepB, voffB); PG8_STAGE(PG8_SA(0, 0), a2, voffA);
            PG8_WAIT_V(8); PG8_WAIT_L(0); PG8_BAR; PG8_MMA(1, 0, At, B0); PG8_MMA(1, 1, At, B1); PG8_BAR; PG8_SCHED;
            PG8_LDB(B0, 1, 0); PG8_LDB(B1, 1, 1); PG8_SCHED; PG8_LDA(At, 1, 0); PG8_STAGE(PG8_SA(0, 1), a2 + hstepA, voffA);
            PG8_WAIT_V(8); PG8_WAIT_L(0); PG8_BAR; PG8_MMA(0, 0, At, B0); PG8_MMA(0, 1, At, B1); PG8_BAR; PG8_SCHED;
            PG8_LDA(At, 1, 1); PG8_STAGE(PG8_SB(1, 0), b3, voffB); PG8_STAGE(PG8_SB(1, 1), b3 + hstepB, voffB); PG8_STAGE(PG8_SA(1, 0), a3, voffA);
            PG8_WAIT_V(8); PG8_WAIT_L(0); PG8_BAR; PG8_MMA(1, 0, At, B0); PG8_MMA(1, 1, At, B1); PG8_BAR; PG8_SCHED;
            } else {
            PG8_LDB(B0, 0, 0); PG8_SCHED; PG8_LDA(At, 0, 0); PG8_STAGE(PG8_SA(1, 1), a1 + hstepA, voffA);
            PG8_WAIT_L(8); PG8_BAR; PG8_WAIT_L(0); PG8_MMA(0, 0, At, B0); PG8_BAR; PG8_SCHED;
            PG8_LDB(B1, 0, 1); PG8_STAGE(PG8_SB(0, 0), b2, voffB);
            PG8_BAR; PG8_WAIT_L(0); PG8_MMA(0, 1, At, B1); PG8_BAR;
            PG8_LDA(At, 0, 1); PG8_STAGE(PG8_SA(0, 0), a2, voffA);
            PG8_BAR; PG8_WAIT_L(0); PG8_MMA(1, 0, At, B0); PG8_BAR; PG8_SCHED;
            PG8_STAGE(PG8_SB(0, 1), b2 + hstepB, voffB);
            PG8_WAIT_V(6); PG8_BAR; PG8_MMA(1, 1, At, B1); PG8_BAR;
            PG8_LDB(B0, 1, 0); PG8_SCHED; PG8_LDA(At, 1, 0); PG8_STAGE(PG8_SA(0, 1), a2 + hstepA, voffA);
            PG8_WAIT_L(8); PG8_BAR; PG8_WAIT_L(0); PG8_MMA(0, 0, At, B0); PG8_BAR; PG8_SCHED;
            PG8_LDB(B1, 1, 1); PG8_STAGE(PG8_SB(1, 0), b3, voffB);
            PG8_BAR; PG8_WAIT_L(0); PG8_MMA(0, 1, At, B1); PG8_BAR;
            PG8_LDA(At, 1, 1); PG8_STAGE(PG8_SA(1, 0), a3, voffA);
            PG8_BAR; PG8_WAIT_L(0); PG8_MMA(1, 0, At, B0); PG8_BAR; PG8_SCHED;
            PG8_STAGE(PG8_SB(1, 1), b3 + hstepB, voffB);
            PG8_WAIT_V(6); PG8_BAR; PG8_MMA(1, 1, At, B1); PG8_BAR;
            }
        }
        if constexpr (ALIGN_EPI) { if (wr == 0) PG8_BAR; }
        if constexpr (!Epi::AFTER_DRAIN) { E(acc, cur, wr, wc, fr, fq, pre); S.done(cur); }
        if (!has_next) break;
#pragma unroll
        for (int a = 0; a < 2; ++a)
#pragma unroll
            for (int b = 0; b < 2; ++b)
#pragma unroll
                for (int m = 0; m < 4; ++m)
#pragma unroll
                    for (int n = 0; n < 2; ++n) acc[a][b][m][n] = (f32x4){0.f, 0.f, 0.f, 0.f};
        cur = nxt; cA = nA; cB = nB; ++ui;
        if constexpr (ALIGN_EPI) { if (wr == 1) PG8_BAR; }
    }
    PG8_WAIT_V(0);
    if constexpr (!ALIGN_EPI) { if (wr == 0) PG8_BAR; }
    PG8_BAR;
    if constexpr (Epi::AFTER_DRAIN) { E.fused(acc, cur, wr, wc, fr, fq, lds, wid, lane); S.done(cur); }
#undef PG8_SA
#undef PG8_SB
#undef PG8_STAGE
#undef PG8_LDA
#undef PG8_LDB
#undef PG8_MMA
#undef PG8_WAIT_V
#undef PG8_WAIT_L
#undef PG8_BAR
#undef PG8_SCHED
}
}

namespace attn {
constexpr int D = 128;
constexpr float THR = 8.f;
constexpr bool WSKIP = false;
constexpr float SCALE = 0.08838834764831845f;
constexpr int NW = 8, QBLK = 32, KVBLK = 64, QB = NW * QBLK;
constexpr int SHM_V = KVBLK * D * 2, SHM_K = KVBLK * D * 2;
constexpr int LDS_BYTES = 2 * SHM_V + 2 * SHM_K + NW * 64 * 4;
using bf16 = __hip_bfloat16;
typedef short bf16x8 __attribute__((ext_vector_type(8)));
typedef short s16x4 __attribute__((ext_vector_type(4)));
typedef float f32x16 __attribute__((ext_vector_type(16)));
typedef float f32x4 __attribute__((ext_vector_type(4)));
typedef unsigned u32x4 __attribute__((ext_vector_type(4)));
template <class A, class Bt> struct same_t { static constexpr bool v = false; };
template <class A> struct same_t<A, A> { static constexpr bool v = true; };

#define KSWZ(row, colB) ((row) * 256 + ((colB) ^ (((row) & 7) << 4)))
#define SBAR() __builtin_amdgcn_sched_barrier(0)
__device__ __forceinline__ int v_st(int k, int c) { const int kk = (k & ~0xC) | ((k & 4) << 1) | ((k & 8) >> 1); return ((kk >> 3) * 4 + (c >> 5)) * 512 + ((kk & 7) * 32 + (c & 31)) * 2; }
__device__ __forceinline__ int v_rd_base(int lane) { return ((lane & 3) << 3) | (((lane >> 2) & 3) << 6) | (((lane >> 4) & 1) << 5) | (((lane >> 5) & 1) << 8); }
constexpr int v_rd_off(int d0, int ks, int half) { return d0 * 512 + ks * 4096 + half * 2048; }
__device__ __forceinline__ int crow(int r, int hi) { return (r & 3) + 8 * (r >> 2) + 4 * hi; }
__device__ __forceinline__ unsigned cvtpk(float lo, float hi) {
    unsigned r; asm volatile("v_cvt_pk_bf16_f32 %0, %1, %2" : "=v"(r) : "v"(lo), "v"(hi)); return r;
}
__device__ __forceinline__ bf16x8 pack8(f32x4 a, f32x4 b) {
    u32x4 w = {cvtpk(a[0], a[1]), cvtpk(a[2], a[3]), cvtpk(b[0], b[1]), cvtpk(b[2], b[3])};
    return *reinterpret_cast<bf16x8*>(&w);
}
template <class T> __device__ __forceinline__ bf16x8 load8(const T* p) {
    if constexpr (same_t<T, float>::v) { return pack8(*(const f32x4*)p, *(const f32x4*)(p + 4)); }
    else { return *reinterpret_cast<const bf16x8*>(p); }
}
__device__ __forceinline__ void mask_tile(f32x16& p0, f32x16& p1, int dq, unsigned W) {
    const float NEG = -__builtin_inff();
#pragma unroll
    for (int r = 0; r < 16; ++r) {
        const int c = (r & 3) + 8 * (r >> 2);
        if ((unsigned)(dq - c) >= W) p0[r] = NEG;
        if ((unsigned)(dq - c - 32) >= W) p1[r] = NEG;
    }
}
__device__ __forceinline__ void partialSM(f32x16& p0, f32x16& p1, float& m_reg, float& mn, float& alpha) {
    float pmax = p0[0]; for (int r = 1; r < 16; ++r) pmax = fmaxf(pmax, p0[r]); for (int r = 0; r < 16; ++r) pmax = fmaxf(pmax, p1[r]);
    { auto rr = __builtin_amdgcn_permlane32_swap(__float_as_uint(pmax), __float_as_uint(pmax), false, false);
      pmax = fmaxf(__uint_as_float(rr[0]), __uint_as_float(rr[1])); }
    constexpr float C2 = 1.4426950408889634f * SCALE;
    if (__builtin_expect(__all((pmax - m_reg) * SCALE <= THR), 1)) { mn = m_reg; alpha = 1.f; }
    else { mn = fmaxf(m_reg, pmax); alpha = __builtin_amdgcn_exp2f((m_reg - mn) * C2); m_reg = mn; }
    const float mnL = -mn * C2;
    for (int r = 0; r < 16; ++r) p0[r] = fmaf(p0[r], C2, mnL); for (int r = 0; r < 16; ++r) p1[r] = fmaf(p1[r], C2, mnL);
    for (int r = 0; r < 16; ++r) p0[r] = __builtin_amdgcn_exp2f(p0[r]);
}
__device__ __forceinline__ void finishSM(f32x16& p0, f32x16& p1, float alpha, float& l_reg, bf16x8& pa0, bf16x8& pa1, bf16x8& pa2, bf16x8& pa3) {
    for (int r = 0; r < 16; ++r) p1[r] = __builtin_amdgcn_exp2f(p1[r]);
    float ps = 0; for (int r = 0; r < 16; ++r) ps += p0[r]; for (int r = 0; r < 16; ++r) ps += p1[r];
    { auto rr = __builtin_amdgcn_permlane32_swap(__float_as_uint(ps), __float_as_uint(ps), false, false);
      ps = __uint_as_float(rr[0]) + __uint_as_float(rr[1]); }
    l_reg = l_reg * alpha + ps;
#define PK4(P, B_, OUT) do { unsigned a0 = cvtpk(P[B_+0], P[B_+1]), a1 = cvtpk(P[B_+2], P[B_+3]);                          \
        unsigned b0 = cvtpk(P[B_+4], P[B_+5]), b1 = cvtpk(P[B_+6], P[B_+7]);                                             \
        auto r0 = __builtin_amdgcn_permlane32_swap(a0, b0, false, false); auto r1 = __builtin_amdgcn_permlane32_swap(a1, b1, false, false); \
        u32x4 w = {r0[0], r1[0], r0[1], r1[1]}; OUT = *reinterpret_cast<bf16x8*>(&w); } while (0)
    PK4(p0, 0, pa0); PK4(p0, 8, pa1); PK4(p1, 0, pa2); PK4(p1, 8, pa3);
#undef PK4
}
template <int KB, bool SK>
__device__ __forceinline__ void qkt(f32x16& p0, f32x16& p1, const char* K_lds, int r32, int hi, const bf16x8* qr, bool act) {
    if (SK && !act) { const float NEG = -__builtin_inff();
#pragma unroll
        for (int r = 0; r < 16; ++r) { p0[r] = NEG; p1[r] = NEG; } return; }
    p0 = f32x16{}; p1 = f32x16{};
    const char* kb[4];
#pragma unroll
    for (int dd = 0; dd < 4; ++dd) kb[dd] = K_lds + KB * SHM_K + KSWZ(r32, (dd * 16 + hi * 8) * 2);
#pragma unroll
    for (int d0 = 0; d0 < 8; ++d0) { const char* a = kb[d0 & 3] + (d0 >> 2) * 128;
        bf16x8 b0 = *reinterpret_cast<const bf16x8*>(a);
        bf16x8 b1 = *reinterpret_cast<const bf16x8*>(a + 32 * 256);
        p0 = __builtin_amdgcn_mfma_f32_32x32x16_bf16(b0, qr[d0], p0, 0, 0, 0);
        p1 = __builtin_amdgcn_mfma_f32_32x32x16_bf16(b1, qr[d0], p1, 0, 0, 0); }
}
template <int VB, bool SK>
__device__ __forceinline__ void pv_tile(f32x16* o, int vb0, bf16x8 pa0, bf16x8 pa1, bf16x8 pa2, bf16x8 pa3, bool act) {
    if (SK && !act) return;
#define TRRD(dst, off) asm volatile("ds_read_b64_tr_b16 %0, %1 offset:%2" : "=&v"(dst) : "v"(vb0), "i"(off) : "memory")
#define PV_D0(d0) do { s16x4 l0, l1, l2, l3, h0, h1, h2, h3; constexpr int b_ = VB * SHM_V + v_rd_off(d0, 0, 0);     \
        TRRD(l0, b_); TRRD(h0, b_ + 2048); TRRD(l1, b_ + 4096); TRRD(h1, b_ + 6144); TRRD(l2, b_ + 8192); TRRD(h2, b_ + 10240); TRRD(l3, b_ + 12288); TRRD(h3, b_ + 14336); \
        asm volatile("s_waitcnt lgkmcnt(0)" ::: "memory"); SBAR();                 \
        o[d0] = __builtin_amdgcn_mfma_f32_32x32x16_bf16(pa0, (bf16x8){l0[0], l0[1], l0[2], l0[3], h0[0], h0[1], h0[2], h0[3]}, o[d0], 0, 0, 0);   \
        o[d0] = __builtin_amdgcn_mfma_f32_32x32x16_bf16(pa1, (bf16x8){l1[0], l1[1], l1[2], l1[3], h1[0], h1[1], h1[2], h1[3]}, o[d0], 0, 0, 0);   \
        o[d0] = __builtin_amdgcn_mfma_f32_32x32x16_bf16(pa2, (bf16x8){l2[0], l2[1], l2[2], l2[3], h2[0], h2[1], h2[2], h2[3]}, o[d0], 0, 0, 0);   \
        o[d0] = __builtin_amdgcn_mfma_f32_32x32x16_bf16(pa3, (bf16x8){l3[0], l3[1], l3[2], l3[3], h3[0], h3[1], h3[2], h3[3]}, o[d0], 0, 0, 0); } while (0)
    PV_D0(0); PV_D0(1); PV_D0(2); PV_D0(3);
#undef PV_D0
#undef TRRD
}

template <class TIn, class TOut> struct BlockRef { const TIn* Q; const TIn* K; const TIn* V; TOut* O; int P0; };
template <class TIn> struct Seam {
    bf16x8 qr[8];
    bf16x8 st_v0, st_v1, st_k0, st_k1; f32x4 sf0, sf1, sf2, sf3;
    f32x4 tq[16];
};
__device__ __forceinline__ int swa_jlo(int P0, int W) { const int lowk = P0 - W + 1; return lowk > 0 ? lowk / KVBLK : 0; }
#define ROW(p, k0, rr) ((p) + (size_t)((k0) + (rr)) * D + sc)
#define VMW() asm volatile("s_waitcnt vmcnt(0)" ::: "memory")
#define VMWN(n) asm volatile("s_waitcnt vmcnt(%0)" :: "i"(n) : "memory")
#define SLOAD_H(Kp, Vp, k0) do { S.st_v0 = load8<TIn>(ROW(Vp, k0, sr)); S.st_v1 = load8<TIn>(ROW(Vp, k0, 32 + sr));              \
                         S.st_k0 = load8<TIn>(ROW(Kp, k0, sr)); S.st_k1 = load8<TIn>(ROW(Kp, k0, 32 + sr)); } while (0)
#define SWRITE_HK(bf) do { *(bf16x8*)(K_lds + (bf) * SHM_K + kws) = S.st_k0; *(bf16x8*)(K_lds + (bf) * SHM_K + kws + 32 * 256) = S.st_k1; } while (0)
#define SWRITE_HV(bf) do { *(bf16x8*)(V_lds + (bf) * SHM_V + vst0) = S.st_v0; *(bf16x8*)(V_lds + (bf) * SHM_V + vst1) = S.st_v1; } while (0)
#define SWRITE_H(bf) do { SWRITE_HV(bf); SWRITE_HK(bf); } while (0)
#define SLOAD_F(p, k0) do { S.sf0 = *(const f32x4*)ROW(p, k0, sr); S.sf1 = *(const f32x4*)(ROW(p, k0, sr) + 4);                \
                            S.sf2 = *(const f32x4*)ROW(p, k0, 32 + sr); S.sf3 = *(const f32x4*)(ROW(p, k0, 32 + sr) + 4); } while (0)
#define SWRITE_KF(bf) do { *(bf16x8*)(K_lds + (bf) * SHM_K + kws) = pack8(S.sf0, S.sf1); *(bf16x8*)(K_lds + (bf) * SHM_K + kws + 32 * 256) = pack8(S.sf2, S.sf3); } while (0)
#define SWRITE_VF(bf) do { *(bf16x8*)(V_lds + (bf) * SHM_V + vst0) = pack8(S.sf0, S.sf1); *(bf16x8*)(V_lds + (bf) * SHM_V + vst1) = pack8(S.sf2, S.sf3); } while (0)
template <class TIn, class TOut>
__device__ __forceinline__ void causal_swa_prime(const BlockRef<TIn, TOut>& cur, int W, char* lds, Seam<TIn>& S) {
    constexpr bool F32 = same_t<TIn, float>::v;
    const int tid = otid(), wid = __builtin_amdgcn_readfirstlane(tid >> 6), lane = tid & 63, r32 = lane & 31, hi = lane >> 5;
    const int sr = tid >> 4, sc = (tid & 15) * 8, kws = KSWZ(sr, sc * 2); char* K_lds = lds + 2 * SHM_V;
    const int kb0 = swa_jlo(cur.P0, W) * KVBLK;
    for (int d0 = 0; d0 < 8; ++d0) S.qr[d0] = load8<TIn>(cur.Q + (size_t)(wid * QBLK + r32) * D + d0 * 16 + hi * 8);
    if constexpr (F32) { SLOAD_F((const float*)cur.K, kb0); VMW(); SWRITE_KF(0); SBAR(); SLOAD_F((const float*)cur.V, kb0); }
    else { SLOAD_H(cur.K, cur.V, kb0); VMW(); SWRITE_HK(0); }
    __syncthreads();
}
template <class TIn, class TOut>
__device__ __forceinline__ void causal_swa_block(const BlockRef<TIn, TOut>& cur, const BlockRef<TIn, TOut>& nxt, int skv, int W, char* lds, Seam<TIn>& S) {
    constexpr bool F32 = same_t<TIn, float>::v;
    const int tid = otid(), wid = __builtin_amdgcn_readfirstlane(tid >> 6), lane = tid & 63, r32 = lane & 31, hi = lane >> 5;
    const int j_lo = swa_jlo(cur.P0, W);
    int j_hi = (cur.P0 + QB - 1) / KVBLK + 1; if (j_hi > skv / KVBLK) j_hi = skv / KVBLK;
    const int NT = j_hi - j_lo;
    const int kbn = swa_jlo(nxt.P0, W) * KVBLK;
    const int qlo = cur.P0 + wid * QBLK, qm = qlo + r32 - 4 * hi;
    char* V_lds = lds; char* K_lds = lds + 2 * SHM_V;
    float* ws = (float*)(lds + 2 * SHM_V + 2 * SHM_K) + wid * 64; float* li_l = ws, * al_l = ws + 32;
    float m_reg = -1e30f, l_reg = 0; f32x16 o[4] = {};
    const int sr = tid >> 4, sc = (tid & 15) * 8, vst0 = v_st(sr, sc), vst1 = v_st(32 + sr, sc), kws = KSWZ(sr, sc * 2);
    const int vb0 = (int)(uintptr_t)V_lds + v_rd_base(lane);
    const TIn* Kh = cur.K; const TIn* Vh = cur.V;
#define RESC(a) do { if (__any((a) < 1.f)) { if (hi == 0) al_l[r32] = (a); asm volatile("s_waitcnt lgkmcnt(0)" ::: "memory");              \
                     for (int d_ = 0; d_ < 4; ++d_) for (int r = 0; r < 16; ++r) o[d_][r] *= al_l[crow(r, hi)]; } } while (0)
#define KBASE(t) ((j_lo + (t)) * KVBLK)
#define ACT(t) (KBASE(t) <= qlo + QBLK - 1 && KBASE(t) + KVBLK - 1 >= qlo - W + 1)
#define MASKT(P0_, P1_, t) do { const int kb_ = KBASE(t); if ((!SK || ACT(t)) && (kb_ + KVBLK - 1 > qlo || kb_ <= qlo + QBLK - 1 - W)) mask_tile(P0_, P1_, qm - kb_, (unsigned)W); } while (0)
    constexpr int NQL = F32 ? 16 : 8;
    constexpr bool SK = WSKIP && !F32;
#define SEAM_K0() do { VMWN(NQL); if constexpr (F32) { SWRITE_KF(0); SBAR(); SLOAD_F((const float*)nxt.V, kbn); } else { SWRITE_HK(0); } SBAR(); } while (0)
    f32x16 pA0, pA1, pB0, pB1; float mnA, mnB, alA, alB; bf16x8 pa0, pa1, pa2, pa3;
    if constexpr (F32) { VMW(); SWRITE_VF(0); SBAR(); } else { SWRITE_HV(0); SBAR(); }
    if (NT > 1) { if constexpr (F32) SLOAD_F((const float*)Kh, KBASE(1)); else SLOAD_H(Kh, Vh, KBASE(1)); }
    SBAR(); qkt<0, SK>(pA0, pA1, K_lds, r32, hi, S.qr, ACT(0));
    if constexpr (F32) { if (NT > 1) { VMW(); SWRITE_KF(1); SBAR(); SLOAD_F((const float*)Vh, KBASE(1)); } }
    MASKT(pA0, pA1, 0); partialSM(pA0, pA1, m_reg, mnA, alA);
    if (NT > 1) { VMW(); if constexpr (F32) { SWRITE_VF(1); SBAR(); if (NT > 2) SLOAD_F((const float*)Kh, KBASE(2)); } else SWRITE_H(1); }
    __syncthreads();
#define HALF_STEP(PX0, PX1, mnX, alX, PY0, PY1, alY, t, KB, VB, SB) do {                                                      \
        SBAR(); qkt<KB, SK>(PX0, PX1, K_lds, r32, hi, S.qr, ACT(t));                                             \
        finishSM(PY0, PY1, alY, l_reg, pa0, pa1, pa2, pa3); SBAR();                                                           \
        if ((t) + 1 < NT) { if constexpr (F32) { VMW(); SWRITE_KF(SB); SBAR(); SLOAD_F((const float*)Vh, KBASE((t) + 1)); }  \
                            else { SLOAD_H(Kh, Vh, KBASE((t) + 1)); } SBAR(); }                                               \
        pv_tile<VB, SK>(o, vb0, pa0, pa1, pa2, pa3, ACT((t) - 1)); MASKT(PX0, PX1, (t)); partialSM(PX0, PX1, m_reg, mnX, alX);                                        \
        __syncthreads();                                                                                                      \
        if ((t) + 1 < NT) { VMW(); if constexpr (F32) { SWRITE_VF(SB); SBAR(); if ((t) + 2 < NT) SLOAD_F((const float*)Kh, KBASE((t) + 2)); } \
                            else { SWRITE_H(SB); } }                                                                          \
        RESC(alX); __syncthreads(); } while (0)
    for (int t = 1; t + 1 < NT; t += 2) {
        HALF_STEP(pB0, pB1, mnB, alB, pA0, pA1, alA, t, 1, 0, 0);
        HALF_STEP(pA0, pA1, mnA, alA, pB0, pB1, alB, t + 1, 0, 1, 1);
    }
    const bool even = (NT & 1) == 0;
    if (even) { SBAR(); qkt<1, SK>(pB0, pB1, K_lds, r32, hi, S.qr, ACT(NT - 1)); SBAR(); }
#define QROW(e) (nxt.Q + (size_t)(wid * QBLK + r32) * D + ((e) >> 1) * 16 + hi * 8 + ((e) & 1) * 4)
    if constexpr (F32) { SLOAD_F((const float*)nxt.K, kbn); SBAR();
#pragma unroll
        for (int e = 0; e < 8; ++e) S.tq[e] = *(const f32x4*)QROW(e); }
    else { SLOAD_H(nxt.K, nxt.V, kbn); SBAR();
#pragma unroll
        for (int d0 = 0; d0 < 8; ++d0) S.qr[d0] = load8<TIn>(nxt.Q + (size_t)(wid * QBLK + r32) * D + d0 * 16 + hi * 8); }
    SBAR();
    finishSM(pA0, pA1, alA, l_reg, pa0, pa1, pa2, pa3); SBAR();
    if constexpr (F32) {
#pragma unroll
        for (int e = 8; e < 16; ++e) S.tq[e] = *(const f32x4*)QROW(e); SBAR(); }
#undef QROW
    pv_tile<0, SK>(o, vb0, pa0, pa1, pa2, pa3, ACT(even ? NT - 2 : NT - 1));
    if (even) { MASKT(pB0, pB1, NT - 1); partialSM(pB0, pB1, m_reg, mnB, alB); __syncthreads(); RESC(alB);
        finishSM(pB0, pB1, alB, l_reg, pa0, pa1, pa2, pa3); SBAR(); pv_tile<1, SK>(o, vb0, pa0, pa1, pa2, pa3, ACT(NT - 1)); }
    SBAR(); SEAM_K0();
    if (hi == 0) li_l[r32] = l_reg; asm volatile("s_waitcnt lgkmcnt(0)" ::: "memory");
    float rli[16];
#pragma unroll
    for (int r = 0; r < 16; ++r) rli[r] = __builtin_amdgcn_rcpf(li_l[crow(r, hi)]);
    TOut* Ow = cur.O + (size_t)(wid * QBLK) * D;
#pragma unroll
    for (int r = 0; r < 16; ++r) { const int orow = crow(r, hi);
#pragma unroll
        for (int d0 = 0; d0 < 4; ++d0) { const float v = o[d0][r] * rli[r];
            if constexpr (same_t<TOut, float>::v) { Ow[(size_t)orow * D + d0 * 32 + r32] = v; }
            else { const float vn = __shfl_xor(v, 1);
                   if ((r32 & 1) == 0) *(unsigned*)(Ow + (size_t)orow * D + d0 * 32 + r32) = cvtpk(v, vn); } } }
    if constexpr (F32) {
#pragma unroll
        for (int d0 = 0; d0 < 8; ++d0) S.qr[d0] = pack8(S.tq[2 * d0], S.tq[2 * d0 + 1]); }
    __syncthreads();
#undef RESC
#undef KBASE
#undef ACT
#undef MASKT
#undef SEAM_K0
#undef HALF_STEP
}
#undef ROW
#undef VMW
#undef VMWN
#undef SLOAD_H
#undef SWRITE_HK
#undef SWRITE_HV
#undef SWRITE_H
#undef SLOAD_F
#undef SWRITE_KF
#undef SWRITE_VF

}

typedef unsigned short bf16_t;
typedef float f32x4 __attribute__((ext_vector_type(4)));
typedef float f32x16 __attribute__((ext_vector_type(16)));
typedef short bf16x8 __attribute__((ext_vector_type(8)));
typedef unsigned u32x4 __attribute__((ext_vector_type(4)));
typedef unsigned u32x2 __attribute__((ext_vector_type(2)));

constexpr int SEQ = 4096, MTOK = 8192, DM = 2048, DFF = 5632, PLED = 256;
constexpr size_t MiB = 1u << 20;
constexpr size_t WS_CTL = 0, WS_ROPE = 1, WS_WGU1 = 2, WS_WD1 = 46, WS_WGU2 = 68, WS_WD2 = 112, WS_WPG = 134, WS_WPE = 142, WS_WPOOL = 143,
                 WS_WMIXIN = 144, WS_WMIXOUT = 176, WS_PB = 184, WS_H = 192, WS_PE = 224, WS_GU = 288,
                 WS_U = 376, WS_QH = 408, WS_KH = 424, WS_VH = 440, WS_OH = 456, WS_DP = 488, WS_CC = 504,
                 WS_OHG = 288, WS_DEC = 320, WS_LF = 376, WS_QS = 440, WS_KB = 472, WS_VB = 504, WS_GS = 536, WS_LT = 568, WS_END = 696;
constexpr int CTL_LAM = 0, CTL_LBS = 1024;
constexpr int LDS_BYTES = 131072 + 64;
constexpr size_t CTL_BAR_BYTE = 65536, CTL_BAR_BYTES = 16384, CTL_ZERO_BYTES = 65536 + 9 * 65536;
constexpr int NPH = 22;
constexpr size_t CTL_SS_BYTE = 131072;

__device__ __forceinline__ float wave_sum(float v) {
#pragma unroll
    for (int o = 1; o < 64; o <<= 1) v += __shfl_xor(v, o);
    return v;
}
__device__ __forceinline__ unsigned pk2(float lo, float hi) { return pg8::cvt_pk_bf16(lo, hi); }
__device__ __forceinline__ bf16_t f2bf(float v) { return (bf16_t)(pg8::cvt_pk_bf16(v, 0.f) & 0xffffu); }
__device__ __forceinline__ float bflo(unsigned w) { return __uint_as_float(w << 16); }
__device__ __forceinline__ float bfhi(unsigned w) { return __uint_as_float(w & 0xffff0000u); }
#define LDS_WAIT() asm volatile("s_waitcnt lgkmcnt(0)" ::: "memory")

struct ConvJob { const float* W; const float* ksc; bf16_t* dst; int K, N, ldd, mode, start, pad; };
__device__ __forceinline__ int conv_find(const ConvJob* tab, int g) { int j = 0;
#pragma nounroll
    while (j < 13 && g >= tab[j + 1].start) ++j;
    return j; }
__device__ __forceinline__ void conv_load(const ConvJob* tab, int g, f32x4 (&v)[8], int lane) {
    const ConvJob jb = tab[conv_find(tab, g)];
    const int it = g - jb.start, nq4 = jb.N >> 8, q = it >> 3, w = it & 7, kq = q / nq4, nq = q - kq * nq4, kb = 2 * kq + (w >> 2), nb = 4 * nq + (w & 3);
    const float* wp = jb.W + (size_t)((kb << 5) + (lane >> 4)) * jb.N + (nb << 6) + (lane & 15) * 4;
#pragma unroll
    for (int r = 0; r < 8; ++r) v[r] = __builtin_nontemporal_load((const f32x4*)(wp + (size_t)(4 * r) * jb.N));
}
__device__ __forceinline__ void conv_proc(const ConvJob* tab, int g, const f32x4 (&v)[8], float* scr, int lane) {
    const ConvJob jb = tab[conv_find(tab, g)];
    const int it = g - jb.start, nq4 = jb.N >> 8, q = it >> 3, w = it & 7, kq = q / nq4, nq = q - kq * nq4, kb = 2 * kq + (w >> 2), nb = 4 * nq + (w & 3), k0 = kb << 5, n0 = nb << 6;
    const int drow0 = jb.mode == 0 ? n0 : (((n0 >> 7) << 8) + (n0 & 127) + (jb.mode == 2 ? 128 : 0));
#pragma unroll
    for (int r = 0; r < 8; ++r) *(f32x4*)(scr + (4 * r + (lane >> 4)) * 68 + (lane & 15) * 4) = v[r];
    LDS_WAIT();
    bf16_t* dp = jb.dst + (size_t)(drow0 + lane) * jb.ldd + k0;
#pragma unroll
    for (int c = 0; c < 4; ++c) { const float* s = scr + (8 * c) * 68 + lane;
        f32x4 ka = {1.f, 1.f, 1.f, 1.f}, kb2 = ka; if (jb.ksc) { ka = *(const f32x4*)(jb.ksc + k0 + 8 * c); kb2 = *(const f32x4*)(jb.ksc + k0 + 8 * c + 4); }
        u32x4 o; o.x = pk2(s[0 * 68] * ka[0], s[1 * 68] * ka[1]); o.y = pk2(s[2 * 68] * ka[2], s[3 * 68] * ka[3]); o.z = pk2(s[4 * 68] * kb2[0], s[5 * 68] * kb2[1]); o.w = pk2(s[6 * 68] * kb2[2], s[7 * 68] * kb2[3]);
        *(u32x4*)(dp + 8 * c) = o; }
    LDS_WAIT();
}

__device__ __forceinline__ void prep_rows(const float* __restrict__ src, bf16_t* __restrict__ xb, unsigned long long* __restrict__ ss0, int gw, int NGW, int lane) {
    for (int m = gw; m < MTOK; m += NGW) {
        const f32x4* xr = (const f32x4*)(src + (size_t)m * DM) + lane;
        f32x4 v[8]; float s = 0.f;
#pragma unroll
        for (int j = 0; j < 8; ++j) { v[j] = xr[64 * j]; s += (v[j].x * v[j].x + v[j].y * v[j].y) + (v[j].z * v[j].z + v[j].w * v[j].w); }
        s = wave_sum(s);
        if (lane == 0) ss0[m] = (unsigned long long)(s * 1048576.f + 0.5f);
#pragma unroll
        for (int j = 0; j < 8; ++j) { u32x2 w; w.x = pk2(v[j].x, v[j].y); w.y = pk2(v[j].z, v[j].w); ((u32x2*)(xb + (size_t)m * DM))[lane + 64 * j] = w; }
    }
}
__device__ __forceinline__ void final_rows(float* x, const float* __restrict__ gain, const unsigned long long* ss, int gw, int NGW, int lane) {
    for (int m = gw; m < MTOK; m += NGW) {
        const float rstd = rsqrtf((float)ss[m] * (1.f / 1048576.f) * (1.f / DM) + 1e-6f);
        f32x4* xr = (f32x4*)(x + (size_t)m * DM) + lane;
#pragma unroll
        for (int j = 0; j < 8; ++j) { const f32x4 g = ((const f32x4*)gain)[lane + 64 * j]; xr[64 * j] = xr[64 * j] * rstd * g; }
    }
}

template <int W> __device__ __forceinline__ void pool_unit(const float* __restrict__ up, bf16_t* __restrict__ dp, int s0) {
    f32x4 v[16 + W];
#pragma unroll
    for (int j = 0; j < 16 + W; ++j) { const int s = s0 - W + j; v[j] = (s >= 0) ? *(const f32x4*)(up + (ptrdiff_t)(j - W) * 1024) : (f32x4){0.f, 0.f, 0.f, 0.f}; }
    f32x4 sum = {0.f, 0.f, 0.f, 0.f};
#pragma unroll
    for (int j = 0; j < W; ++j) sum += v[j];
#pragma unroll
    for (int i = 0; i < 16; ++i) {
        const int s = s0 + i; const f32x4 cur = v[W + i];
        sum += cur; sum -= v[i];
        const float inv = 1.f / (float)((s + 1) < W ? (s + 1) : W);
        const f32x4 d = sum * inv - cur;
        u32x2 o; o.x = pk2(d.x, d.y); o.y = pk2(d.z, d.w);
        *(u32x2*)(dp + (size_t)i * 1024) = o;
    }
}
__device__ __forceinline__ void pool_diff(const float* __restrict__ U, bf16_t* __restrict__ Dp, int blk, int nblk, int tid) {
    const int half = tid >> 8, c4 = tid & 255, g = __builtin_amdgcn_readfirstlane(c4 >> 6);
    for (int un = blk * 2 + half; un < MTOK / 16; un += nblk * 2) {
        const int row0 = un * 16, s0 = row0 & (SEQ - 1);
        const float* up = U + (size_t)row0 * 1024 + c4 * 4; bf16_t* dp = Dp + (size_t)row0 * 1024 + c4 * 4;
        if (g == 0) pool_unit<2>(up, dp, s0); else if (g == 1) pool_unit<4>(up, dp, s0); else if (g == 2) pool_unit<8>(up, dp, s0); else pool_unit<16>(up, dp, s0);
    }
}

__device__ __forceinline__ void attn_combine(const bf16_t* __restrict__ Oh, const float* __restrict__ subln, const float* lamp, bf16_t* __restrict__ CC, int gw, int NGW, int lane) {
    const float lam = *lamp;
    const int vh = lane >> 5, e = (lane & 31) * 4;
    const f32x4 g = *(const f32x4*)(subln + vh * 128 + e);
#pragma unroll 4
    for (int it = gw; it < MTOK * 4; it += NGW) {
        const int row = it >> 2, h = it & 3, b = row >> 12, s = row & (SEQ - 1);
        const size_t base0 = ((size_t)((((b * 4 + h) * 2 + 0) * 2 + vh) * SEQ + s)) * 128 + e;
        const size_t base1 = ((size_t)((((b * 4 + h) * 2 + 1) * 2 + vh) * SEQ + s)) * 128 + e;
        const u32x2 a = *(const u32x2*)(Oh + base0), c = *(const u32x2*)(Oh + base1);
        f32x4 o; o.x = bflo(a.x) - lam * bflo(c.x); o.y = bfhi(a.x) - lam * bfhi(c.x); o.z = bflo(a.y) - lam * bflo(c.y); o.w = bfhi(a.y) - lam * bfhi(c.y);
        const float ss = wave_sum((o.x * o.x + o.y * o.y) + (o.z * o.z + o.w * o.w));
        const float rstd = rsqrtf(ss * (1.f / 256.f) + 1e-5f) * 0.8f;
        o = o * rstd * g;
        u32x2 w; w.x = pk2(o.x, o.y); w.y = pk2(o.z, o.w);
        *(u32x2*)(CC + (size_t)row * DM + 1024 + h * 256 + vh * 128 + e) = w;
    }
}

__device__ __forceinline__ int tsw_wr(int d, int t) { return d * 72 + (t ^ (((d >> 3) & 7) << 3)); }
__device__ __forceinline__ int tsw_rd(int row, int c8) { return row * 72 + ((c8 ^ ((row >> 3) & 7)) << 3); }
__device__ __forceinline__ void lds_barrier() { asm volatile("s_waitcnt lgkmcnt(0)\n\ts_barrier" ::: "memory"); }
struct HgrnIn { f32x4 lf[4]; u32x4 a[2], b[2], c[2]; };
template <bool THREE> __device__ __forceinline__ void hgrn_load(HgrnIn& in, const float* __restrict__ LF, const bf16_t* __restrict__ A, const bf16_t* __restrict__ B, const bf16_t* __restrict__ C, int item, int tid) {
    const int bh = item >> 6, c = item & 63, b = bh >> 4, h = bh & 15, r0 = b * SEQ + c * 64, cb = h * 128;
#pragma unroll
    for (int r = 0; r < 4; ++r) { const int i = tid + 512 * r, t = i >> 5, c4 = i & 31; in.lf[r] = *(const f32x4*)(LF + (size_t)(r0 + t) * DM + cb + c4 * 4); }
#pragma unroll
    for (int r = 0; r < 2; ++r) { const int i = tid + 512 * r, t = i >> 4, d8 = (i & 15) * 8; const size_t go = (size_t)(r0 + t) * DM + cb + d8;
        in.a[r] = *(const u32x4*)(A + go); in.b[r] = *(const u32x4*)(B + go); if (THREE) in.c[r] = *(const u32x4*)(C + go); }
}
__device__ __forceinline__ void hgrn_prep(const HgrnIn& in, float* G, float* tot, int tid) {
#pragma unroll
    for (int r = 0; r < 4; ++r) { const int i = tid + 512 * r, t = i >> 5, c4 = i & 31; *(f32x4*)(G + t * 128 + c4 * 4) = in.lf[r]; }
    lds_barrier();
    const int col = tid & 127, q = tid >> 7; float* gp = G + (16 * q) * 128 + col;
    { float a = 0.f;
#pragma unroll
      for (int t = 0; t < 16; ++t) { a += gp[t * 128]; gp[t * 128] = a; }
      tot[q * 128 + col] = a; }
    lds_barrier();
    { float off = 0.f;
#pragma unroll
      for (int qq = 0; qq < 3; ++qq) off += (qq < q) ? tot[qq * 128 + col] : 0.f;
#pragma unroll
      for (int t = 0; t < 16; ++t) gp[t * 128] += off; }
    lds_barrier();
}
__device__ __forceinline__ void hgrn_passA(unsigned char* lds, const float* __restrict__ LF, const bf16_t* __restrict__ Kb, const bf16_t* __restrict__ Vb,
                                           bf16_t* __restrict__ LT, float* __restrict__ DEC, int blk, int nblk, int tid, int wave, int lane) {
    float* G = (float*)lds; bf16_t* khT = (bf16_t*)(lds + 32768); bf16_t* vT = (bf16_t*)(lds + 32768 + 18432);
    HgrnIn in;
    { int b0 = blk; asm volatile("" : "+s"(b0)); if (b0 < 2048) hgrn_load<false>(in, LF, Kb, Vb, Vb, b0, tid); }
    for (int item = blk; item < 2048; item += nblk) {
        hgrn_prep(in, G, (float*)(lds + 69632), tid);
        if (tid < 128) DEC[item * 128 + tid] = __expf(G[63 * 128 + tid]);
#pragma unroll
        for (int r = 0; r < 2; ++r) { const int i = tid + 512 * r, t = i >> 4, d8 = (i & 15) * 8;
            const u32x4 kk = in.a[r], vv = in.b[r];
#pragma unroll
            for (int j = 0; j < 4; ++j) { const unsigned kw = kk[j], vw = vv[j]; const int d = d8 + 2 * j;
                const float k0 = bflo(kw) * __expf(G[63 * 128 + d] - G[t * 128 + d]), k1 = bfhi(kw) * __expf(G[63 * 128 + d + 1] - G[t * 128 + d + 1]);
                khT[tsw_wr(d, t)] = f2bf(k0); khT[tsw_wr(d + 1, t)] = f2bf(k1);
                vT[tsw_wr(d, t)] = (bf16_t)(vw & 0xffffu); vT[tsw_wr(d + 1, t)] = (bf16_t)(vw >> 16); } }
        if (item + nblk < 2048) hgrn_load<false>(in, LF, Kb, Vb, Vb, item + nblk, tid);
        lds_barrier();
        const int r = lane & 31, hq = lane >> 5, et = wave >> 1, dt0 = (wave & 1) * 2;
        f32x16 acc0 = {}, acc1 = {};
#pragma unroll
        for (int kk = 0; kk < 4; ++kk) {
            const bf16x8 av = *(const bf16x8*)(vT + tsw_rd(et * 32 + r, kk * 2 + hq));
            const bf16x8 b0 = *(const bf16x8*)(khT + tsw_rd(dt0 * 32 + r, kk * 2 + hq));
            const bf16x8 b1 = *(const bf16x8*)(khT + tsw_rd((dt0 + 1) * 32 + r, kk * 2 + hq));
            acc0 = __builtin_amdgcn_mfma_f32_32x32x16_bf16(av, b0, acc0, 0, 0, 0);
            acc1 = __builtin_amdgcn_mfma_f32_32x32x16_bf16(av, b1, acc1, 0, 0, 0); }
        bf16_t* Lp = LT + (size_t)item * 16384;
#pragma unroll
        for (int reg = 0; reg < 16; ++reg) { const int e = et * 32 + (reg & 3) + 8 * (reg >> 2) + 4 * hq;
            const float n0 = __shfl_xor(acc0[reg], 1), n1 = __shfl_xor(acc1[reg], 1);
            if ((r & 1) == 0) { *(unsigned*)(Lp + e * 128 + dt0 * 32 + r) = pk2(acc0[reg], n0); *(unsigned*)(Lp + e * 128 + (dt0 + 1) * 32 + r) = pk2(acc1[reg], n1); } }
        lds_barrier();
    }
}
__device__ __forceinline__ void hgrn_scan(bf16_t* LT, const float* __restrict__ DEC, int gtid, int nthreads) {
    for (int base = gtid; base < 32 * 8192; base += 2 * nthreads) {
        float S[2][2] = {{0.f, 0.f}, {0.f, 0.f}}; unsigned* p[2]; const float* dp[2];
#pragma unroll
        for (int u = 0; u < 2; ++u) { int idx = base + u * nthreads; if (idx >= 32 * 8192) idx = base; const int bh = idx >> 13, ed = (idx & 8191) * 2;
            p[u] = (unsigned*)(LT + (size_t)bh * 64 * 16384 + ed); dp[u] = DEC + bh * 64 * 128 + (ed & 127); }
#pragma nounroll
        for (int cb = 0; cb < 64; cb += 16) {
            unsigned L[16][2]; float d0[16][2], d1[16][2];
#pragma unroll
            for (int j = 0; j < 16; ++j)
#pragma unroll
                for (int u = 0; u < 2; ++u) { L[j][u] = p[u][(size_t)(cb + j) * 8192]; const float* q = dp[u] + (cb + j) * 128; d0[j][u] = q[0]; d1[j][u] = q[1]; }
#pragma unroll
            for (int j = 0; j < 16; ++j) { const size_t o = (size_t)(cb + j) * 8192;
                p[0][o] = pk2(S[0][0], S[0][1]); p[1][o] = pk2(S[1][0], S[1][1]);
#pragma unroll
                for (int u = 0; u < 2; ++u) { S[u][0] = d0[j][u] * S[u][0] + bflo(L[j][u]); S[u][1] = d1[j][u] * S[u][1] + bfhi(L[j][u]); } }
        }
    }
}
__device__ __forceinline__ void hgrn_passC(unsigned char* lds, const float* __restrict__ LF, const bf16_t* __restrict__ Qs, const bf16_t* __restrict__ Kb, const bf16_t* __restrict__ Vb,
                                           const bf16_t* __restrict__ Gs, const bf16_t* __restrict__ ST, const float* __restrict__ gain, bf16_t* __restrict__ OHG,
                                           int blk, int nblk, int tid, int wave, int lane) {
    float* G = (float*)lds; bf16_t* qt = (bf16_t*)(lds + 32768); bf16_t* kt = (bf16_t*)(lds + 50176); bf16_t* vT = (bf16_t*)(lds + 67584);
    bf16_t* Ab = (bf16_t*)(lds + 86016); float* osm = (float*)(lds + 95232);
    HgrnIn in;
    { int b0 = blk; asm volatile("" : "+s"(b0)); if (b0 < 2048) hgrn_load<true>(in, LF, Qs, Kb, Vb, b0, tid); }
    for (int item = blk; item < 2048; item += nblk) {
        const int bh = item >> 6, c = item & 63, b = bh >> 4, h = bh & 15, r0 = b * SEQ + c * 64, cb = h * 128;
        u32x4 sreg[8]; { const bf16_t* Sp0 = ST + (size_t)item * 16384 + (size_t)((wave & 3) * 32 + (lane & 31)) * 128 + (lane >> 5) * 8;
#pragma unroll
            for (int kk = 0; kk < 8; ++kk) sreg[kk] = *(const u32x4*)(Sp0 + kk * 16); }
        const size_t gog = (size_t)(r0 + (tid >> 3)) * DM + cb + (tid & 7) * 16;
        const u32x4 ga = *(const u32x4*)(Gs + gog), gb = *(const u32x4*)(Gs + gog + 8);
        hgrn_prep(in, G, (float*)(lds + 129024), tid);
#pragma unroll
        for (int rr = 0; rr < 2; ++rr) { const int i = tid + 512 * rr, t = i >> 4, d8 = (i & 15) * 8;
            const u32x4 qq = in.a[rr], kk = in.b[rr], vv = in.c[rr];
            u32x4 qo, ko;
#pragma unroll
            for (int j = 0; j < 4; ++j) { const int d = d8 + 2 * j; const float g0 = G[t * 128 + d], g1 = G[t * 128 + d + 1];
                qo[j] = pk2(bflo(qq[j]) * __expf(g0), bfhi(qq[j]) * __expf(g1));
                ko[j] = pk2(bflo(kk[j]) * __expf(-g0), bfhi(kk[j]) * __expf(-g1));
                vT[tsw_wr(d, t)] = (bf16_t)(vv[j] & 0xffffu); vT[tsw_wr(d + 1, t)] = (bf16_t)(vv[j] >> 16); }
            *(u32x4*)(qt + t * 136 + d8) = qo; *(u32x4*)(kt + t * 136 + d8) = ko; }
        if (item + nblk < 2048) hgrn_load<true>(in, LF, Qs, Kb, Vb, item + nblk, tid);
        lds_barrier();
        const int r = lane & 31, hq = lane >> 5;
        if (wave < 4) { const int tt = wave >> 1, st = wave & 1; f32x16 acc = {};
#pragma unroll
            for (int kk = 0; kk < 8; ++kk) {
                const bf16x8 av = *(const bf16x8*)(qt + (tt * 32 + r) * 136 + kk * 16 + hq * 8);
                const bf16x8 bv = *(const bf16x8*)(kt + (st * 32 + r) * 136 + kk * 16 + hq * 8);
                acc = __builtin_amdgcn_mfma_f32_32x32x16_bf16(av, bv, acc, 0, 0, 0); }
#pragma unroll
            for (int reg = 0; reg < 16; ++reg) { const int t = tt * 32 + (reg & 3) + 8 * (reg >> 2) + 4 * hq, s = st * 32 + r;
                Ab[t * 72 + s] = f2bf(s <= t ? acc[reg] : 0.f); } }
        lds_barrier();
        { const int tt = wave >> 2, et = wave & 3; f32x16 acc = {};
#pragma unroll
            for (int kk = 0; kk < 8; ++kk) {
                const bf16x8 av = *(const bf16x8*)(qt + (tt * 32 + r) * 136 + kk * 16 + hq * 8);
                const u32x4 bw = sreg[kk];
                acc = __builtin_amdgcn_mfma_f32_32x32x16_bf16(av, *(const bf16x8*)&bw, acc, 0, 0, 0); }
#pragma unroll
            for (int kk = 0; kk < 4; ++kk) {
                const bf16x8 av = *(const bf16x8*)(Ab + (tt * 32 + r) * 72 + kk * 16 + hq * 8);
                const bf16x8 bv = *(const bf16x8*)(vT + tsw_rd(et * 32 + r, kk * 2 + hq));
                acc = __builtin_amdgcn_mfma_f32_32x32x16_bf16(av, bv, acc, 0, 0, 0); }
#pragma unroll
            for (int reg = 0; reg < 16; ++reg) { const int t = tt * 32 + (reg & 3) + 8 * (reg >> 2) + 4 * hq; osm[t * 132 + et * 32 + r] = acc[reg]; } }
        lds_barrier();
        { const int row = tid >> 3, j = tid & 7; f32x4 o[4]; float ss = 0.f;
#pragma unroll
            for (int q = 0; q < 4; ++q) { o[q] = *(const f32x4*)(osm + row * 132 + j * 16 + q * 4); ss += (o[q].x * o[q].x + o[q].y * o[q].y) + (o[q].z * o[q].z + o[q].w * o[q].w); }
            ss += __shfl_xor(ss, 1); ss += __shfl_xor(ss, 2); ss += __shfl_xor(ss, 4);
            const float rstd = rsqrtf(ss * (1.f / 128.f) + 1e-6f);
            const size_t go = (size_t)(r0 + row) * DM + cb + j * 16;
            u32x4 wa, wb;
#pragma unroll
            for (int q = 0; q < 4; ++q) { const f32x4 gn = *(const f32x4*)(gain + j * 16 + q * 4); const f32x4 v = o[q] * rstd * gn;
                const unsigned g01 = q < 2 ? ga[2 * q] : gb[2 * (q - 2)], g23 = q < 2 ? ga[2 * q + 1] : gb[2 * (q - 2) + 1];
                const unsigned w0 = pk2(v.x * bflo(g01), v.y * bfhi(g01)), w1 = pk2(v.z * bflo(g23), v.w * bfhi(g23));
                if (q < 2) { wa[2 * q] = w0; wa[2 * q + 1] = w1; } else { wb[2 * (q - 2)] = w0; wb[2 * (q - 2) + 1] = w1; } }
            *(u32x4*)(OHG + go) = wa; *(u32x4*)(OHG + go + 8) = wb; }
        lds_barrier();
    }
}

typedef attn::BlockRef<attn::bf16, attn::bf16> ABR;
__device__ __forceinline__ ABR attn_ref(int L, int pass, const attn::bf16* Qh, const attn::bf16* Kh, const attn::bf16* Vh, attn::bf16* Oh) {
    const int qh = L >> 3, x = L & 7, qb = pass ? 15 - x : x, bhc = qh >> 1, bh = qh >> 2, vh = qh & 1;
    ABR r;
    r.Q = Qh + ((size_t)bhc * SEQ + (size_t)qb * 256) * 128; r.K = Kh + (size_t)bhc * SEQ * 128; r.V = Vh + (size_t)(bh * 2 + vh) * SEQ * 128;
    r.O = Oh + ((size_t)qh * SEQ + (size_t)qb * 256) * 128; r.P0 = qb * 256;
    return r;
}
__device__ __forceinline__ void attn_phase(char* lds, const attn::bf16* Qh, const attn::bf16* Kh, const attn::bf16* Vh, attn::bf16* Oh, int blk, int nblk) {
    constexpr int NITEMS = 256, W = 1 << 20;
    int L = (nblk == 256) ? ((blk & 7) * 32 + (blk >> 3)) : blk; if (L >= NITEMS) return;
    int pass = 0; ABR cur = attn_ref(L, 0, Qh, Kh, Vh, Oh);
    attn::Seam<attn::bf16> S;
    attn::causal_swa_prime<attn::bf16, attn::bf16>(cur, W, lds, S);
    for (;;) {
        const bool more_pass = pass == 0, more_item = L + nblk < NITEMS, last = !more_pass && !more_item;
        int passn = pass + 1, Ln = L;
        if (!more_pass) { passn = 0; Ln = more_item ? L + nblk : L; }
        const ABR nxt = last ? cur : attn_ref(Ln, passn, Qh, Kh, Vh, Oh);
        attn::causal_swa_block<attn::bf16, attn::bf16>(cur, nxt, SEQ, W, lds, S);
        if (last) break;
        cur = nxt; pass = passn; L = Ln;
    }
}

#define XB_TMO      128
#define XB_XCNT(j)  (256  + 64 * (j))
#define XB_XSUB(j)  (1280 + 64 * (j))
#define XB_XGEN(j)  (2304 + 64 * (j))
#define XB_TOP      3328
#define XB_TOPGEN   3392
#define XCD_BAR_WORDS 3456
#define XB_SPIN_CAP (1u << 18)

__device__ __forceinline__ unsigned xb_ld(unsigned* p)              { return __hip_atomic_load(p, __ATOMIC_RELAXED, __HIP_MEMORY_SCOPE_AGENT); }
__device__ __forceinline__ unsigned xb_add(unsigned* p, unsigned v) { return __hip_atomic_fetch_add(p, v, __ATOMIC_RELAXED, __HIP_MEMORY_SCOPE_AGENT); }
__device__ __forceinline__ unsigned xb_xcc_id() { return (unsigned)__builtin_amdgcn_s_getreg((3 << 11) | 20) & 0xFu; }
#define XB_SPIN(cond, bar) do { unsigned _sp = 0; while (cond) { __builtin_amdgcn_s_sleep(1); \
    if ((++_sp & 255u) == 0u) { if (xb_ld(&(bar)[XB_TMO])) break; if (_sp > XB_SPIN_CAP) { atomicAdd(&(bar)[XB_TMO], 1u); break; } } } } while (0)

struct XcdBarrier {
    unsigned* bar; unsigned x;
    volatile unsigned* st;
};

__device__ __forceinline__ XcdBarrier xcd_barrier_post(unsigned* bar, volatile unsigned* st) {
    XcdBarrier b; b.bar = bar; b.x = xb_xcc_id(); b.st = st;
    if (otid() == 0) (void)xb_add(&bar[XB_XCNT(b.x)], 1u);
    return b;
}
__device__ __forceinline__ void xcd_barrier_complete(unsigned* bar, unsigned x, unsigned& nloc, unsigned& nx) {
    const unsigned G = gridDim.x * gridDim.y * gridDim.z;
    unsigned sum, cnt, mine, sp = 0u;
    for (;;) {
        sum = 0u; cnt = 0u; mine = 0u;
#pragma unroll
        for (unsigned j = 0; j < 16; ++j) { const unsigned c = xb_ld(&bar[XB_XCNT(j)]); sum += c; cnt += (c > 0u) ? 1u : 0u; mine = (j == x) ? c : mine; }
        if (sum == G) break;
        __builtin_amdgcn_s_sleep(1);
        if ((++sp & 255u) == 0u) { if (xb_ld(&bar[XB_TMO])) break; if (sp > XB_SPIN_CAP) { atomicAdd(&bar[XB_TMO], 1u); break; } }
    }
    nloc = mine > 0u ? mine : 1u; nx = cnt > 0u ? cnt : 1u;
}

__device__ __forceinline__ void xcd_barrier(const XcdBarrier& b) {
    asm volatile("s_waitcnt vmcnt(0)" ::: "memory");
    __syncthreads();
    if (otid() == 0) {
        unsigned* bar = b.bar;
        __builtin_amdgcn_s_waitcnt(0);
        unsigned nloc = b.st[0], nx = b.st[1];
        if (nloc == 0u) { xcd_barrier_complete(bar, b.x, nloc, nx); b.st[0] = nloc; b.st[1] = nx; }
        const unsigned old = xb_add(&bar[XB_XSUB(b.x)], 1u);
        const unsigned gen = old / nloc;
        if (old + 1u == (gen + 1u) * nloc) {
            __builtin_amdgcn_fence(__ATOMIC_RELEASE, "agent");
            asm volatile("s_waitcnt vmcnt(0)" ::: "memory");
            const unsigned og = xb_add(&bar[XB_TOP], 1u);
            const unsigned tg = og / nx;
            if (og + 1u == (tg + 1u) * nx) xb_add(&bar[XB_TOPGEN], 1u);
            else XB_SPIN(xb_ld(&bar[XB_TOPGEN]) == tg, bar);
            __builtin_amdgcn_fence(__ATOMIC_ACQUIRE, "agent");
            xb_add(&bar[XB_XGEN(b.x)], 1u);
            asm volatile("s_waitcnt vmcnt(0)" ::: "memory");
        } else {
            XB_SPIN(xb_ld(&bar[XB_XGEN(b.x)]) == gen, bar);
            __builtin_amdgcn_fence(__ATOMIC_ACQUIRE, "agent");
            asm volatile("s_waitcnt vmcnt(0)" ::: "memory");
        }
    }
    __syncthreads();
}

__device__ __forceinline__ int opq(int i) { asm volatile("" : "+s"(i)); return i; }
#define inptr(i) (a.in[opq(i)])
struct Args { const void* in[26]; float* out; unsigned char* ws; int ph_lo, ph_hi; };

__device__ __forceinline__ void convert_layer(const Args& a, unsigned char* ws, int l, unsigned jobmask, unsigned char* lds, int tid, int wave, int gw, int NGW, int lane) {
    ConvJob* tab = (ConvJob*)(lds + 8 * 8704);
    if (tid == 0) { int start = 0;
#pragma nounroll
        for (int j = 0; j < 14; ++j) {
            const float* W = nullptr; const float* ksc = nullptr; int K = 0, N = 0, ldd = 0, mode = 0; bf16_t* dst = nullptr;
            switch (j) {
                case 0: W = (const float*)inptr(4) + (size_t)l * DM * DFF; K = DM; N = DFF; dst = (bf16_t*)(ws + WS_WGU1 * MiB); ldd = DM; mode = 1; ksc = (const float*)inptr(3) + l * DM; break;
                case 1: W = (const float*)inptr(5) + (size_t)l * DM * DFF; K = DM; N = DFF; dst = (bf16_t*)(ws + WS_WGU1 * MiB); ldd = DM; mode = 2; ksc = (const float*)inptr(3) + l * DM; break;
                case 2: W = (const float*)inptr(6) + (size_t)l * DM * DFF; K = DFF; N = DM; dst = (bf16_t*)(ws + WS_WD1 * MiB); ldd = DFF; break;
                case 3: W = (const float*)inptr(9) + (size_t)l * DM * DFF; K = DM; N = DFF; dst = (bf16_t*)(ws + WS_WGU2 * MiB); ldd = DM; mode = 1; ksc = (const float*)inptr(8) + l * DM; break;
                case 4: W = (const float*)inptr(10) + (size_t)l * DM * DFF; K = DM; N = DFF; dst = (bf16_t*)(ws + WS_WGU2 * MiB); ldd = DM; mode = 2; ksc = (const float*)inptr(8) + l * DM; break;
                case 5: W = (const float*)inptr(11) + (size_t)l * DM * DFF; K = DFF; N = DM; dst = (bf16_t*)(ws + WS_WD2 * MiB); ldd = DFF; break;
                case 6: W = (const float*)inptr(13) + (size_t)l * DM * DM; K = DM; N = DM; dst = (bf16_t*)(ws + WS_WPG * MiB); ldd = DM; ksc = (const float*)inptr(12) + l * DM; break;
                case 7: W = (const float*)inptr(14) + (size_t)l * PLED * DM; K = PLED; N = DM; dst = (bf16_t*)(ws + WS_WPE * MiB); ldd = PLED; break;
                case 8: if (l == 0) { W = (const float*)inptr(15); K = DM; N = 4096; } else { W = (const float*)inptr(21); K = DM; N = 8192; } dst = (bf16_t*)(ws + WS_WMIXIN * MiB); ldd = DM; ksc = (const float*)inptr(7) + l * DM; break;
                case 9: W = (const float*)(l == 0 ? inptr(20) : inptr(24)); K = DM; N = DM; dst = (bf16_t*)(ws + WS_WMIXOUT * MiB); ldd = DM; break;
                default: if (l == 0) { const int g = j - 10; W = (const float*)inptr(16) + (size_t)g * 65536; K = 256; N = 256; dst = (bf16_t*)(ws + WS_WPOOL * MiB) + (size_t)g * 65536; ldd = 256; } else { W = (const float*)inptr(16); K = 0; N = 64; dst = (bf16_t*)(ws + WS_WPOOL * MiB); ldd = 256; } break;
            }
            if (!((jobmask >> j) & 1u)) K = 0;
            ConvJob jb; jb.W = W; jb.ksc = ksc; jb.dst = dst; jb.K = K; jb.N = N; jb.ldd = ldd; jb.mode = mode; jb.start = start; jb.pad = 0;
            tab[j] = jb; start += (K >> 5) * (N >> 6);
        }
        tab[14].start = start;
    }
    __syncthreads();
    const int total = tab[14].start; float* scr = (float*)(lds + wave * 8704);
    f32x4 va[8], vb[8];
    int g0 = gw; if (g0 < total) conv_load(tab, g0, va, lane);
#pragma nounroll
    for (;;) {
        if (g0 >= total) break;
        const int g1 = g0 + NGW; if (g1 < total) conv_load(tab, g1, vb, lane);
        conv_proc(tab, g0, va, scr, lane);
        if (g1 >= total) break;
        g0 = g1 + NGW; if (g0 < total) conv_load(tab, g0, va, lane);
        conv_proc(tab, g1, vb, scr, lane);
    }
    __syncthreads();
}
#ifndef KMASK
#define KMASK 0xFFF
#endif
#define KON(k) if constexpr (((KMASK) >> (k)) & 1)
#define LOCAL_IDS const int tid = otid(), lane = tid & 63, wave = __builtin_amdgcn_readfirstlane(tid >> 6), gw = blk * 8 + wave; (void)gw; (void)lane
__global__ void __launch_bounds__(512, 2) mega_fwd(Args a) {
    extern __shared__ __attribute__((aligned(16))) unsigned char lds[];
    cg::grid_group grid = cg::this_grid();
    const int G = gridDim.x, blk = blockIdx.x, NGW = G * 8;
    volatile unsigned* bst = (volatile unsigned*)(lds + 131072);
    if (otid() < 2) bst[otid()] = 0u;
    __syncthreads();
    XcdBarrier xbar = xcd_barrier_post((unsigned*)(a.ws + CTL_BAR_BYTE), bst);
    for (int ph = a.ph_lo; ph < a.ph_hi; ++ph) {
        size_t zoff = 0; asm volatile("" : "+s"(zoff));
        unsigned char* ws = a.ws + zoff; float* out = a.out + zoff;
        float* ctl = (float*)(ws + WS_CTL * MiB);
        float* rope = (float*)(ws + WS_ROPE * MiB);
        bf16_t* Hb = (bf16_t*)(ws + WS_H * MiB);
        bf16_t* GU = (bf16_t*)(ws + WS_GU * MiB);
        bf16_t* PE = (bf16_t*)(ws + WS_PE * MiB);
        bf16_t* PB = (bf16_t*)(ws + WS_PB * MiB);
        int kind = 0, l = 0, sub = 0;
        if (ph > 0) { l = ph >= 11 ? 1 : 0; const int r = ph - (l ? 11 : 1);
            const unsigned long long kk = l ? 0x37212BA9821ULL : 0x3721265421ULL, ss = l ? 0x40112000000ULL : 0x3011200000ULL;
            kind = (int)((kk >> (4 * r)) & 15ULL); sub = (int)((ss >> (4 * r)) & 15ULL); }
        unsigned long long* SS = (unsigned long long*)(ws + CTL_SS_BYTE);
#ifdef DUPMASK
        const int nrep = (((DUPMASK) >> kind) & 1) && kind != 2 && kind != 7 && kind != 10 && !(kind == 3 && sub == 4) ? 2 : 1;
#else
        const int nrep = 1;
#endif
        for (int rep = 0; rep < nrep; ++rep)
        switch (kind) {
        case 0: KON(0) {
            LOCAL_IDS;
            convert_layer(a, ws, 0, G == 256 ? 0x3FDBu : 0x3FFFu, lds, tid, wave, gw, NGW, lane);
            for (int i = blk * 512 + tid; i < 8 * 8192; i += G * 512) SS[8192 + i] = 0ull;
            { const f32x4* __restrict__ p4 = (const f32x4*)inptr(1); u32x2* __restrict__ o = (u32x2*)PB; const int n4 = 2 * MTOK * PLED / 4;
#pragma unroll 4
              for (int i = blk * 512 + tid; i < n4; i += G * 512) { const f32x4 v = p4[i]; u32x2 w; w.x = pk2(v.x, v.y); w.y = pk2(v.z, v.w); o[i] = w; } }
            { const int* pos = (const int*)inptr(2);
              for (int i = blk * 512 + tid; i < MTOK * 16; i += G * 512) { const int row = i >> 4, j = i & 15;
                  const float inv_freq = exp2f(-(float)j * (18.931568569324174f / 16.f));
                  const float ang = (float)pos[row] * inv_freq;
                  double rev = (double)ang * 0.15915494309189535; rev -= floor(rev);
                  const float rf = (float)rev;
                  rope[row * 32 + j] = __builtin_amdgcn_cosf(rf); rope[row * 32 + 16 + j] = __builtin_amdgcn_sinf(rf); } }
            if (blk == 0) {
                if (wave == 0) { const float* lp = (const float*)inptr(18); float s1 = 0.f, s2 = 0.f;
                    for (int i = lane; i < 128; i += 64) { s1 += lp[i] * lp[128 + i]; s2 += lp[256 + i] * lp[384 + i]; }
                    s1 = wave_sum(s1); s2 = wave_sum(s2);
                    if (lane == 0) ctl[CTL_LAM] = expf(s1) - expf(s2) + 0.2f; }
                const float* lb = (const float*)inptr(22);
                for (int i = tid; i < DM; i += 512) { const float b0 = lb[i], b1 = lb[DM + i], mx = fmaxf(b0, b1), e0 = expf(b0 - mx), e1 = expf(b1 - mx); ctl[CTL_LBS + i] = e1 / (e0 + e1); }
            }
            prep_rows((const float*)inptr(0), (bf16_t*)(ws + WS_LT * MiB), SS, gw, NGW, lane);
        } break;
        case 1: KON(1) {
            { pg8::Gemm g{sub ? Hb : (const bf16_t*)(ws + WS_LT * MiB), (const bf16_t*)(ws + (sub ? WS_WGU2 : WS_WGU1) * MiB), MTOK, 2 * DFF, DM, DM, DM, 0}; pg8::StaticOrder S; S.init(MTOK, 2 * DFF, G, blk);
              pg8::EpiSwiGLU E{GU, DFF, SS + 8192 * (4 * l + (sub ? 2 : 0))};
              pg8::gemm_phase<pg8::EpiSwiGLU, pg8::StaticOrder, true, true>((PG8_LAS unsigned char*)lds, g, S, E); }
            if (sub) { pg8::Gemm g{PB + (size_t)l * MTOK * PLED, (const bf16_t*)(ws + WS_WPE * MiB), MTOK, DM, PLED, PLED, PLED, 0}; asm volatile("" : "+s"(g.K)); pg8::StaticOrder S; S.init(MTOK, DM, G, blk);
              pg8::EpiF32<2> E{nullptr, nullptr, nullptr, PE, nullptr, ws, 1, 0, 0};
              pg8::gemm_phase<pg8::EpiF32<2>, pg8::StaticOrder, true, true>((PG8_LAS unsigned char*)lds, g, S, E); }
            if (G == 256 && blk >= 128) { LOCAL_IDS; convert_layer(a, ws, l, sub ? 0x20u : 0x4u, lds, tid, wave, (blk - 128) * 8 + wave, 128 * 8, lane); }
        } break;
        case 2: KON(2) {
            pg8::Gemm g; const float* basef = (l == 0 && sub == 0) ? (const float*)inptr(0) : nullptr;
            const bf16_t* baseb = (l == 1 && sub == 0) ? (const bf16_t*)(ws + WS_LT * MiB) : Hb;
            if (sub == 2) { g = pg8::Gemm{(const bf16_t*)(ws + (l ? WS_OHG : WS_CC) * MiB), (const bf16_t*)(ws + WS_WMIXOUT * MiB), MTOK, DM, DM, DM, DM, 0}; }
            else { g = pg8::Gemm{GU, (const bf16_t*)(ws + (sub ? WS_WD2 : WS_WD1) * MiB), MTOK, DM, DFF, DFF, DFF, 0}; }
            pg8::StaticOrder S; S.init(MTOK, DM, G, blk);
            pg8::EpiF32<0> E{basef, baseb, nullptr, Hb, nullptr, ws, sub == 2 ? 1 : 0, 4 * l + (sub == 0 ? 1 : sub == 2 ? 2 : 3), 0};
            pg8::gemm_phase<pg8::EpiF32<0>, pg8::StaticOrder, true, true>((PG8_LAS unsigned char*)lds, g, S, E);
        } break;
        case 3: KON(3) {
            LOCAL_IDS;
            if (sub == 3) convert_layer(a, ws, 1, G == 256 ? 0x3FDBu : 0x3FFFu, lds, tid, wave, gw, NGW, lane);
            else final_rows(out, (const float*)inptr(25), SS + 8192 * 8, gw, NGW, lane);
        } break;
        case 4: KON(4) {
            pg8::Gemm g{Hb, (const bf16_t*)(ws + WS_WMIXIN * MiB), MTOK, 4096, DM, DM, DM, 0}; pg8::StaticOrder S; S.init(MTOK, 4096, G, blk);
            pg8::EpiABin E{(float*)(ws + WS_U * MiB), (bf16_t*)(ws + WS_QH * MiB), rope, SS + 8192 * 1};
            pg8::gemm_phase<pg8::EpiABin, pg8::StaticOrder, true, true>((PG8_LAS unsigned char*)lds, g, S, E);
        } break;
        case 5: KON(5) {
            { LOCAL_IDS; pool_diff((const float*)(ws + WS_U * MiB), (bf16_t*)(ws + WS_DP * MiB), blk, G, tid); }
            attn_phase((char*)lds, (const attn::bf16*)(ws + WS_QH * MiB), (const attn::bf16*)(ws + WS_KH * MiB), (const attn::bf16*)(ws + WS_VH * MiB), (attn::bf16*)(ws + WS_OH * MiB), blk, G);
        } break;
        case 6: KON(6) {
            { pg8::Gemm g{(const bf16_t*)(ws + WS_DP * MiB), (const bf16_t*)(ws + WS_WPOOL * MiB), MTOK, 1024, 256, 1024, 256, 512}; asm volatile("" : "+s"(g.K)); pg8::StaticOrder S; S.init(MTOK, 1024, G, blk);
              pg8::EpiPool E{(bf16_t*)(ws + WS_CC * MiB), DM, (const float*)inptr(17)};
              pg8::gemm_phase<pg8::EpiPool, pg8::StaticOrder, true, true>((PG8_LAS unsigned char*)lds, g, S, E); }
            LOCAL_IDS;
            attn_combine((const bf16_t*)(ws + WS_OH * MiB), (const float*)inptr(19), ctl + CTL_LAM, (bf16_t*)(ws + WS_CC * MiB), gw, NGW, lane);
        } break;
        case 7: KON(7) {
            pg8::Gemm g{Hb, (const bf16_t*)(ws + WS_WPG * MiB), MTOK, DM, DM, DM, DM, 0}; pg8::StaticOrder S; S.init(MTOK, DM, G, blk);
            pg8::EpiF32<1> E{nullptr, Hb, l ? out : nullptr, (bf16_t*)(ws + WS_LT * MiB), PE, ws, 1, 4 * l + 4, 4 * l + 3};
            pg8::gemm_phase<pg8::EpiF32<1>, pg8::StaticOrder, true, true>((PG8_LAS unsigned char*)lds, g, S, E);
        } break;
        case 8: KON(8) {
            pg8::Gemm g{Hb, (const bf16_t*)(ws + WS_WMIXIN * MiB), MTOK, 8192, DM, DM, DM, 0}; pg8::StaticOrder S; S.init(MTOK, 8192, G, blk);
            pg8::EpiHin E{(bf16_t*)(ws + WS_QS * MiB), (float*)(ws + WS_LF * MiB), ctl + CTL_LBS, SS + 8192 * 5};
            pg8::gemm_phase<pg8::EpiHin, pg8::StaticOrder, true, true>((PG8_LAS unsigned char*)lds, g, S, E);
        } break;
        case 9: KON(9) { LOCAL_IDS; hgrn_passA(lds, (const float*)(ws + WS_LF * MiB), (const bf16_t*)(ws + WS_KB * MiB), (const bf16_t*)(ws + WS_VB * MiB), (bf16_t*)(ws + WS_LT * MiB), (float*)(ws + WS_DEC * MiB), blk, G, tid, wave, lane); } break;
        case 10: KON(10) { LOCAL_IDS; hgrn_scan((bf16_t*)(ws + WS_LT * MiB), (const float*)(ws + WS_DEC * MiB), blk * 512 + tid, G * 512); } break;
        case 11: KON(11) { LOCAL_IDS; hgrn_passC(lds, (const float*)(ws + WS_LF * MiB), (const bf16_t*)(ws + WS_QS * MiB), (const bf16_t*)(ws + WS_KB * MiB), (const bf16_t*)(ws + WS_VB * MiB), (const bf16_t*)(ws + WS_GS * MiB),
                            (const bf16_t*)(ws + WS_LT * MiB), (const float*)inptr(23), (bf16_t*)(ws + WS_OHG * MiB), blk, G, tid, wave, lane); } break;
        default: break;
        }
#ifdef DUPSYNC
        for (int srep = 0; srep < 2; ++srep)
#endif
        if (ph + 1 < a.ph_hi) {
            { int phh = a.ph_hi; asm volatile("" : "+s"(phh)); if (phh > 1000) grid.sync(); }
            xcd_barrier(xbar);
        }
    }
}

#ifndef MK_MULTI
#define MK_MULTI 0
#endif
extern "C" void kernel_launch(void* const* d_in, const int* in_sizes, int n_in, void* d_out, int out_size, void* d_ws, size_t ws_size, hipStream_t stream) {
    static int grid = 0;
    if (grid == 0) {
        if (n_in != 26 || out_size != MTOK * DM || ws_size < WS_END * MiB) { fprintf(stderr, "kernel_launch: unexpected shapes (n_in %d, out %d, ws %zu)\n", n_in, out_size, ws_size); grid = -1; return; }
        int dev = 0, cus = 0, per_cu = 0;
        (void)hipGetDevice(&dev); (void)hipDeviceGetAttribute(&cus, hipDeviceAttributeMultiprocessorCount, dev);
        (void)hipFuncSetAttribute((const void*)mega_fwd, hipFuncAttributeMaxDynamicSharedMemorySize, LDS_BYTES);
        (void)hipOccupancyMaxActiveBlocksPerMultiprocessor(&per_cu, (const void*)mega_fwd, 512, LDS_BYTES);
        if (per_cu < 1) { fprintf(stderr, "kernel_launch: occupancy query says %d blocks per CU\n", per_cu); per_cu = 1; }
        (void)hipGetLastError();
        grid = cus > 0 ? cus : 256;
    }
    if (grid < 0) return;
    (void)hipMemsetAsync((char*)d_ws + CTL_BAR_BYTE, 0, CTL_BAR_BYTES, stream);
    Args a{};
    for (int i = 0; i < 26; ++i) a.in[i] = d_in[i];
    a.out = (float*)d_out; a.ws = (unsigned char*)d_ws;
#if MK_MULTI
    for (int ph = 0; ph < NPH; ++ph) { a.ph_lo = ph; a.ph_hi = ph + 1; hipLaunchKernelGGL(mega_fwd, dim3(grid), dim3(512), LDS_BYTES, stream, a); }
#else
    a.ph_lo = 0; a.ph_hi = NPH;
    void* args[] = {&a};
    hipError_t e = hipLaunchCooperativeKernel((const void*)mega_fwd, dim3(grid), dim3(512), args, LDS_BYTES, stream);
    if (e != hipSuccess) fprintf(stderr, "cooperative launch failed: %s (grid %d)\n", hipGetErrorString(e), grid);
#ifdef PROBE_LIST
    { const int plist[] = PROBE_LIST;
      for (int p : plist) { Args a2 = a; a2.out = (float*)((char*)d_ws + WS_LT * MiB); a2.ph_lo = p; a2.ph_hi = p + 1; void* args2[] = {&a2};
          (void)hipLaunchCooperativeKernel((const void*)mega_fwd, dim3(grid), dim3(512), args2, LDS_BYTES, stream); } }
#endif
#endif
}
```
